# Optimizing an MI355X kernel written in HIP

```python
import math
import jax, jax.numpy as jnp
from jax import lax
import numpy as np

D_MODEL = 2048
BATCH = 1
SEQ = 16384
DEPTH = 1

GRID_W = 64
CTX_LEN = 256
EPS = 1e-6

SSM_HEADS = 32
SSM_HEAD_DIM = 64
SSM_INNER = SSM_HEADS * SSM_HEAD_DIM
SSM_GROUPS = 4
SSM_STATE = 128
SSM_CONV = 4
SSM_CHUNK = 128
CONV_DIM = SSM_INNER + 2 * SSM_GROUPS * SSM_STATE

HGRN_HEADS = 16
HGRN_KEY_DIM = 128
HGRN_VAL_DIM = D_MODEL // HGRN_HEADS
HGRN_FDIM = HGRN_HEADS * HGRN_KEY_DIM
HGRN_INNER = HGRN_HEADS * HGRN_VAL_DIM
HGRN_CHUNK = 64

N_EXPERTS = 32
TOP_K = 4
D_FF = 2048
SWIGLU_LIMIT = 7.0
SWIGLU_ALPHA = 1.702
MOE_BLOCK = 256

IN_SIZES = (SSM_INNER, CONV_DIM, 2 * SSM_HEADS, HGRN_FDIM, 2 * HGRN_FDIM, HGRN_INNER, HGRN_INNER, 2 * D_MODEL)
D_IN = sum(IN_SIZES)
IN_OFFSETS = tuple(sum(IN_SIZES[:k + 1]) for k in range(len(IN_SIZES) - 1))

kernel_name = 'hybrid_ssd_hgrn2_moe_dit_block'


def rmsnorm(x, w):
    x32 = x.astype(jnp.float32)
    y = x32 * lax.rsqrt(jnp.mean(x32 * x32, axis=-1, keepdims=True) + EPS)
    return (y * w.astype(jnp.float32)).astype(x.dtype)


def modulate(xn, shift, scale):
    return xn * (1 + scale) + shift


def centred_dwconv(u, w, b, n_rows):
    bsz, L, C = u.shape
    row_len = L // n_rows
    r = u.reshape(bsz * n_rows, row_len, C)
    left = SSM_CONV // 2
    rp = jnp.pad(r, ((0, 0), (left, SSM_CONV - 1 - left), (0, 0)))
    out = sum(rp[:, k:k + row_len] * w[k] for k in range(SSM_CONV)) + b
    return out.reshape(bsz, L, C)


def ssd_chunked(xdt, loga, Bm, Cm, s0):
    bsz, L, H, P = xdt.shape
    G, N = Bm.shape[2], Bm.shape[3]
    J = H // G
    Q = SSM_CHUNK
    nc = L // Q
    x = xdt.reshape(bsz, nc, Q, G, J, P)
    Bc = Bm.reshape(bsz, nc, Q, G, N)
    Cc = Cm.reshape(bsz, nc, Q, G, N)
    acs = jnp.cumsum(loga.reshape(bsz, nc, Q, G, J).transpose(0, 3, 4, 1, 2), axis=-1)
    causal = jnp.tril(jnp.ones((Q, Q), bool))
    decay = jnp.exp(jnp.where(causal, acs[..., :, None] - acs[..., None, :], -jnp.inf))
    cb = jnp.einsum('bctgn,bcsgn->bgcts', Cc, Bc)
    y_diag = jnp.einsum('bgcts,bgjcts,bcsgjp->bctgjp', cb, decay, x)
    to_end = jnp.exp(acs[..., -1:] - acs)
    states = jnp.einsum('bcsgn,bgjcs,bcsgjp->cbgjpn', Bc, to_end, x)
    chunk_decay = jnp.exp(acs[..., -1]).transpose(3, 0, 1, 2)

    def step(S, inp):
        st, dec = inp
        return S * dec[..., None, None] + st, S

    S_fin, S_in = lax.scan(step, s0.reshape(bsz, G, J, P, N), (states, chunk_decay))
    y_off = jnp.einsum('bctgn,cbgjpn,bgjct->bctgjp', Cc, S_in, jnp.exp(acs))
    y = (y_diag + y_off).reshape(bsz, L, H, P)
    return y, S_fin.reshape(bsz, H, P, N)


def hgrn2_chunked(q, k, v, logf, s0):
    bsz, L, H, K = q.shape
    V = v.shape[-1]
    Q = HGRN_CHUNK
    nc = L // Q

    def to_chunks(t):
        return t.reshape(bsz, nc, Q, H, t.shape[-1]).transpose(1, 0, 3, 2, 4)

    causal = jnp.tril(jnp.ones((Q, Q), bool))[:, :, None]

    def step(S, inp):
        qc, kc, vc, gc = inp
        bcs = jnp.cumsum(gc, axis=2)
        o_inter = jnp.einsum('bhtk,bhkv->bhtv', qc * jnp.exp(bcs), S)
        rel = jnp.exp(jnp.where(causal, bcs[:, :, :, None, :] - bcs[:, :, None, :, :], -jnp.inf))
        att = jnp.einsum('bhtk,bhtsk,bhsk->bhts', qc, rel, kc)
        o = o_inter + jnp.einsum('bhts,bhsv->bhtv', att, vc)
        last = bcs[:, :, -1:]
        S = jnp.exp(last[:, :, 0])[..., None] * S + jnp.einsum('bhsk,bhsv->bhkv', kc * jnp.exp(last - bcs), vc)
        return S, o

    S_fin, o = lax.scan(step, s0, (to_chunks(q), to_chunks(k), to_chunks(v), to_chunks(logf)))
    return o.transpose(1, 0, 3, 2, 4).reshape(bsz, L, H, V), S_fin


def mamba2_branch(z, xbc, dt_raw, n_rows, conv_w, conv_b, dt_bias, a_log, d_skip, norm_w, s0):
    f32 = jnp.float32
    bsz, L, _ = z.shape
    xbc = jax.nn.silu(centred_dwconv(xbc, conv_w, conv_b, n_rows)).astype(f32)
    xs, Bm, Cm = jnp.split(xbc, [SSM_INNER, SSM_INNER + SSM_GROUPS * SSM_STATE], axis=-1)
    xs = xs.reshape(bsz, L, SSM_HEADS, SSM_HEAD_DIM)
    Bm = Bm.reshape(bsz, L, SSM_GROUPS, SSM_STATE)
    Cm = Cm.reshape(bsz, L, SSM_GROUPS, SSM_STATE)
    dt = jax.nn.softplus(dt_raw.astype(f32).reshape(bsz, L, 2, SSM_HEADS) + dt_bias.astype(f32))
    A = -jnp.exp(a_log.astype(f32))
    y_f, s_f = ssd_chunked(xs * dt[:, :, 0, :, None], A[0] * dt[:, :, 0], Bm, Cm, s0[0])
    flip = lambda t: jnp.flip(t, axis=1)
    y_b, s_b = ssd_chunked(flip(xs * dt[:, :, 1, :, None]), flip(A[1] * dt[:, :, 1]), flip(Bm), flip(Cm), s0[1])
    y = y_f + flip(y_b) + d_skip.astype(f32)[:, None] * xs
    gsz = SSM_INNER // SSM_GROUPS
    y = y.reshape(bsz, L, SSM_GROUPS, gsz) * jax.nn.silu(z.astype(f32)).reshape(bsz, L, SSM_GROUPS, gsz)
    y = y * lax.rsqrt(jnp.mean(y * y, axis=-1, keepdims=True) + EPS) * norm_w.astype(f32).reshape(SSM_GROUPS, gsz)
    return y.reshape(bsz, L, SSM_INNER).astype(z.dtype), (s_f, s_b)


def hgrn2_branch(q, f_raw, i, g, lb, norm_w, s0):
    f32 = jnp.float32
    bsz, L, _ = q.shape
    H, K, V = HGRN_HEADS, HGRN_KEY_DIM, HGRN_VAL_DIM
    q32 = q.astype(f32).reshape(bsz, L, H, K) * (K ** -0.5)
    v32 = jax.nn.silu(i.astype(f32)).reshape(bsz, L, H, V)
    fr = f_raw.astype(f32).reshape(bsz, L, 2, H, K)
    lbh = lb.reshape(2, H, K)
    logf = jnp.log(lbh + (1 - lbh) * jax.nn.sigmoid(fr))
    kin = (1 - lbh) * jax.nn.sigmoid(-fr)
    o_f, s_f = hgrn2_chunked(q32, kin[:, :, 0], v32, logf[:, :, 0], s0[0])
    flip = lambda t: jnp.flip(t, axis=1)
    o_b, s_b = hgrn2_chunked(flip(q32), flip(kin[:, :, 1]), flip(v32), flip(logf[:, :, 1]), s0[1])
    o = o_f + flip(o_b)
    o = o * lax.rsqrt(jnp.mean(o * o, axis=-1, keepdims=True) + EPS) * norm_w.astype(f32)
    o = o.reshape(bsz, L, HGRN_INNER) * jax.nn.silu(g.astype(f32))
    return o.astype(q.dtype), (s_f, s_b)


def mixer_branches(hn, n_rows, init, w_in, conv_w, conv_b, dt_bias, a_log, d_skip, ssm_norm_w, lb, hgrn_norm_w):
    proj = hn @ w_in
    z, xbc, dt_raw, q, f_raw, i, g, merge = jnp.split(proj, IN_OFFSETS, axis=-1)
    y_ssm, ssm_states = mamba2_branch(z, xbc, dt_raw, n_rows, conv_w, conv_b, dt_bias, a_log, d_skip, ssm_norm_w, init[0])
    y_hgrn, hgrn_states = hgrn2_branch(q, f_raw, i, g, lb, hgrn_norm_w, init[1])
    return y_ssm, y_hgrn, merge, (ssm_states, hgrn_states)


def merge_branches(y_ssm, y_hgrn, merge, w_bs, w_bh, w_o):
    g_s, g_h = jnp.split(merge, 2, axis=-1)
    y = jax.nn.sigmoid(g_s) * (y_ssm @ w_bs) + jax.nn.sigmoid(g_h) * (y_hgrn @ w_bh)
    return y @ w_o


def moe_ffn(h, w_r, b_r, w_gu, b_gu, w_dn, b_dn):
    T, D = h.shape
    logits = (h @ w_r + b_r).astype(jnp.float32)
    top_v, top_i = lax.top_k(logits, TOP_K)
    probs = jax.nn.softmax(top_v, axis=-1)
    n_assign = T * TOP_K
    e_flat = top_i.reshape(-1)
    order = jnp.argsort(e_flat)
    e_sorted = e_flat[order]
    tok_sorted = (order // TOP_K).astype(jnp.int32)
    p_sorted = probs.reshape(-1)[order]
    counts = jnp.bincount(e_flat, length=N_EXPERTS)
    padded = (counts + MOE_BLOCK - 1) // MOE_BLOCK * MOE_BLOCK
    pad_end = jnp.cumsum(padded)
    pad_start = pad_end - padded
    start = jnp.cumsum(counts) - counts
    dest = pad_start[e_sorted] + jnp.arange(n_assign) - start[e_sorted]
    n_blocks = -(-(n_assign + N_EXPERTS * (MOE_BLOCK - 1)) // MOE_BLOCK)
    n_slots = n_blocks * MOE_BLOCK
    row_tok = jnp.full((n_slots,), T, jnp.int32).at[dest].set(tok_sorted)
    row_p = jnp.zeros((n_slots,), h.dtype).at[dest].set(p_sorted.astype(h.dtype))
    blk_e = jnp.minimum(jnp.searchsorted(pad_end, jnp.arange(n_blocks) * MOE_BLOCK, side='right'), N_EXPERTS - 1)
    h_pad = jnp.concatenate([h, jnp.zeros((1, D), h.dtype)], axis=0)
    xb = h_pad[row_tok].reshape(n_blocks, MOE_BLOCK, D)

    def expert_block(args):
        xe, e = args
        gu = xe @ w_gu[e] + b_gu[e]
        gate, up = gu[:, :D_FF], gu[:, D_FF:]
        gate = jnp.minimum(gate, SWIGLU_LIMIT)
        up = jnp.clip(up, -SWIGLU_LIMIT, SWIGLU_LIMIT)
        glu = gate * jax.nn.sigmoid(SWIGLU_ALPHA * gate)
        return ((up + 1) * glu) @ w_dn[e] + b_dn[e]

    yb = lax.map(expert_block, (xb, blk_e)).reshape(n_slots, D)
    out = jnp.zeros((T + 1, D), h.dtype).at[row_tok].add(yb * row_p[:, None])
    return out[:T]


def setup_inputs(seed: int = 0) -> dict:
    key = jax.random.key(seed)
    ks = jax.random.split(key, 32)
    f32 = jnp.float32
    D = D_MODEL
    nrm = lambda k, shape, s: jax.random.normal(k, shape, f32) * s
    dt0 = jnp.exp(jax.random.uniform(ks[10], (DEPTH, 2, SSM_HEADS), f32, math.log(1e-3), math.log(1e-1)))
    return {
        'x': nrm(ks[0], (BATCH, SEQ, D), 1.0),
        'c': nrm(ks[1], (BATCH, D), 1.0),
        'ctx': nrm(ks[2], (BATCH, CTX_LEN, D), 1.0),
        'c_ctx': nrm(ks[3], (D,), 1.0),
        'w_ada': nrm(ks[4], (DEPTH, D, 6 * D), 0.5 * D ** -0.5),
        'b_ada': nrm(ks[5], (DEPTH, 6 * D), 0.02),
        'norm1_w': 1.0 + nrm(ks[6], (DEPTH, D), 0.02),
        'norm2_w': 1.0 + nrm(ks[7], (DEPTH, D), 0.02),
        'w_in': nrm(ks[8], (DEPTH, D, D_IN), D ** -0.5),
        'conv_w': nrm(ks[9], (DEPTH, SSM_CONV, CONV_DIM), SSM_CONV ** -0.5),
        'conv_b': nrm(ks[11], (DEPTH, CONV_DIM), 0.02),
        'dt_bias': dt0 + jnp.log(-jnp.expm1(-dt0)),
        'a_log': jnp.log(jax.random.uniform(ks[12], (DEPTH, 2, SSM_HEADS), f32, 1.0, 16.0)),
        'd_skip': 1.0 + nrm(ks[13], (DEPTH, SSM_HEADS), 0.1),
        'ssm_norm_w': 1.0 + nrm(ks[14], (DEPTH, SSM_INNER), 0.02),
        'hgrn_lb': nrm(ks[15], (2, DEPTH + 1, HGRN_FDIM), 1.0),
        'hgrn_norm_w': 1.0 + nrm(ks[16], (DEPTH, HGRN_VAL_DIM), 0.02),
        'w_branch_ssm': nrm(ks[17], (DEPTH, SSM_INNER, D), SSM_INNER ** -0.5),
        'w_branch_hgrn': nrm(ks[18], (DEPTH, HGRN_INNER, D), HGRN_INNER ** -0.5),
        'w_out': nrm(ks[19], (DEPTH, D, D), D ** -0.5),
        'w_router': nrm(ks[20], (DEPTH, D, N_EXPERTS), D ** -0.5),
        'b_router': nrm(ks[21], (DEPTH, N_EXPERTS), 0.01),
        'w_gate_up': nrm(ks[22], (DEPTH, N_EXPERTS, D, 2 * D_FF), D ** -0.5),
        'b_gate_up': nrm(ks[23], (DEPTH, N_EXPERTS, 2 * D_FF), 0.02),
        'w_down': nrm(ks[24], (DEPTH, N_EXPERTS, D_FF, D), D_FF ** -0.5),
        'b_down': nrm(ks[25], (DEPTH, N_EXPERTS, D), 0.02),
        'final_norm_w': 1.0 + nrm(ks[26], (D,), 0.02),
    }


def reference(x, c, ctx, c_ctx, w_ada, b_ada, norm1_w, norm2_w, w_in, conv_w, conv_b, dt_bias, a_log, d_skip, ssm_norm_w, hgrn_lb, hgrn_norm_w, w_branch_ssm, w_branch_hgrn, w_out, w_router, b_router, w_gate_up, b_gate_up, w_down, b_down, final_norm_w):
    f32 = jnp.float32
    bsz, seq, d = x.shape
    rows = seq // GRID_W
    ctx_len = ctx.shape[1]
    lower_bounds = jnp.cumsum(jax.nn.softmax(hgrn_lb.astype(f32), axis=1), axis=1)
    zs = jnp.zeros((bsz, SSM_HEADS, SSM_HEAD_DIM, SSM_STATE), f32)
    zh = jnp.zeros((bsz, HGRN_HEADS, HGRN_KEY_DIM, HGRN_VAL_DIM), f32)
    zero_init = ((zs, zs), (zh, zh))
    h, hc = x, ctx
    for l in range(DEPTH):
        mod = (jax.nn.silu(c) @ w_ada[l] + b_ada[l])[:, None, :]
        mod_c = (jax.nn.silu(c_ctx) @ w_ada[l] + b_ada[l])[None, None, :]
        sh1, sc1, g1, sh2, sc2, g2 = jnp.split(mod, 6, axis=-1)
        csh1, csc1, cg1, csh2, csc2, cg2 = jnp.split(mod_c, 6, axis=-1)
        mix_p = (w_in[l], conv_w[l], conv_b[l], dt_bias[l], a_log[l], d_skip[l], ssm_norm_w[l], lower_bounds[:, l], hgrn_norm_w[l])
        out_p = (w_branch_ssm[l], w_branch_hgrn[l], w_out[l])
        ffn_p = (w_router[l], b_router[l], w_gate_up[l], b_gate_up[l], w_down[l], b_down[l])
        hn_c = modulate(rmsnorm(hc, norm1_w[l]), csh1, csc1)
        ys_c, yh_c, gates_c, ctx_states = mixer_branches(hn_c, 1, zero_init, *mix_p)
        hn = modulate(rmsnorm(h, norm1_w[l]), sh1, sc1)
        ys, yh, gates, _ = mixer_branches(hn, rows, ctx_states, *mix_p)
        h = h + g1 * merge_branches(ys, yh, gates, *out_p)
        hn2 = modulate(rmsnorm(h, norm2_w[l]), sh2, sc2)
        h = h + g2 * moe_ffn(hn2.reshape(-1, d), *ffn_p).reshape(bsz, seq, d)
        if l < DEPTH - 1:
            hc = hc + cg1 * merge_branches(ys_c, yh_c, gates_c, *out_p)
            hn2_c = modulate(rmsnorm(hc, norm2_w[l]), csh2, csc2)
            hc = hc + cg2 * moe_ffn(hn2_c.reshape(-1, d), *ffn_p).reshape(bsz, ctx_len, d)
    return rmsnorm(h, final_norm_w)
```

```cpp
#include <hip/hip_runtime.h>
#include <cstdio>
#include <cstdint>

#ifndef NAIVE_SCAN
#define NAIVE_SCAN 0
#endif
#ifndef PROBE_PHASE
#define PROBE_PHASE -1
#endif
#ifndef PROBE_MASK
#define PROBE_MASK 7
#endif
#ifndef MK_PER_PHASE
#define MK_PER_PHASE 0
#endif

#define GAS __attribute__((address_space(1)))
#define LAS __attribute__((address_space(3)))
#define PG8_LAS __attribute__((address_space(3)))
typedef unsigned short bf16;
typedef unsigned v4u __attribute__((ext_vector_type(4)));
typedef unsigned v2u __attribute__((ext_vector_type(2)));
typedef float f32x4 __attribute__((ext_vector_type(4)));
typedef float f32x2 __attribute__((ext_vector_type(2)));
typedef short bf16x8 __attribute__((ext_vector_type(8)));

namespace pg8 {
typedef unsigned short bf16_t;
typedef unsigned u32x4 __attribute__((ext_vector_type(4)));
constexpr int BM = 256, BK = 64, HALF = 128, HTB = HALF * BK * 2  , STAGE_BYTES = 8 * HTB, NXCD = 8, WGM = 8;

__host__ __device__ __forceinline__ int lds_byte(int r, int c) { const int st = (r >> 4) * 2 + (c >> 5), rr = r & 15, cc = c & 31, ob = rr * 64 + cc * 2; return st * 1024 + (ob ^ (((ob >> 9) & 1) << 5)); }
__host__ __device__ __forceinline__ void stage_rc(int b, int& R, int& C) { const int st = b / 1024, sb = b % 1024, swz = sb ^ (((sb >> 9) & 1) << 5); R = (st >> 1) * 16 + swz / 64; C = (st & 1) * 32 + (swz % 64) / 2; }
__host__ __device__ __forceinline__ int perm32(int rho) { const int n = rho >> 4, i = rho & 15; return 8 * (i >> 2) + 4 * n + (i & 3); }

struct Unit { int pm, pn, sel; };
struct Gemm { const bf16_t* A; const bf16_t* Bt; int M, N, K; const bf16_t* A2; const bf16_t* Bt2; };

struct StaticOrder {
    static constexpr bool GATHER = false;
    int nM, nN, nwg, G, c;
    __host__ __device__ void init(int M, int N, int G_, int c_) { nM = M / BM; nN = N / BM; nwg = nM * nN; G = G_; c = c_; }
    __host__ __device__ bool next(int i, Unit& u) const {
        const long L = (long)i * G + c; if (L >= nwg) return false;
        int wgid = (int)L; { const int q = nwg / NXCD, r = nwg % NXCD, xcd = wgid % NXCD, off = wgid / NXCD; wgid = (xcd < r ? xcd * (q + 1) : r * (q + 1) + (xcd - r) * q) + off; }
        const int nig = WGM * nN, gid = wgid / nig, fm = gid * WGM, gsz = (nM - fm) < WGM ? (nM - fm) : WGM;
        u.pm = fm + ((wgid % nig) % gsz); u.pn = (wgid % nig) / gsz; u.sel = 0; return true;
    }
    __device__ __forceinline__ void a_ready(const Unit&) const {}
    __device__ __forceinline__ void done(const Unit&) const {}
};
struct PairOrder : StaticOrder {
    __device__ bool next(int i, Unit& u) const { const bool ok = StaticOrder::next(i >> 1, u); u.sel = i & 1; return ok; }
};
struct MoeOrder {
    static constexpr bool GATHER = false;
    int nM, nN, nwg, G, c; const LAS int* blk_e;
    __device__ void init(int nblk, int NT, int G_, int c_, const LAS int* tbl) { nM = nblk; nN = NT; nwg = nM * nN; G = G_; c = c_; blk_e = tbl; }
    __device__ __forceinline__ bool next(int i, Unit& u) const {
        const long L = (long)i * G + c; if (L >= nwg) return false;
        int wgid = (int)L; { const int q = nwg / NXCD, r = nwg % NXCD, xcd = wgid % NXCD, off = wgid / NXCD; wgid = (xcd < r ? xcd * (q + 1) : r * (q + 1) + (xcd - r) * q) + off; }
        const int nig = WGM * nN, gid = wgid / nig, fm = gid * WGM, gsz = (nM - fm) < WGM ? (nM - fm) : WGM;
        u.pm = fm + ((wgid % nig) % gsz); u.pn = blk_e[u.pm] * nN + (wgid % nig) / gsz; u.sel = 0; return true;
    }
    __device__ __forceinline__ void a_ready(const Unit&) const {}
    __device__ __forceinline__ void done(const Unit&) const {}
};

struct MoeGatherOrder : MoeOrder { static constexpr bool GATHER = true; const LAS unsigned* rowtab; };

typedef __bf16 bf16x2_t __attribute__((ext_vector_type(2)));
typedef float f32x2_t __attribute__((ext_vector_type(2)));
__device__ __forceinline__ unsigned cvt_pk_bf16(float lo, float hi) { const f32x2_t v = {lo, hi}; const bf16x2_t r = __builtin_convertvector(v, bf16x2_t); return __builtin_bit_cast(unsigned, r); }

template <class Epi, class Sched, bool ALIGN_EPI = false, bool SP2 = false>
__device__ __forceinline__ void gemm_phase(PG8_LAS unsigned char* lds, const Gemm g, const Sched& S, const Epi& E) {
    const int tid = threadIdx.x, wid = __builtin_amdgcn_readfirstlane(tid >> 6), lane = tid & 63, wr = wid >> 2, wc = wid & 3, fr = lane & 15, fq = lane >> 4;
    const int K = g.K, nt = K / BK;
    unsigned voffA[2], voffB[2];
#pragma unroll
    for (int i = 0; i < 2; ++i) { int R, C; stage_rc(tid * 16 + i * 8192, R, C); const int Rb = Epi::PERM ? ((R & ~31) + perm32(R & 31)) : R;
        voffA[i] = (unsigned)(R * K + C) * 2u; voffB[i] = (unsigned)(Rb * K + C) * 2u; }
    unsigned vC[2][2] = {{0u, 0u}, {0u, 0u}}, vN[2][2] = {{0u, 0u}, {0u, 0u}};
#define PG8_ROWOFF(dst, unit_) do { _Pragma("unroll") for (int i_ = 0; i_ < 2; ++i_) { int R_, C_; stage_rc(tid * 16 + i_ * 8192, R_, C_); \
        dst[0][i_] = S.rowtab[(unit_) * 256 + R_] + (unsigned)C_ * 2u; dst[1][i_] = S.rowtab[(unit_) * 256 + 128 + R_] + (unsigned)C_ * 2u; } } while (0)
    const size_t kstep = (size_t)(BK * 2);
    const size_t hstep = (size_t)HALF * K * 2;
    const size_t tstep = 2 * hstep;
    const size_t tstepA = Sched::GATHER ? (size_t)0 : tstep;
    const unsigned ldsw = (unsigned)wid * 1024u;
    const int aoff = lds_byte(wr * 64 + fr, fq * 8), boff = lds_byte(wc * 32 + fr, fq * 8);
#define PG8_SA(b, h) (((b) * 2 + (h)) * HTB)
#define PG8_SB(b, h) ((4 + (b) * 2 + (h)) * HTB)
#define PG8_STAGE(bufoff, gbase, voff) do { _Pragma("unroll") for (int _i = 0; _i < 2; ++_i) \
        __builtin_amdgcn_global_load_lds((const unsigned*)((const char*)(gbase) + (voff)[_i]), (PG8_LAS unsigned*)(lds + (bufoff) + ldsw + _i * 8192), 16, 0, 0); } while (0)
#define PG8_STAGE_A(bufoff, kptr, half, nx) do { if constexpr (Sched::GATHER) { _Pragma("unroll") for (int _i = 0; _i < 2; ++_i) \
        __builtin_amdgcn_global_load_lds((const unsigned*)((const char*)(kptr) + ((nx) ? vN[half][_i] : vC[half][_i])), (PG8_LAS unsigned*)(lds + (bufoff) + ldsw + _i * 8192), 16, 0, 0); } \
    else { PG8_STAGE(bufoff, (kptr) + ((half) ? hstep : (size_t)0), voffA); } } while (0)
#define PG8_LDA(dst, b, h) do { _Pragma("unroll") for (int m = 0; m < 4; ++m) _Pragma("unroll") for (int k = 0; k < 2; ++k) dst[m][k] = *(const PG8_LAS bf16x8*)(lds + PG8_SA(b, h) + aoff + m * 2048 + k * 1024); } while (0)
#define PG8_LDB(dst, b, h) do { _Pragma("unroll") for (int n = 0; n < 2; ++n) _Pragma("unroll") for (int k = 0; k < 2; ++k) dst[n][k] = *(const PG8_LAS bf16x8*)(lds + PG8_SB(b, h) + boff + n * 2048 + k * 1024); } while (0)
#define PG8_MMA(ai, bj, At, Bt) do { __builtin_amdgcn_s_setprio(1); _Pragma("unroll") for (int m = 0; m < 4; ++m) _Pragma("unroll") for (int n = 0; n < 2; ++n) _Pragma("unroll") for (int k = 0; k < 2; ++k) \
        acc[ai][bj][m][n] = __builtin_amdgcn_mfma_f32_16x16x32_bf16(Bt[n][k], At[m][k], acc[ai][bj][m][n], 0, 0, 0); __builtin_amdgcn_s_setprio(0); } while (0)
#define PG8_WAIT_V(n) asm volatile("s_waitcnt vmcnt(" #n ")" ::: "memory")
#define PG8_WAIT_L(n) asm volatile("s_waitcnt lgkmcnt(" #n ")" ::: "memory")
#define PG8_BAR __builtin_amdgcn_s_barrier()
#define PG8_SCHED __builtin_amdgcn_sched_barrier(0)
    Unit cur, nxt; int ui = 0;
    if (!S.next(0, cur)) return;
    f32x4 acc[2][2][4][2];
#pragma unroll
    for (int a = 0; a < 2; ++a)
#pragma unroll
        for (int b = 0; b < 2; ++b)
#pragma unroll
            for (int m = 0; m < 4; ++m)
#pragma unroll
                for (int n = 0; n < 2; ++n) acc[a][b][m][n] = (f32x4){0.f, 0.f, 0.f, 0.f};
    bf16x8 At[4][2], B0[2][2], B1[2][2];
    const char* cA = (const char*)(cur.sel ? g.A2 : g.A) + (size_t)cur.pm * tstepA; const char* cB = (const char*)(cur.sel ? g.Bt2 : g.Bt) + (size_t)cur.pn * tstep;
    if constexpr (Sched::GATHER) PG8_ROWOFF(vC, 0);
    S.a_ready(cur);
    if constexpr (SP2) {
        PG8_STAGE(PG8_SB(0, 0), cB, voffB); PG8_STAGE(PG8_SB(0, 1), cB + hstep, voffB); PG8_STAGE_A(PG8_SA(0, 0), cA, 0, false); PG8_STAGE_A(PG8_SA(0, 1), cA, 1, false);
        if (wr == 1) PG8_BAR;
        PG8_WAIT_V(2); PG8_BAR;
        PG8_STAGE(PG8_SB(1, 0), cB + kstep, voffB); PG8_STAGE_A(PG8_SA(1, 0), cA + kstep, 0, false); PG8_STAGE(PG8_SB(1, 1), cB + hstep + kstep, voffB);
        PG8_WAIT_V(6); PG8_BAR;
    } else {
        PG8_STAGE(PG8_SB(0, 0), cB, voffB); PG8_STAGE(PG8_SA(0, 0), cA, voffA); PG8_STAGE(PG8_SB(0, 1), cB + hstep, voffB); PG8_STAGE(PG8_SA(0, 1), cA + hstep, voffA);
        if (wr == 1) PG8_BAR;
        PG8_WAIT_V(4); PG8_BAR;
        PG8_STAGE(PG8_SB(1, 0), cB + kstep, voffB); PG8_STAGE(PG8_SA(1, 0), cA + kstep, voffA); PG8_STAGE(PG8_SB(1, 1), cB + hstep + kstep, voffB);
        PG8_WAIT_V(6); PG8_BAR;
    }
    for (;;) {
        const bool has_next = S.next(ui + 1, nxt);
        if constexpr (Sched::GATHER) { if (has_next) PG8_ROWOFF(vN, ui + 1); else { vN[0][0] = vC[0][0]; vN[0][1] = vC[0][1]; vN[1][0] = vC[1][0]; vN[1][1] = vC[1][1]; } }
        const char* nA = has_next ? (const char*)(nxt.sel ? g.A2 : g.A) + (size_t)nxt.pm * tstepA : cA; const char* nB = has_next ? (const char*)(nxt.sel ? g.Bt2 : g.Bt) + (size_t)nxt.pn * tstep : cB;
        for (int t = 0; t < nt; t += 2) {
            const bool last = (t == nt - 2);
            const char* a1 = cA + (size_t)(t + 1) * kstep;
            const char* a2 = last ? nA : cA + (size_t)(t + 2) * kstep; const char* b2 = last ? nB : cB + (size_t)(t + 2) * kstep;
            const char* a3 = a2 + kstep; const char* b3 = b2 + kstep;
            if (last && has_next) S.a_ready(nxt);
            if constexpr (SP2) {
            PG8_LDB(B0, 0, 0); PG8_LDB(B1, 0, 1); PG8_SCHED; PG8_LDA(At, 0, 0); PG8_STAGE_A(PG8_SA(1, 1), a1, 1, false);
            PG8_WAIT_V(8); PG8_WAIT_L(0); PG8_BAR; PG8_MMA(0, 0, At, B0); PG8_MMA(0, 1, At, B1); PG8_BAR; PG8_SCHED;
            PG8_LDA(At, 0, 1); PG8_STAGE(PG8_SB(0, 0), b2, voffB); PG8_STAGE(PG8_SB(0, 1), b2 + hstep, voffB); PG8_STAGE_A(PG8_SA(0, 0), a2, 0, last);
            PG8_WAIT_V(8); PG8_WAIT_L(0); PG8_BAR; PG8_MMA(1, 0, At, B0); PG8_MMA(1, 1, At, B1); PG8_BAR; PG8_SCHED;
            PG8_LDB(B0, 1, 0); PG8_LDB(B1, 1, 1); PG8_SCHED; PG8_LDA(At, 1, 0); PG8_STAGE_A(PG8_SA(0, 1), a2, 1, last);
            PG8_WAIT_V(8); PG8_WAIT_L(0); PG8_BAR; PG8_MMA(0, 0, At, B0); PG8_MMA(0, 1, At, B1); PG8_BAR; PG8_SCHED;
            PG8_LDA(At, 1, 1); PG8_STAGE(PG8_SB(1, 0), b3, voffB); PG8_STAGE(PG8_SB(1, 1), b3 + hstep, voffB); PG8_STAGE_A(PG8_SA(1, 0), a3, 0, last);
            PG8_WAIT_V(8); PG8_WAIT_L(0); PG8_BAR; PG8_MMA(1, 0, At, B0); PG8_MMA(1, 1, At, B1); PG8_BAR; PG8_SCHED;
            } else {
            PG8_LDB(B0, 0, 0); PG8_SCHED; PG8_LDA(At, 0, 0); PG8_STAGE(PG8_SA(1, 1), a1 + hstep, voffA);
            PG8_WAIT_L(8); PG8_BAR; PG8_WAIT_L(0); PG8_MMA(0, 0, At, B0); PG8_BAR; PG8_SCHED;
            PG8_LDB(B1, 0, 1); PG8_STAGE(PG8_SB(0, 0), b2, voffB);
            PG8_BAR; PG8_WAIT_L(0); PG8_MMA(0, 1, At, B1); PG8_BAR;
            PG8_LDA(At, 0, 1); PG8_STAGE(PG8_SA(0, 0), a2, voffA);
            PG8_BAR; PG8_WAIT_L(0); PG8_MMA(1, 0, At, B0); PG8_BAR; PG8_SCHED;
            PG8_STAGE(PG8_SB(0, 1), b2 + hstep, voffB);
            PG8_WAIT_V(6); PG8_BAR; PG8_MMA(1, 1, At, B1); PG8_BAR;
            PG8_LDB(B0, 1, 0); PG8_SCHED; PG8_LDA(At, 1, 0); PG8_STAGE(PG8_SA(0, 1), a2 + hstep, voffA);
            PG8_WAIT_L(8); PG8_BAR; PG8_WAIT_L(0); PG8_MMA(0, 0, At, B0); PG8_BAR; PG8_SCHED;
            PG8_LDB(B1, 1, 1); PG8_STAGE(PG8_SB(1, 0), b3, voffB);
            PG8_BAR; PG8_WAIT_L(0); PG8_MMA(0, 1, At, B1); PG8_BAR;
            PG8_LDA(At, 1, 1); PG8_STAGE(PG8_SA(1, 0), a3, voffA);
            PG8_BAR; PG8_WAIT_L(0); PG8_MMA(1, 0, At, B0); PG8_BAR; PG8_SCHED;
            PG8_STAGE(PG8_SB(1, 1), b3 + hstep, voffB);
            PG8_WAIT_V(6); PG8_BAR; PG8_MMA(1, 1, At, B1); PG8_BAR;
            }
        }
        if constexpr (ALIGN_EPI) { if (wr == 0) PG8_BAR; }
        bool keep = false;
        if constexpr (!Epi::AFTER_DRAIN) { if constexpr (Epi::CHAIN) keep = E.chain(acc, cur, wr, wc, fr, fq); else E(acc, cur, wr, wc, fr, fq); S.done(cur); }
        if (!has_next) break;
        if (!keep) {
#pragma unroll
        for (int a = 0; a < 2; ++a)
#pragma unroll
            for (int b = 0; b < 2; ++b)
#pragma unroll
                for (int m = 0; m < 4; ++m)
#pragma unroll
                    for (int n = 0; n < 2; ++n) acc[a][b][m][n] = (f32x4){0.f, 0.f, 0.f, 0.f};
        }
        cur = nxt; cA = nA; cB = nB; ++ui; vC[0][0] = vN[0][0]; vC[0][1] = vN[0][1]; vC[1][0] = vN[1][0]; vC[1][1] = vN[1][1];
        if constexpr (ALIGN_EPI) { if (wr == 1) PG8_BAR; }
    }
    PG8_WAIT_V(0);
    if constexpr (!ALIGN_EPI) { if (wr == 0) PG8_BAR; }
    PG8_BAR;
    if constexpr (Epi::AFTER_DRAIN) { E.fused(acc, cur, wr, wc, fr, fq, lds, wid, lane); S.done(cur); }
#undef PG8_SA
#undef PG8_SB
#undef PG8_STAGE
#undef PG8_LDA
#undef PG8_LDB
#undef PG8_MMA
#undef PG8_WAIT_V
#undef PG8_WAIT_L
#undef PG8_BAR
#undef PG8_SCHED
#undef PG8_STAGE_A
#undef PG8_ROWOFF
}

}

constexpr int D = 2048, L = 16384, LC = 256, LT = L + LC;
constexpr int NP = 19712;
constexpr int PW = 19456;
constexpr int PC_Z = 0, PC_X = 2048, PC_B = 4096, PC_C = 4608, PC_Q = 5120, PC_FF = 7168, PC_FB = 9216, PC_I = 11264, PC_G = 13312, PC_GS = 15360, PC_GH = 17408, PC_DT = 19456;
constexpr int NEXP = 32, TOPK = 4, NASSIGN = L * TOPK, MAXBLK = 288, MAXSLOT = MAXBLK * 256;
constexpr float EPS = 1e-6f;
__device__ __forceinline__ size_t pidx(size_t t, int col) { return ((size_t)(col >> 7) * LT + t) * 128 + (size_t)(col & 127); }

constexpr size_t MiB = 1u << 20;
constexpr size_t WS_CTL = 0, CTL_ZERO_BYTES = 65536;
constexpr size_t WS_MOD = 1 * MiB;
constexpr size_t WS_WR2 = WS_MOD + 131072;
constexpr size_t WS_RSTD = WS_MOD + 524288;
constexpr size_t WS_WIN = 2 * MiB;
constexpr size_t WS_WBS = 80 * MiB, WS_WBH = 88 * MiB, WS_WO = 96 * MiB;
constexpr size_t WS_WGU = 104 * MiB;
constexpr size_t WS_WDN = 616 * MiB;
constexpr size_t WS_HN = 872 * MiB;
constexpr size_t WS_PROJ = 937 * MiB;
constexpr size_t WS_DTRAW = 1555 * MiB;
constexpr size_t WS_XS = 1560 * MiB;
constexpr size_t WS_BN = 1625 * MiB, WS_CN = 1642 * MiB;
constexpr size_t WS_DTV = 1659 * MiB;
constexpr size_t WS_XT = 1664 * MiB;
constexpr size_t WS_BT = 1729 * MiB;
constexpr size_t WS_YF = 1746 * MiB, WS_YB = 1874 * MiB, WS_OF = 2002 * MiB, WS_OB = 2130 * MiB;
constexpr size_t WS_ACS = 1746 * MiB;
constexpr size_t WS_SST = 1751 * MiB;
constexpr size_t WS_HST = 1881 * MiB;
constexpr size_t WS_BETA = 2011 * MiB;
constexpr size_t WS_DEC = 2028 * MiB;
constexpr size_t WS_VT = 2031 * MiB;
constexpr size_t WS_QT = 2096 * MiB;
constexpr size_t WS_Y2 = 2258 * MiB;
constexpr size_t WS_PART = 2386 * MiB;
constexpr size_t WS_YM = 2514 * MiB;
constexpr size_t WS_H1 = 2578 * MiB;
constexpr size_t WS_HN2 = 2706 * MiB;
constexpr size_t WS_ROUTE = 2770 * MiB;
constexpr size_t WS_XG = 2772 * MiB, WS_ACT = 3060 * MiB, WS_Y2M = 3348 * MiB;
constexpr size_t WS_KD = 3636 * MiB;
constexpr size_t WS_KHT = 3766 * MiB;
constexpr size_t WS_SSTI = 3896 * MiB;
constexpr size_t WS_HSTI0 = WS_XS, WS_HSTI1 = 4024 * MiB;
constexpr size_t WS_END = 4088 * MiB;
static_assert(WS_WIN + (size_t)NP * D * 2 <= WS_WBS && WS_PROJ + (size_t)LT * PW * 2 <= WS_DTRAW && WS_DTRAW + (size_t)LT * 64 * 4 <= WS_XS && WS_BN + (size_t)LT * 512 * 2 <= WS_CN &&
              WS_CN + (size_t)LT * 512 * 2 <= WS_DTV && WS_DTV + (size_t)LT * 64 * 4 <= WS_XT && WS_BT + (size_t)LT * 512 * 2 <= WS_YF && WS_XG + (size_t)MAXSLOT * D * 2 <= WS_ACT, "d_ws map");
constexpr int CW_BAR = 4096;
constexpr int CW_GCNT = 8192;

constexpr int RING_BYTES = 131072;
constexpr int MISC_OFF = RING_BYTES;
constexpr int LDS_BYTES = 163840;
constexpr int ROWTAB_UNITS = (LDS_BYTES - RING_BYTES - 4096) / 1024;
constexpr int CONV_SCR_OFF = RING_BYTES + 4096;
constexpr int NWAVES = 8;

#define LDS_WAIT() asm volatile("s_waitcnt lgkmcnt(0)" ::: "memory")
#define VM_WAIT() asm volatile("s_waitcnt vmcnt(0)" ::: "memory")
__device__ __forceinline__ unsigned f2bf(float f) { unsigned u = __float_as_uint(f); return (u + 0x7fffu + ((u >> 16) & 1u)) >> 16; }
__device__ __forceinline__ unsigned pk2(float lo, float hi) { return f2bf(lo) | (f2bf(hi) << 16); }
__device__ __forceinline__ float bflo(unsigned w) { return __uint_as_float(w << 16); }
__device__ __forceinline__ float bfhi(unsigned w) { return __uint_as_float(w & 0xffff0000u); }
__device__ __forceinline__ float bf1(bf16 h) { return __uint_as_float(((unsigned)h) << 16); }
__device__ __forceinline__ float sigm(float x) { return __builtin_amdgcn_rcpf(1.f + __expf(-x)); }
__device__ __forceinline__ float silu(float x) { return x * __builtin_amdgcn_rcpf(1.f + __expf(-x)); }
__device__ __forceinline__ float wave_sum(float v) {
#pragma unroll
    for (int o = 1; o < 64; o <<= 1) v += __shfl_xor(v, o);
    return v;
}

#define XB_TMO      128
#define XB_XCNT(j)  (256  + 64 * (j))
#define XB_XSUB(j)  (1280 + 64 * (j))
#define XB_XGEN(j)  (2304 + 64 * (j))
#define XB_TOP      3328
#define XB_TOPGEN   3392
#define XCD_BAR_WORDS 3456
#define XB_SPIN_CAP (1u << 18)

__device__ __forceinline__ unsigned xb_ld(unsigned* p)              { return __hip_atomic_load(p, __ATOMIC_RELAXED, __HIP_MEMORY_SCOPE_AGENT); }
__device__ __forceinline__ unsigned xb_add(unsigned* p, unsigned v) { return __hip_atomic_fetch_add(p, v, __ATOMIC_RELAXED, __HIP_MEMORY_SCOPE_AGENT); }
__device__ __forceinline__ unsigned xb_xcc_id() { return (unsigned)__builtin_amdgcn_s_getreg((3 << 11) | 20) & 0xFu; }
#define XB_SPIN(cond, bar) do { unsigned _sp = 0; while (cond) { __builtin_amdgcn_s_sleep(1); \
    if ((++_sp & 255u) == 0u) { if (xb_ld(&(bar)[XB_TMO])) break; if (_sp > XB_SPIN_CAP) { atomicAdd(&(bar)[XB_TMO], 1u); break; } } } } while (0)

struct XcdBarrier {
    unsigned* bar; unsigned x;
    volatile LAS unsigned* st;
};

__device__ __forceinline__ XcdBarrier xcd_barrier_post(unsigned* bar, volatile LAS unsigned* st) {
    XcdBarrier b; b.bar = bar; b.x = xb_xcc_id(); b.st = st;
    if (threadIdx.x == 0) (void)xb_add(&bar[XB_XCNT(b.x)], 1u);
    return b;
}
__device__ __forceinline__ void xcd_barrier_complete(unsigned* bar, unsigned x, unsigned& nloc, unsigned& nx) {
    const unsigned G = gridDim.x * gridDim.y * gridDim.z;
    unsigned sum, cnt, mine, sp = 0u;
    for (;;) {
        sum = 0u; cnt = 0u; mine = 0u;
#pragma unroll
        for (unsigned j = 0; j < 16; ++j) { const unsigned c = xb_ld(&bar[XB_XCNT(j)]); sum += c; cnt += (c > 0u) ? 1u : 0u; mine = (j == x) ? c : mine; }
        if (sum == G) break;
        __builtin_amdgcn_s_sleep(1);
        if ((++sp & 255u) == 0u) { if (xb_ld(&bar[XB_TMO])) break; if (sp > XB_SPIN_CAP) { atomicAdd(&bar[XB_TMO], 1u); break; } }
    }
    nloc = mine > 0u ? mine : 1u; nx = cnt > 0u ? cnt : 1u;
}

__device__ __forceinline__ void xcd_barrier(const XcdBarrier& b) {
    asm volatile("s_waitcnt vmcnt(0)" ::: "memory");
    __syncthreads();
    if (threadIdx.x == 0) {
        unsigned* bar = b.bar;
        __builtin_amdgcn_s_waitcnt(0);
        unsigned nloc = b.st[0], nx = b.st[1];
        if (nloc == 0u) { xcd_barrier_complete(bar, b.x, nloc, nx); b.st[0] = nloc; b.st[1] = nx; }
        const unsigned old = xb_add(&bar[XB_XSUB(b.x)], 1u);
        const unsigned gen = old / nloc;
        if (old + 1u == (gen + 1u) * nloc) {
            __builtin_amdgcn_fence(__ATOMIC_RELEASE, "agent");
            asm volatile("s_waitcnt vmcnt(0)" ::: "memory");
            const unsigned og = xb_add(&bar[XB_TOP], 1u);
            const unsigned tg = og / nx;
            if (og + 1u == (tg + 1u) * nx) xb_add(&bar[XB_TOPGEN], 1u);
            else XB_SPIN(xb_ld(&bar[XB_TOPGEN]) == tg, bar);
            __builtin_amdgcn_fence(__ATOMIC_ACQUIRE, "agent");
            xb_add(&bar[XB_XGEN(b.x)], 1u);
            asm volatile("s_waitcnt vmcnt(0)" ::: "memory");
        } else {
            XB_SPIN(xb_ld(&bar[XB_XGEN(b.x)]) == gen, bar);
            __builtin_amdgcn_fence(__ATOMIC_ACQUIRE, "agent");
            asm volatile("s_waitcnt vmcnt(0)" ::: "memory");
        }
    }
    __syncthreads();
}

using pg8::Unit; using pg8::cvt_pk_bf16;
struct EpiProj {
    static constexpr bool PERM = true, AFTER_DRAIN = false, CHAIN = false;
    bf16* P; float* dtraw;
    __device__ __forceinline__ void operator()(const f32x4 (&acc)[2][2][4][2], const Unit& u, int wr, int wc, int fr, int fq) const {
        const int row0 = u.pm * 256 + wr * 64 + fr;
        if (u.pn < PW / 256) {
            const int col0 = u.pn * 256 + wc * 32 + 8 * fq; const bool si = u.pn >= PC_I / 256 && u.pn < (PC_I + 2048) / 256;
#pragma unroll
            for (int ai = 0; ai < 2; ++ai)
#pragma unroll
                for (int m = 0; m < 4; ++m) { bf16* rowp = P + pidx((size_t)(row0 + ai * 128 + m * 16), col0);
#pragma unroll
                    for (int bj = 0; bj < 2; ++bj) { f32x4 v0 = acc[ai][bj][m][0], v1 = acc[ai][bj][m][1];
                        if (si) {
#pragma unroll
                            for (int e_ = 0; e_ < 4; ++e_) { v0[e_] = silu(v0[e_]); v1[e_] = silu(v1[e_]); } }
                        v4u w; w.x = cvt_pk_bf16(v0[0], v0[1]); w.y = cvt_pk_bf16(v0[2], v0[3]); w.z = cvt_pk_bf16(v1[0], v1[1]); w.w = cvt_pk_bf16(v1[2], v1[3]);
                        *(v4u*)(rowp + (size_t)bj * LT * 128) = w; } }
        } else if (wc < 2) {
#pragma unroll
            for (int ai = 0; ai < 2; ++ai)
#pragma unroll
                for (int m = 0; m < 4; ++m) { float* rp = dtraw + (size_t)(row0 + ai * 128 + m * 16) * 64 + wc * 32 + 8 * fq;
                    *(f32x4*)rp = acc[ai][0][m][0]; *(f32x4*)(rp + 4) = acc[ai][0][m][1]; }
        }
    }
};
struct EpiBranch {
    static constexpr bool PERM = true, AFTER_DRAIN = false, CHAIN = true;
    const bf16* P; bf16* ym;
    __device__ __forceinline__ bool chain(f32x4 (&acc)[2][2][4][2], const Unit& u, int wr, int wc, int fr, int fq) const { if (u.sel == 0) { mid(acc, u, wr, wc, fr, fq); return true; } fin(acc, u, wr, wc, fr, fq); return false; }
    __device__ __forceinline__ void mid(f32x4 (&acc)[2][2][4][2], const Unit& u, int wr, int wc, int fr, int fq) const {
        const int row0 = u.pm * 256 + wr * 64 + fr, col0 = u.pn * 256 + wc * 32 + 8 * fq;
#pragma unroll
        for (int ai = 0; ai < 2; ++ai) { v4u gs[4][2], gh[4][2];
#pragma unroll
            for (int m = 0; m < 4; ++m)
#pragma unroll
                for (int bj = 0; bj < 2; ++bj) { const size_t r = (size_t)(row0 + ai * 128 + m * 16); gs[m][bj] = *(const v4u*)(P + pidx(r, PC_GS + col0 + bj * 128)); gh[m][bj] = *(const v4u*)(P + pidx(r, PC_GH + col0 + bj * 128)); }
#pragma unroll
            for (int m = 0; m < 4; ++m)
#pragma unroll
                for (int bj = 0; bj < 2; ++bj) { const unsigned gsw[4] = {gs[m][bj].x, gs[m][bj].y, gs[m][bj].z, gs[m][bj].w}, ghw[4] = {gh[m][bj].x, gh[m][bj].y, gh[m][bj].z, gh[m][bj].w};
#pragma unroll
                    for (int q = 0; q < 4; ++q) { const float r0 = (1.f + __expf(-bflo(ghw[q]))) * __builtin_amdgcn_rcpf(1.f + __expf(-bflo(gsw[q]))), r1 = (1.f + __expf(-bfhi(ghw[q]))) * __builtin_amdgcn_rcpf(1.f + __expf(-bfhi(gsw[q])));
                        acc[ai][bj][m][q >> 1][2 * (q & 1)] *= r0; acc[ai][bj][m][q >> 1][2 * (q & 1) + 1] *= r1; } }
            asm volatile("" ::: "memory"); }
    }
    __device__ __forceinline__ void fin(const f32x4 (&acc)[2][2][4][2], const Unit& u, int wr, int wc, int fr, int fq) const {
        const int row0 = u.pm * 256 + wr * 64 + fr, col0 = u.pn * 256 + wc * 32 + 8 * fq;
#pragma unroll
        for (int ai = 0; ai < 2; ++ai) { v4u gh[4][2];
#pragma unroll
            for (int m = 0; m < 4; ++m)
#pragma unroll
                for (int bj = 0; bj < 2; ++bj) gh[m][bj] = *(const v4u*)(P + pidx((size_t)(row0 + ai * 128 + m * 16), PC_GH + col0 + bj * 128));
#pragma unroll
            for (int m = 0; m < 4; ++m) { const size_t r = (size_t)(row0 + ai * 128 + m * 16);
#pragma unroll
                for (int bj = 0; bj < 2; ++bj) { const int c = col0 + bj * 128; const v4u g = gh[m][bj];
                    f32x4 v0 = acc[ai][bj][m][0], v1 = acc[ai][bj][m][1];
                    v0[0] *= sigm(bflo(g.x)); v0[1] *= sigm(bfhi(g.x)); v0[2] *= sigm(bflo(g.y)); v0[3] *= sigm(bfhi(g.y));
                    v1[0] *= sigm(bflo(g.z)); v1[1] *= sigm(bfhi(g.z)); v1[2] *= sigm(bflo(g.w)); v1[3] *= sigm(bfhi(g.w));
                    v4u w; w.x = cvt_pk_bf16(v0[0], v0[1]); w.y = cvt_pk_bf16(v0[2], v0[3]); w.z = cvt_pk_bf16(v1[0], v1[1]); w.w = cvt_pk_bf16(v1[2], v1[3]);
                    *(v4u*)(ym + r * D + c) = w; } }
            asm volatile("" ::: "memory"); }
    }
};
struct EpiOut {
    static constexpr bool PERM = true, AFTER_DRAIN = false, CHAIN = false;
    const float* x; const float* g1; bf16* h1;
    __device__ __forceinline__ void operator()(const f32x4 (&acc)[2][2][4][2], const Unit& u, int wr, int wc, int fr, int fq) const {
        const int row0 = u.pm * 256 + wr * 64 + fr, col0 = u.pn * 256 + wc * 32 + 8 * fq;
        f32x4 gv[2][2];
#pragma unroll
        for (int bj = 0; bj < 2; ++bj) { gv[bj][0] = *(const f32x4*)(g1 + col0 + bj * 128); gv[bj][1] = *(const f32x4*)(g1 + col0 + bj * 128 + 4); }
#pragma unroll
        for (int ai = 0; ai < 2; ++ai) { f32x4 xv[4][2][2];
#pragma unroll
            for (int m = 0; m < 4; ++m)
#pragma unroll
                for (int bj = 0; bj < 2; ++bj) { const float* xp = x + (size_t)(row0 + ai * 128 + m * 16) * D + col0 + bj * 128; xv[m][bj][0] = *(const f32x4*)xp; xv[m][bj][1] = *(const f32x4*)(xp + 4); }
#pragma unroll
            for (int m = 0; m < 4; ++m) { const size_t r = (size_t)(row0 + ai * 128 + m * 16);
#pragma unroll
                for (int bj = 0; bj < 2; ++bj) { const int c = col0 + bj * 128;
                    const f32x4 o0 = xv[m][bj][0] + gv[bj][0] * acc[ai][bj][m][0], o1 = xv[m][bj][1] + gv[bj][1] * acc[ai][bj][m][1];
                    v4u w; w.x = cvt_pk_bf16(o0[0], o0[1]); w.y = cvt_pk_bf16(o0[2], o0[3]); w.z = cvt_pk_bf16(o1[0], o1[1]); w.w = cvt_pk_bf16(o1[2], o1[3]);
                    *(v4u*)(h1 + r * D + c) = w; } }
            asm volatile("" ::: "memory"); }
    }
};
struct EpiMoe1 {
    static constexpr bool PERM = true, AFTER_DRAIN = false, CHAIN = false;
    const float* bgu; bf16* act;
    __device__ __forceinline__ void operator()(const f32x4 (&acc)[2][2][4][2], const Unit& u, int wr, int wc, int fr, int fq) const {
        const int e = u.pn >> 4, j = u.pn & 15, row0 = u.pm * 256 + wr * 64 + fr, gcol = 128 * j + wc * 32 + 8 * fq;
        const float* bb = bgu + (size_t)e * 4096 + gcol;
        f32x4 bg[2], bu[2];
        bg[0] = *(const f32x4*)bb; bg[1] = *(const f32x4*)(bb + 4); bu[0] = *(const f32x4*)(bb + 2048); bu[1] = *(const f32x4*)(bb + 2052);
#pragma unroll
        for (int ai = 0; ai < 2; ++ai)
#pragma unroll
            for (int m = 0; m < 4; ++m) { const size_t r = (size_t)(row0 + ai * 128 + m * 16); float o[8];
#pragma unroll
                for (int n = 0; n < 2; ++n)
#pragma unroll
                    for (int i = 0; i < 4; ++i) { float gt = acc[ai][0][m][n][i] + bg[n][i], up = acc[ai][1][m][n][i] + bu[n][i];
                        gt = fminf(gt, 7.0f); up = fminf(fmaxf(up, -7.0f), 7.0f);
                        const float glu = gt * sigm(1.702f * gt); o[4 * n + i] = (up + 1.0f) * glu; }
                v4u w; w.x = cvt_pk_bf16(o[0], o[1]); w.y = cvt_pk_bf16(o[2], o[3]); w.z = cvt_pk_bf16(o[4], o[5]); w.w = cvt_pk_bf16(o[6], o[7]);
                *(v4u*)(act + r * D + gcol) = w; }
    }
};
struct EpiMoe2 {
    static constexpr bool PERM = true, AFTER_DRAIN = false, CHAIN = false;
    const float* bdn; const float* rowp; bf16* y2m;
    __device__ __forceinline__ void operator()(const f32x4 (&acc)[2][2][4][2], const Unit& u, int wr, int wc, int fr, int fq) const {
        const int e = u.pn >> 3, j = u.pn & 7, row0 = u.pm * 256 + wr * 64 + fr, col0 = 256 * j + wc * 32 + 8 * fq;
        f32x4 bv[2][2];
#pragma unroll
        for (int bj = 0; bj < 2; ++bj) { bv[bj][0] = *(const f32x4*)(bdn + (size_t)e * D + col0 + bj * 128); bv[bj][1] = *(const f32x4*)(bdn + (size_t)e * D + col0 + bj * 128 + 4); }
        float pv[2][4];
#pragma unroll
        for (int ai = 0; ai < 2; ++ai)
#pragma unroll
            for (int m = 0; m < 4; ++m) pv[ai][m] = rowp[row0 + ai * 128 + m * 16];
#pragma unroll
        for (int ai = 0; ai < 2; ++ai)
#pragma unroll
            for (int m = 0; m < 4; ++m) { const size_t r = (size_t)(row0 + ai * 128 + m * 16); const float p = pv[ai][m];
#pragma unroll
                for (int bj = 0; bj < 2; ++bj) { const f32x4 v0 = (acc[ai][bj][m][0] + bv[bj][0]) * p, v1 = (acc[ai][bj][m][1] + bv[bj][1]) * p;
                    v4u w; w.x = cvt_pk_bf16(v0[0], v0[1]); w.y = cvt_pk_bf16(v0[2], v0[3]); w.z = cvt_pk_bf16(v1[0], v1[1]); w.w = cvt_pk_bf16(v1[2], v1[3]);
                    *(v4u*)(y2m + r * D + col0 + bj * 128) = w; } }
    }
};

struct Ctx {
    LAS unsigned char* lds; int tid, lane, wave, G, bid;
};

struct TrDesc { const float* src; bf16* dst; int ldsrc, k0, srccol0, K, dstrow0; };
__device__ __forceinline__ TrDesc tr_decode(int it, const float* const* in, unsigned char* ws) {
    constexpr int I_IN = 32 * (NP / 32), I_SQ = 32 * 64, I_GU = 32 * 128, I_DN = 32 * 64;
    TrDesc t; int r = it;
    if (r < I_IN) { const int nblk = NP / 32, kb = r / nblk, nb = r % nblk, n0 = 32 * nb;
        t.srccol0 = n0 < 5120 ? n0 : (n0 < PC_DT ? n0 + 64 : (n0 < PC_DT + 64 ? n0 - PC_DT + 5120 : -1));
        t.src = in[8]; t.ldsrc = 19520; t.k0 = 64 * kb; t.dst = (bf16*)(ws + WS_WIN); t.K = D; t.dstrow0 = n0; return t; } r -= I_IN;
    if (r < 3 * I_SQ) { const int w = r / I_SQ, rr = r % I_SQ, kb = rr / 64, nb = rr % 64;
        t.src = in[17 + w]; t.ldsrc = D; t.k0 = 64 * kb; t.srccol0 = 32 * nb; t.dst = (bf16*)(ws + (w == 0 ? WS_WBS : (w == 1 ? WS_WBH : WS_WO))); t.K = D; t.dstrow0 = 32 * nb; return t; } r -= 3 * I_SQ;
    if (r < NEXP * I_GU) { const int e = r / I_GU, rr = r % I_GU, kb = rr / 128, nb = rr % 128, n0 = 32 * nb, j = n0 >> 8, q = n0 & 255;
        t.srccol0 = q < 128 ? 128 * j + q : 2048 + 128 * j + (q - 128);
        t.src = in[22] + (size_t)e * D * 4096; t.ldsrc = 4096; t.k0 = 64 * kb; t.dst = (bf16*)(ws + WS_WGU); t.K = D; t.dstrow0 = e * 4096 + n0; return t; } r -= NEXP * I_GU;
    { const int e = r / I_DN, rr = r % I_DN, kb = rr / 64, nb = rr % 64;
        t.src = in[24] + (size_t)e * D * D; t.ldsrc = D; t.k0 = 64 * kb; t.srccol0 = 32 * nb; t.dst = (bf16*)(ws + WS_WDN); t.K = D; t.dstrow0 = e * D + 32 * nb; return t; }
}
__device__ __forceinline__ void tr_load(const TrDesc& t, f32x4 (&v)[8], int lane) {
    if (t.srccol0 >= 0) {
#pragma unroll
        for (int j = 0; j < 8; ++j) v[j] = *(const f32x4*)(t.src + (size_t)(t.k0 + 16 * (j >> 1) + 2 * (lane >> 3) + (j & 1)) * t.ldsrc + t.srccol0 + 4 * (lane & 7));
    } else {
#pragma unroll
        for (int j = 0; j < 8; ++j) v[j] = (f32x4){0.f, 0.f, 0.f, 0.f};
    }
}
__device__ __forceinline__ void tr_store(const TrDesc& t, const f32x4 (&v)[8], LAS bf16* scr, int lane) {
    const int kr = lane >> 3, n4 = lane & 7;
#pragma unroll
    for (int hf = 0; hf < 2; ++hf) {
#pragma unroll
        for (int m = 0; m < 2; ++m) { const f32x4 x0 = v[4 * hf + 2 * m], x1 = v[4 * hf + 2 * m + 1]; LAS unsigned* s32 = (LAS unsigned*)scr;
#pragma unroll
            for (int c = 0; c < 4; ++c) s32[(4 * n4 + c) * 20 + 8 * m + kr] = pg8::cvt_pk_bf16(x0[c], x1[c]); }
        LDS_WAIT(); asm volatile("" ::: "memory");
        const int n = lane >> 2, q = lane & 3;
        const v4u a = *(const LAS v4u*)(scr + n * 40 + q * 8), b = *(const LAS v4u*)(scr + (16 + n) * 40 + q * 8);
        bf16* dp = t.dst + (size_t)(t.dstrow0 + n) * t.K + t.k0 + 32 * hf + 8 * q;
        *(v4u*)dp = a; *(v4u*)(dp + (size_t)16 * t.K) = b;
        LDS_WAIT(); asm volatile("" ::: "memory");
    }
}
constexpr int TR_I_HEAD = 32 * (NP / 32) + 3 * 32 * 64;
constexpr int TR_I_ALL = TR_I_HEAD + NEXP * 32 * 128 + NEXP * 32 * 64;
__device__ __forceinline__ int tr_run(int first, int stride, int last, const float* const* in, unsigned char* ws, LAS bf16* scr, int lane) {
    int i0 = first, i1 = first + stride, i2 = first + 2 * stride; TrDesc d0, d1, d2; f32x4 a[8], b[8], c[8];
    d0 = tr_decode(i0 < last ? i0 : first, in, ws); d1 = d0; d2 = d0;
    if (i0 < last) tr_load(d0, a, lane);
    if (i1 < last) { d1 = tr_decode(i1, in, ws); tr_load(d1, b, lane); }
    if (i2 < last) { d2 = tr_decode(i2, in, ws); tr_load(d2, c, lane); }
#pragma unroll 1
    while (i0 < last) {
        tr_store(d0, a, scr, lane); i0 += 3 * stride; if (i0 < last) { d0 = tr_decode(i0, in, ws); tr_load(d0, a, lane); }
        if (i1 < last) { tr_store(d1, b, scr, lane); i1 += 3 * stride; if (i1 < last) { d1 = tr_decode(i1, in, ws); tr_load(d1, b, lane); } }
        if (i2 < last) { tr_store(d2, c, scr, lane); i2 += 3 * stride; if (i2 < last) { d2 = tr_decode(i2, in, ws); tr_load(d2, c, lane); } }
    }
    return i0;
}
struct ConvOrder : pg8::StaticOrder {
    const float* const* in; unsigned char* ws; LAS bf16* scr; int lane, stride; mutable int cursor;
    __device__ __forceinline__ void done(const pg8::Unit&) const {
        constexpr int IPU = 6;
        if (cursor >= TR_I_ALL) return;
        const int last = cursor + IPU * stride < TR_I_ALL ? cursor + IPU * stride : TR_I_ALL;
        (void)tr_run(cursor, stride, last, in, ws, scr, lane); cursor += IPU * stride;
        asm volatile("s_waitcnt vmcnt(0)" ::: "memory");
    }
};

__device__ __forceinline__ void p0_prologue(const Ctx& F, const float* const* in, unsigned char* ws) {
    {
        const float* cvec = in[1]; const float* cctx = in[3]; const float* w_ada = in[4]; const float* b_ada = in[5];
        float* mod = (float*)(ws + WS_MOD); float* modc = mod + 12288;
        LAS float* s1 = (LAS float*)F.lds; LAS float* s2 = s1 + 2048; LAS float* red = s2 + 2048;
        for (int k = F.tid; k < 2048; k += 512) { s1[k] = silu(cvec[k]); s2[k] = silu(cctx[k]); }
        __syncthreads();
        for (int cg = F.bid; cg < 256; cg += F.G) {
            const int q = F.tid % 12, kg = F.tid / 12;
            f32x4 a1 = {0.f, 0.f, 0.f, 0.f}, a2 = {0.f, 0.f, 0.f, 0.f};
            if (kg < 42) for (int k = kg; k < 2048; k += 42) { const f32x4 w = *(const f32x4*)(w_ada + (size_t)k * 12288 + cg * 48 + 4 * q); a1 += w * s1[k]; a2 += w * s2[k]; }
            if (kg < 42) {
#pragma unroll
                for (int i = 0; i < 4; ++i) { red[(0 * 42 + kg) * 48 + 4 * q + i] = a1[i]; red[(1 * 42 + kg) * 48 + 4 * q + i] = a2[i]; } }
            __syncthreads();
            if (F.tid < 96) { const int which = F.tid / 48, col = F.tid % 48; float s = 0.f; for (int g = 0; g < 42; ++g) s += red[(which * 42 + g) * 48 + col];
                s += b_ada[cg * 48 + col]; (which ? modc : mod)[cg * 48 + col] = s; }
            __syncthreads();
        }
    }
    LAS bf16* scr = (LAS bf16*)(F.lds + 40960 + F.wave * 2560);
    const int gw = F.bid * NWAVES + F.wave, NGW = F.G * NWAVES;
    constexpr int NITEMS = TR_I_HEAD;
    (void)tr_run(gw, NGW, NITEMS, in, ws, scr, F.lane);
}

__device__ __forceinline__ void p1_rows(const Ctx& F, const float* src0, const float* sh, const float* sc, const float* w1, bf16* hn0, int nrows) {
    const int gw = F.bid * NWAVES + F.wave, NGW = F.G * NWAVES;
    if (gw >= nrows) return;
    f32x4 sv[4][2], hv[4][2];
#pragma unroll
    for (int j = 0; j < 4; ++j)
#pragma unroll
        for (int q = 0; q < 2; ++q) { const int col = 8 * F.lane + 512 * j + 4 * q; sv[j][q] = *(const f32x4*)(w1 + col) * (*(const f32x4*)(sc + col) + 1.0f); hv[j][q] = *(const f32x4*)(sh + col); }
    for (int row = gw; row < nrows; row += NGW) {
        const float* src = src0 + (size_t)row * D; f32x4 v[4][2]; float ss = 0.f;
#pragma unroll
        for (int j = 0; j < 4; ++j)
#pragma unroll
            for (int q = 0; q < 2; ++q) { v[j][q] = *(const f32x4*)(src + 8 * F.lane + 512 * j + 4 * q); ss += (v[j][q][0] * v[j][q][0] + v[j][q][1] * v[j][q][1]) + (v[j][q][2] * v[j][q][2] + v[j][q][3] * v[j][q][3]); }
        const float rstd = 1.0f / sqrtf(wave_sum(ss) * (1.0f / D) + EPS);
#pragma unroll
        for (int j = 0; j < 4; ++j) { const f32x4 o0 = v[j][0] * rstd * sv[j][0] + hv[j][0], o1 = v[j][1] * rstd * sv[j][1] + hv[j][1];
            v4u pk; pk.x = pg8::cvt_pk_bf16(o0[0], o0[1]); pk.y = pg8::cvt_pk_bf16(o0[2], o0[3]); pk.z = pg8::cvt_pk_bf16(o1[0], o1[1]); pk.w = pg8::cvt_pk_bf16(o1[2], o1[3]);
            *(v4u*)(hn0 + (size_t)row * D + 8 * F.lane + 512 * j) = pk; }
    }
}
__device__ __forceinline__ void p1_norm(const Ctx& F, const float* const* in, unsigned char* ws) {
    const float* mod = (const float*)(ws + WS_MOD); const float* modc = mod + 12288; bf16* hn = (bf16*)(ws + WS_HN);
    p1_rows(F, in[0], mod, mod + 2048, in[6], hn, L);
    p1_rows(F, in[2], modc, modc + 2048, in[6], hn + (size_t)L * D, LC);
}

__device__ __forceinline__ void p1_router_fold(const Ctx& F, const float* const* in, unsigned char* ws) {
    const float* mod = (const float*)(ws + WS_MOD); const float* sh2 = mod + 6144; const float* sc2 = mod + 8192; const float* w2 = in[7]; const float* wr = in[20];
    f32x4* W2 = (f32x4*)(ws + WS_WR2); float* cvec = (float*)(ws + WS_WR2 + 262144);
    for (int u = F.bid * 512 + F.tid; u < 16384; u += F.G * 512) { const int e = u & 31, hf = (u >> 5) & 1, kq = (u >> 6) & 3, j = u >> 8; f32x4 o;
#pragma unroll
        for (int i = 0; i < 4; ++i) { const int k = 32 * j + 8 * kq + 4 * hf + i; o[i] = w2[k] * (1.0f + sc2[k]) * wr[k * 32 + e]; }
        W2[u] = o; }
    { const int e = F.bid * NWAVES + F.wave;
      if (e < NEXP) { float s = 0.f;
#pragma unroll 8
          for (int j = 0; j < 32; ++j) { const int k = F.lane + 64 * j; s += sh2[k] * wr[k * 32 + e]; }
          s = wave_sum(s); if (F.lane == 0) cvec[e] = s + in[21][e]; } }
}

__device__ __forceinline__ void p3_prep(const Ctx& F, const float* const* in, unsigned char* ws) {
    const bf16* P = (const bf16*)(ws + WS_PROJ); const float* cw = in[9]; const float* cb = in[10];
    bf16* XS = (bf16*)(ws + WS_XS); bf16* BN = (bf16*)(ws + WS_BN); bf16* CN = (bf16*)(ws + WS_CN);
    constexpr int NT = LT / 64, NS = 24, NCONV = NT * NS;
    for (int it = F.bid; it < NCONV + NT; it += F.G) {
        if (it < NCONV) {
            const int tt = it / NS, sb = it % NS, tl = F.tid >> 3, cg = F.tid & 7, t = tt * 64 + tl, ch0 = sb * 128 + cg * 16;
            const int r0 = t < L ? tt * 64 : L, r1 = t < L ? tt * 64 + 64 : LT;
            float a[16];
#pragma unroll
            for (int i = 0; i < 16; i += 4) { const f32x4 b = *(const f32x4*)(cb + ch0 + i); a[i] = b[0]; a[i + 1] = b[1]; a[i + 2] = b[2]; a[i + 3] = b[3]; }
#pragma unroll
            for (int k = 0; k < 4; ++k) { const int ts = t + k - 2;
                if (ts >= r0 && ts < r1) { const v4u u0 = *(const v4u*)(P + pidx((size_t)ts, PC_X + ch0)), u1 = *(const v4u*)(P + pidx((size_t)ts, PC_X + ch0 + 8));
                    const unsigned uu[8] = {u0.x, u0.y, u0.z, u0.w, u1.x, u1.y, u1.z, u1.w};
#pragma unroll
                    for (int i = 0; i < 8; ++i) { const float w0 = cw[k * 3072 + ch0 + 2 * i], w1 = cw[k * 3072 + ch0 + 2 * i + 1]; a[2 * i] += w0 * bflo(uu[i]); a[2 * i + 1] += w1 * bfhi(uu[i]); } } }
            v4u o0, o1;
            o0.x = pk2(silu(a[0]), silu(a[1])); o0.y = pk2(silu(a[2]), silu(a[3])); o0.z = pk2(silu(a[4]), silu(a[5])); o0.w = pk2(silu(a[6]), silu(a[7]));
            o1.x = pk2(silu(a[8]), silu(a[9])); o1.y = pk2(silu(a[10]), silu(a[11])); o1.z = pk2(silu(a[12]), silu(a[13])); o1.w = pk2(silu(a[14]), silu(a[15]));
            bf16* dst = ch0 < 2048 ? XS + (size_t)t * 2048 + ch0 : (ch0 < 2560 ? BN + (size_t)t * 512 + (ch0 - 2048) : CN + (size_t)t * 512 + (ch0 - 2560));
            *(v4u*)dst = o0; *(v4u*)(dst + 8) = o1;
        } else {
            const int tt = it - NCONV, t = tt * 64 + (F.tid >> 3), dh0 = (F.tid & 7) * 8;
            const float* dr = (const float*)(ws + WS_DTRAW) + (size_t)t * 64 + dh0; float* dtv = (float*)(ws + WS_DTV);
#pragma unroll
            for (int i = 0; i < 8; ++i) { const float xx = dr[i] + in[11][dh0 + i]; const float sp = fmaxf(xx, 0.f) + log1pf(expf(-fabsf(xx))); dtv[(size_t)(dh0 + i) * LT + t] = sp; }
        }
    }
}

__device__ __forceinline__ void p4_ssd_naive(const Ctx& F, const float* const* in, unsigned char* ws) {
    const bf16* XS = (const bf16*)(ws + WS_XS); const bf16* BN = (const bf16*)(ws + WS_BN); const bf16* CN = (const bf16*)(ws + WS_CN); const float* DTV = (const float*)(ws + WS_DTV);
    for (int u = F.bid * 512 + F.tid; u < 131072; u += F.G * 512) {
        const int nq = u & 31, p = (u >> 5) & 63, h = (u >> 11) & 31, d = u >> 16, g = h >> 3;
        const float A = -expf(in[12][d * 32 + h]);
        float* Y = (float*)(ws + (d ? WS_YB : WS_YF));
        const float* dtp = DTV + (size_t)(d * 32 + h) * LT;
        float S0 = 0.f, S1 = 0.f, S2 = 0.f, S3 = 0.f;
        for (int i = 0; i < LT; ++i) {
            const int tok = d == 0 ? (i < LC ? L + i : i - LC) : (i < LC ? LT - 1 - i : L - 1 - (i - LC));
            const float dt = dtp[tok], dec = __expf(A * dt), xv = bf1(XS[(size_t)tok * 2048 + h * 64 + p]) * dt;
            const v2u bq = *(const v2u*)(BN + (size_t)tok * 512 + g * 128 + 4 * nq), cq = *(const v2u*)(CN + (size_t)tok * 512 + g * 128 + 4 * nq);
            S0 = S0 * dec + xv * bflo(bq.x); S1 = S1 * dec + xv * bfhi(bq.x); S2 = S2 * dec + xv * bflo(bq.y); S3 = S3 * dec + xv * bfhi(bq.y);
            float y = (bflo(cq.x) * S0 + bfhi(cq.x) * S1) + (bflo(cq.y) * S2 + bfhi(cq.y) * S3);
            y += __shfl_xor(y, 1); y += __shfl_xor(y, 2); y += __shfl_xor(y, 4); y += __shfl_xor(y, 8); y += __shfl_xor(y, 16);
            if (nq == 0 && tok < L) Y[(size_t)tok * 2048 + h * 64 + p] = y;
        }
    }
}
__device__ __forceinline__ void p5_hgrn_naive(const Ctx& F, const float* const* in, unsigned char* ws) {
    const bf16* P = (const bf16*)(ws + WS_PROJ);
    for (int u = F.bid * 512 + F.tid; u < 131072; u += F.G * 512) {
        const int kq = u & 31, v = (u >> 5) & 127, h = (u >> 12) & 15, d = u >> 16;
        float* O = (float*)(ws + (d ? WS_OB : WS_OF));
        float lb[4];
#pragma unroll
        for (int j = 0; j < 4; ++j) { const int k = h * 128 + 4 * kq + j; lb[j] = 1.0f / (1.0f + expf(in[15][(d * 2 + 1) * 2048 + k] - in[15][(d * 2 + 0) * 2048 + k])); }
        float S[4] = {0.f, 0.f, 0.f, 0.f};
        const int fcol = (d ? PC_FB : PC_FF) + h * 128 + 4 * kq, qcol = PC_Q + h * 128 + 4 * kq, icol = PC_I + h * 128 + v;
        for (int i = 0; i < LT; ++i) {
            const int tok = d == 0 ? (i < LC ? L + i : i - LC) : (i < LC ? LT - 1 - i : L - 1 - (i - LC));
            const v2u fq = *(const v2u*)(P + pidx((size_t)tok, fcol)), qq = *(const v2u*)(P + pidx((size_t)tok, qcol)); const float vv = silu(bf1(P[pidx((size_t)tok, icol)]));
            const float fr[4] = {bflo(fq.x), bfhi(fq.x), bflo(fq.y), bfhi(fq.y)}; const float qv[4] = {bflo(qq.x), bfhi(qq.x), bflo(qq.y), bfhi(qq.y)};
            float o = 0.f;
#pragma unroll
            for (int j = 0; j < 4; ++j) { const float kin = (1.0f - lb[j]) * sigm(-fr[j]), f = 1.0f - kin; S[j] = f * S[j] + kin * vv; o += qv[j] * S[j]; }
            o += __shfl_xor(o, 1); o += __shfl_xor(o, 2); o += __shfl_xor(o, 4); o += __shfl_xor(o, 8); o += __shfl_xor(o, 16);
            if (kq == 0 && tok < L) O[(size_t)tok * 2048 + h * 128 + v] = o * 0.08838834764831845f;
        }
    }
}
__device__ __forceinline__ void p6_combine_naive(const Ctx& F, const float* const* in, unsigned char* ws) {
    const bf16* P = (const bf16*)(ws + WS_PROJ); const bf16* XS = (const bf16*)(ws + WS_XS);
    const float* YF = (const float*)(ws + WS_YF); const float* YB = (const float*)(ws + WS_YB); const float* OF = (const float*)(ws + WS_OF); const float* OB = (const float*)(ws + WS_OB);
    bf16* Y2S = (bf16*)(ws + WS_Y2); bf16* Y2H = (bf16*)(ws + WS_Y2 + 64 * MiB);
    const int gw = F.bid * NWAVES + F.wave, NGW = F.G * NWAVES;
    for (int t = gw; t < L; t += NGW) {
        f32x4 y[8]; float part[8];
#pragma unroll
        for (int j = 0; j < 8; ++j) { const int col = 4 * F.lane + 256 * j; const size_t o = (size_t)t * 2048 + col;
            const f32x4 a = *(const f32x4*)(YF + o), b = *(const f32x4*)(YB + o); const v2u xs = *(const v2u*)(XS + o), zz = *(const v2u*)(P + pidx((size_t)t, PC_Z + col));
            const float dsk = in[13][col >> 6];
            f32x4 v; v[0] = a[0] + b[0] + dsk * bflo(xs.x); v[1] = a[1] + b[1] + dsk * bfhi(xs.x); v[2] = a[2] + b[2] + dsk * bflo(xs.y); v[3] = a[3] + b[3] + dsk * bfhi(xs.y);
            v[0] *= silu(bflo(zz.x)); v[1] *= silu(bfhi(zz.x)); v[2] *= silu(bflo(zz.y)); v[3] *= silu(bfhi(zz.y));
            y[j] = v; part[j] = (v[0] * v[0] + v[1] * v[1]) + (v[2] * v[2] + v[3] * v[3]); }
#pragma unroll
        for (int g = 0; g < 4; ++g) { const float ss = wave_sum(part[2 * g] + part[2 * g + 1]); const float rstd = 1.0f / sqrtf(ss * (1.0f / 512.0f) + EPS);
#pragma unroll
            for (int jj = 0; jj < 2; ++jj) { const int j = 2 * g + jj, col = 4 * F.lane + 256 * j; const f32x4 w = *(const f32x4*)(in[14] + col); const f32x4 o = y[j] * rstd * w;
                v2u pk; pk.x = pk2(o[0], o[1]); pk.y = pk2(o[2], o[3]); *(v2u*)(Y2S + (size_t)t * 2048 + col) = pk; } }
#pragma unroll
        for (int j = 0; j < 8; ++j) { const int col = 4 * F.lane + 256 * j; const size_t o = (size_t)t * 2048 + col;
            const f32x4 a = *(const f32x4*)(OF + o), b = *(const f32x4*)(OB + o); f32x4 v = a + b;
            float ss = (v[0] * v[0] + v[1] * v[1]) + (v[2] * v[2] + v[3] * v[3]);
            ss += __shfl_xor(ss, 1); ss += __shfl_xor(ss, 2); ss += __shfl_xor(ss, 4); ss += __shfl_xor(ss, 8); ss += __shfl_xor(ss, 16);
            const float rstd = 1.0f / sqrtf(ss * (1.0f / 128.0f) + EPS);
            const f32x4 w = *(const f32x4*)(in[16] + (col & 127)); const v2u gg = *(const v2u*)(P + pidx((size_t)t, PC_G + col));
            v = v * rstd * w; v[0] *= silu(bflo(gg.x)); v[1] *= silu(bfhi(gg.x)); v[2] *= silu(bflo(gg.y)); v[3] *= silu(bfhi(gg.y));
            v2u pk; pk.x = pk2(v[0], v[1]); pk.y = pk2(v[2], v[3]); *(v2u*)(Y2H + (size_t)t * 2048 + col) = pk; }
    }
}

__device__ __forceinline__ void p10_route(const Ctx& F, const float* const* in, unsigned char* ws) {
    const bf16* H1 = (const bf16*)(ws + WS_H1); const f32x4* W2 = (const f32x4*)(ws + WS_WR2); const float* cvec = (const float*)(ws + WS_WR2 + 262144);
    unsigned* gcnt = (unsigned*)(ws + WS_CTL) + CW_GCNT; float* RSTD = (float*)(ws + WS_RSTD);
    int* A_E = (int*)(ws + WS_ROUTE); int* A_POS = A_E + NASSIGN; float* A_P = (float*)(A_POS + NASSIGN);
    LAS float* part = (LAS float*)F.lds;
    LAS int* lcnt = (LAS int*)(F.lds + 16384); LAS int* lbase = lcnt + 32; LAS int* rec_e = lbase + 32; LAS int* rec_lp = rec_e + 256; LAS float* rec_p = (LAS float*)(rec_lp + 256);
    const int l15 = F.lane & 15, g4 = F.lane >> 4, tg = F.wave & 3, kh = F.wave >> 2;
    for (int tb = F.bid; tb < L / 64; tb += F.G) {
        if (F.tid < 32) lcnt[F.tid] = 0;
        const int tok = tb * 64 + tg * 16 + l15;
        f32x4 acc0 = {0.f, 0.f, 0.f, 0.f}, acc1 = {0.f, 0.f, 0.f, 0.f}; float ss = 0.f;
        const bf16* hp = H1 + (size_t)tok * D + 8 * g4;
#pragma unroll 2
        for (int j = kh * 32; j < kh * 32 + 32; ++j) {
            const v4u raw = *(const v4u*)(hp + 32 * j); const f32x4* wq = W2 + ((j * 4 + g4) * 2) * 32;
            const f32x4 a4 = {bflo(raw.x), bfhi(raw.x), bflo(raw.y), bfhi(raw.y)}, a5 = {bflo(raw.z), bfhi(raw.z), bflo(raw.w), bfhi(raw.w)};
            const f32x4 b0 = wq[l15], b1 = wq[16 + l15], b2 = wq[32 + l15], b3 = wq[48 + l15];
            ss += ((a4[0] * a4[0] + a4[1] * a4[1]) + (a4[2] * a4[2] + a4[3] * a4[3])) + ((a5[0] * a5[0] + a5[1] * a5[1]) + (a5[2] * a5[2] + a5[3] * a5[3]));
#pragma unroll
            for (int i = 0; i < 4; ++i) { acc0 = __builtin_amdgcn_mfma_f32_16x16x4f32(a4[i], b0[i], acc0, 0, 0, 0); acc1 = __builtin_amdgcn_mfma_f32_16x16x4f32(a4[i], b1[i], acc1, 0, 0, 0); }
#pragma unroll
            for (int i = 0; i < 4; ++i) { acc0 = __builtin_amdgcn_mfma_f32_16x16x4f32(a5[i], b2[i], acc0, 0, 0, 0); acc1 = __builtin_amdgcn_mfma_f32_16x16x4f32(a5[i], b3[i], acc1, 0, 0, 0); }
        }
        ss += __shfl_xor(ss, 16); ss += __shfl_xor(ss, 32);
        if (kh == 1) {
#pragma unroll
            for (int r = 0; r < 4; ++r) { part[(tg * 9 + r) * 64 + F.lane] = acc0[r]; part[(tg * 9 + 4 + r) * 64 + F.lane] = acc1[r]; }
            part[(tg * 9 + 8) * 64 + F.lane] = ss; }
        __syncthreads();
        if (kh == 0) {
#pragma unroll
            for (int r = 0; r < 4; ++r) { acc0[r] += part[(tg * 9 + r) * 64 + F.lane]; acc1[r] += part[(tg * 9 + 4 + r) * 64 + F.lane]; }
            ss += part[(tg * 9 + 8) * 64 + F.lane];
            const float rstd = 1.0f / sqrtf(ss * (1.0f / D) + EPS);
            if (g4 == 0) RSTD[tok] = rstd;
            const float c0 = cvec[l15], c1 = cvec[16 + l15];
#pragma unroll
            for (int r = 0; r < 4; ++r) { const float rs = __shfl(rstd, 4 * g4 + r);
                float v0 = acc0[r] * rs + c0, v1 = acc1[r] * rs + c1; int te[4]; float tv[4];
#pragma unroll
                for (int i = 0; i < 4; ++i) { float bv = v0 >= v1 ? v0 : v1; int bi = v0 >= v1 ? l15 : 16 + l15;
#pragma unroll
                    for (int o = 1; o < 16; o <<= 1) { const float ov = __shfl_xor(bv, o); const int oi = __shfl_xor(bi, o); const bool take = ov > bv || (ov == bv && oi < bi); bv = take ? ov : bv; bi = take ? oi : bi; }
                    bi = (bi < 0 || bi > 31) ? i : bi;
                    te[i] = bi; tv[i] = bv; if (bi == l15) v0 = -__builtin_inff(); if (bi == 16 + l15) v1 = -__builtin_inff(); }
                const float e1 = expf(tv[1] - tv[0]), e2 = expf(tv[2] - tv[0]), e3 = expf(tv[3] - tv[0]); const float inv = 1.0f / (1.0f + e1 + e2 + e3);
                const float pr[4] = {inv, e1 * inv, e2 * inv, e3 * inv};
                if (l15 == 0) { const int tl = tg * 16 + 4 * g4 + r;
#pragma unroll
                    for (int i = 0; i < 4; ++i) { const int lp = __hip_atomic_fetch_add(&lcnt[te[i]], 1, __ATOMIC_RELAXED, __HIP_MEMORY_SCOPE_WORKGROUP); rec_e[tl * 4 + i] = te[i]; rec_lp[tl * 4 + i] = lp; rec_p[tl * 4 + i] = pr[i]; } } }
        }
        __syncthreads();
        if (F.tid < 32) { const int c = lcnt[F.tid]; lbase[F.tid] = c ? (int)__hip_atomic_fetch_add(gcnt + F.tid * 64, (unsigned)c, __ATOMIC_RELAXED, __HIP_MEMORY_SCOPE_AGENT) : 0; }
        __syncthreads();
        if (F.tid < 256) { const int a = F.tid, t = tb * 64 + (a >> 2), ee = rec_e[a]; A_E[4 * t + (a & 3)] = ee; A_POS[4 * t + (a & 3)] = lbase[ee] + rec_lp[a]; A_P[4 * t + (a & 3)] = rec_p[a]; }
        __syncthreads();
    }
}
__device__ __forceinline__ int moe_tables(const Ctx& F, unsigned char* ws, LAS int* blk_e, LAS int* pad_start, LAS int* nblk_w) {
    const unsigned* gcnt = (const unsigned*)(ws + WS_CTL) + CW_GCNT;
    if (F.tid < 64) { const int e = F.lane & 31; const int c = (int)__hip_atomic_load(gcnt + e * 64, __ATOMIC_RELAXED, __HIP_MEMORY_SCOPE_AGENT); const int nbe = (c + 255) >> 8;
        int incl = nbe;
#pragma unroll
        for (int o = 1; o < 32; o <<= 1) { const int v = __shfl_up(incl, o, 32); if (e >= o) incl += v; }
        const int start = incl - nbe;
        if (F.lane < 32) { pad_start[e] = start * 256; for (int j = 0; j < nbe && start + j < MAXBLK; ++j) blk_e[start + j] = e; if (e == 31) nblk_w[0] = incl < MAXBLK ? incl : MAXBLK; } }
    __syncthreads();
    return nblk_w[0];
}
typedef int i32x4 __attribute__((ext_vector_type(4)));
__device__ __forceinline__ void p11_gather(const Ctx& F, const float* const* in, unsigned char* ws) {
    LAS int* blk_e = (LAS int*)(F.lds + MISC_OFF + 1024); LAS int* pad_start = blk_e + MAXBLK; LAS int* nblk_w = pad_start + 32;
    (void)moe_tables(F, ws, blk_e, pad_start, nblk_w);
    const int* A_E = (const int*)(ws + WS_ROUTE); const int* A_POS = A_E + NASSIGN; const float* A_P = (const float*)(A_POS + NASSIGN); int* SLOT = (int*)(A_P + NASSIGN); float* ROWP = (float*)(SLOT + NASSIGN); int* TOK = (int*)(ROWP + MAXSLOT);
    const bf16* H1 = (const bf16*)(ws + WS_H1); const float* RSTD = (const float*)(ws + WS_RSTD); bf16* HN2 = (bf16*)(ws + WS_XG);
    const float* mod = (const float*)(ws + WS_MOD); const float* sh2 = mod + 6144; const float* sc2 = mod + 8192; const float* w2 = in[7];
    const int gw = F.bid * NWAVES + F.wave, NGW = F.G * NWAVES;
    f32x4 sv[4][2], hv[4][2];
#pragma unroll
    for (int j = 0; j < 4; ++j)
#pragma unroll
        for (int q = 0; q < 2; ++q) { const int col = 8 * F.lane + 512 * j + 4 * q; sv[j][q] = *(const f32x4*)(w2 + col) * (*(const f32x4*)(sc2 + col) + 1.0f); hv[j][q] = *(const f32x4*)(sh2 + col); }
    for (int t = gw; t < L; t += NGW) {
        const float rstd = RSTD[t]; const i32x4 ae = *(const i32x4*)(A_E + 4 * t), ap = *(const i32x4*)(A_POS + 4 * t); const f32x4 pp = *(const f32x4*)(A_P + 4 * t);
        i32x4 slot; slot[0] = pad_start[ae[0]] + ap[0]; slot[1] = pad_start[ae[1]] + ap[1]; slot[2] = pad_start[ae[2]] + ap[2]; slot[3] = pad_start[ae[3]] + ap[3];
        if (F.lane == 0) { *(i32x4*)(SLOT + 4 * t) = slot; ROWP[slot[0]] = pp[0]; ROWP[slot[1]] = pp[1]; ROWP[slot[2]] = pp[2]; ROWP[slot[3]] = pp[3]; TOK[slot[0]] = t; TOK[slot[1]] = t; TOK[slot[2]] = t; TOK[slot[3]] = t; }
#pragma unroll
        for (int j = 0; j < 4; ++j) { const int col = 8 * F.lane + 512 * j; const v4u hr = *(const v4u*)(H1 + (size_t)t * D + col); const f32x4 v0 = {bflo(hr.x), bfhi(hr.x), bflo(hr.y), bfhi(hr.y)}, v1 = {bflo(hr.z), bfhi(hr.z), bflo(hr.w), bfhi(hr.w)};
            const f32x4 o0 = v0 * rstd * sv[j][0] + hv[j][0], o1 = v1 * rstd * sv[j][1] + hv[j][1];
            v4u pk; pk.x = pg8::cvt_pk_bf16(o0[0], o0[1]); pk.y = pg8::cvt_pk_bf16(o0[2], o0[3]); pk.z = pg8::cvt_pk_bf16(o1[0], o1[1]); pk.w = pg8::cvt_pk_bf16(o1[2], o1[3]);
            *(v4u*)(HN2 + (size_t)t * D + col) = pk; }
    }
}
__device__ __forceinline__ void p14_final(const Ctx& F, const float* const* in, float* out, unsigned char* ws) {
    const bf16* H1 = (const bf16*)(ws + WS_H1); const bf16* Y2M = (const bf16*)(ws + WS_Y2M); const float* g2 = (const float*)(ws + WS_MOD) + 10240; const float* fw = in[26];
    const int* SLOT = (const int*)(ws + WS_ROUTE) + 3 * NASSIGN;
    const int gw = F.bid * NWAVES + F.wave, NGW = F.G * NWAVES;
    f32x4 gv[4][2], fv[4][2];
#pragma unroll
    for (int j = 0; j < 4; ++j)
#pragma unroll
        for (int q = 0; q < 2; ++q) { const int col = 8 * F.lane + 512 * j + 4 * q; gv[j][q] = *(const f32x4*)(g2 + col); fv[j][q] = *(const f32x4*)(fw + col); }
    for (int t = gw; t < L; t += NGW) {
        const i32x4 sl = *(const i32x4*)(SLOT + 4 * t);
        f32x4 v[4][2]; float ss = 0.f;
#pragma unroll
        for (int j = 0; j < 4; ++j) { const int col = 8 * F.lane + 512 * j;
            const v4u a = *(const v4u*)(Y2M + (size_t)sl[0] * D + col), b = *(const v4u*)(Y2M + (size_t)sl[1] * D + col), c = *(const v4u*)(Y2M + (size_t)sl[2] * D + col), d = *(const v4u*)(Y2M + (size_t)sl[3] * D + col);
            f32x4 m0, m1;
            m0[0] = (bflo(a.x) + bflo(b.x)) + (bflo(c.x) + bflo(d.x)); m0[1] = (bfhi(a.x) + bfhi(b.x)) + (bfhi(c.x) + bfhi(d.x)); m0[2] = (bflo(a.y) + bflo(b.y)) + (bflo(c.y) + bflo(d.y)); m0[3] = (bfhi(a.y) + bfhi(b.y)) + (bfhi(c.y) + bfhi(d.y));
            m1[0] = (bflo(a.z) + bflo(b.z)) + (bflo(c.z) + bflo(d.z)); m1[1] = (bfhi(a.z) + bfhi(b.z)) + (bfhi(c.z) + bfhi(d.z)); m1[2] = (bflo(a.w) + bflo(b.w)) + (bflo(c.w) + bflo(d.w)); m1[3] = (bfhi(a.w) + bfhi(b.w)) + (bfhi(c.w) + bfhi(d.w));
            const v4u hr = *(const v4u*)(H1 + (size_t)t * D + col); const f32x4 h0 = {bflo(hr.x), bfhi(hr.x), bflo(hr.y), bfhi(hr.y)}, h1v = {bflo(hr.z), bfhi(hr.z), bflo(hr.w), bfhi(hr.w)};
            v[j][0] = h0 + gv[j][0] * m0; v[j][1] = h1v + gv[j][1] * m1;
            ss += (v[j][0][0] * v[j][0][0] + v[j][0][1] * v[j][0][1]) + (v[j][0][2] * v[j][0][2] + v[j][0][3] * v[j][0][3]) + (v[j][1][0] * v[j][1][0] + v[j][1][1] * v[j][1][1]) + (v[j][1][2] * v[j][1][2] + v[j][1][3] * v[j][1][3]); }
        const float rstd = 1.0f / sqrtf(wave_sum(ss) * (1.0f / D) + EPS);
#pragma unroll
        for (int j = 0; j < 4; ++j) { const int col = 8 * F.lane + 512 * j; *(f32x4*)(out + (size_t)t * D + col) = v[j][0] * rstd * fv[j][0]; *(f32x4*)(out + (size_t)t * D + col + 4) = v[j][1] * rstd * fv[j][1]; }
    }
}

__device__ __forceinline__ unsigned tile_off(int r, int ch) { return (unsigned)(r * 256 + ((ch ^ (r & 15)) << 4)); }
__device__ __forceinline__ void load_tile128(LAS unsigned char* dst, const bf16* src, size_t pitch, int tid) {
#pragma unroll
    for (int p = 0; p < 4; ++p) { const int idx = p * 512 + tid, r = idx >> 4, ch = idx & 15; const v4u v = *(const v4u*)(src + (size_t)r * pitch + ch * 8); *(LAS v4u*)(dst + tile_off(r, ch)) = v; }
}
__device__ __forceinline__ bf16x8 frag(const LAS unsigned char* tile, int row, int chunk) { return *(const LAS bf16x8*)(tile + tile_off(row, chunk)); }
__device__ __forceinline__ bf16x8 as_frag(v4u v) { return __builtin_bit_cast(bf16x8, v); }
typedef short s16x4 __attribute__((ext_vector_type(4)));
__device__ __forceinline__ unsigned vimg_off(int r, int ch) { return 256u * (unsigned)r + 16u * (unsigned)(ch ^ (((r & 3) << 2) | ((r >> 2) & 3))); }
__device__ __forceinline__ void stage_vimg(LAS unsigned char* img, const bf16* P, int tok0, int h, int tid) {
#pragma unroll
    for (int p = 0; p < 4; ++p) { const int idx = p * 512 + tid, r = idx >> 4, ch = idx & 15; *(LAS v4u*)(img + vimg_off(r, ch)) = *(const v4u*)(P + pidx((size_t)(tok0 + r), PC_I + h * 128 + 8 * ch)); }
}
__device__ __forceinline__ v2u vtr(const LAS unsigned char* a) { return __builtin_bit_cast(v2u, __builtin_amdgcn_ds_read_tr16_b64_v4i16((LAS s16x4*)a)); }
__device__ __forceinline__ bf16x8 scale8(v4u raw, const f32x4 fa, const f32x4 fb) {
    v4u o; o.x = cvt_pk_bf16(bflo(raw.x) * fa[0], bfhi(raw.x) * fa[1]); o.y = cvt_pk_bf16(bflo(raw.y) * fa[2], bfhi(raw.y) * fa[3]);
    o.z = cvt_pk_bf16(bflo(raw.z) * fb[0], bfhi(raw.z) * fb[1]); o.w = cvt_pk_bf16(bflo(raw.w) * fb[2], bfhi(raw.w) * fb[3]); return __builtin_bit_cast(bf16x8, o);
}
#define MFMA16(a, b, c) __builtin_amdgcn_mfma_f32_16x16x32_bf16((a), (b), (c), 0, 0, 0)
__device__ __forceinline__ v2u pack4(const f32x4 v) { v2u o; o.x = cvt_pk_bf16(v[0], v[1]); o.y = cvt_pk_bf16(v[2], v[3]); return o; }

template <int DIR> __device__ __forceinline__ void hg_item(const Ctx& F, const float* const* in, unsigned char* ws, int c, int h, int mask) {
    const bf16* P = (const bf16*)(ws + WS_PROJ);
    constexpr int d = DIR; const int kc = h * 128 + 2 * F.lane, tokc = c * 128, fc = (d ? PC_FB : PC_FF) + kc;
    const float oml0 = 1.0f - 1.0f / (1.0f + expf(in[15][(d * 2 + 1) * 2048 + kc] - in[15][(d * 2 + 0) * 2048 + kc]));
    const float oml1 = 1.0f - 1.0f / (1.0f + expf(in[15][(d * 2 + 1) * 2048 + kc + 1] - in[15][(d * 2 + 0) * 2048 + kc + 1]));
    const bf16* Pf = P + pidx((size_t)tokc, fc); const bf16* Pq = P + pidx((size_t)tokc, PC_Q + kc);
    const size_t tile = (((size_t)c * 16 + h) * 2 + d) * 16384;
    bf16* QTd = (bf16*)(ws + WS_QT) + tile; bf16* KDd = (bf16*)(ws + WS_KD) + tile;
    const bool needq = c < 128;
    float run0 = 0.f, run1 = 0.f;
    LAS unsigned* qb = (LAS unsigned*)(F.lds + F.wave * 16384); LAS unsigned* kb = qb + 1088;
    const int fslot = (F.lane >> 4) * 64 + ((F.lane >> 2) & 3) * 16;
#pragma unroll 1
    for (int half = 0; half < 2; ++half) {
#pragma unroll
        for (int b4 = 0; b4 < 4; ++b4) { const int Ii = half * 4 + b4, I = d ? 7 - Ii : Ii;
            unsigned u[16], q[16];
#pragma unroll
            for (int j = 0; j < 16; ++j) { u[j] = *(const unsigned*)(Pf + (16 * I + j) * 128); q[j] = needq ? *(const unsigned*)(Pq + (16 * I + j) * 128) : 0u; }
            *(f32x2*)((float*)(ws + WS_BETA) + ((size_t)(c * 2 + d) * 8 + I) * 2048 + kc) = (f32x2){run0, run1};
            float e0 = 1.0f, e1 = 1.0f;
#pragma unroll
            for (int jj = 0; jj < 16; ++jj) { const int j = DIR ? 15 - jj : jj;
                const float k0 = oml0 * sigm(-bflo(u[j])), k1 = oml1 * sigm(-bfhi(u[j]));
                e0 = fmaxf(e0 * (1.0f - k0), 1e-30f); e1 = fmaxf(e1 * (1.0f - k1), 1e-30f);
                const float kd0 = k0 * __builtin_amdgcn_rcpf(e0), kd1 = k1 * __builtin_amdgcn_rcpf(e1);
                { const int slot = fslot + j; qb[(slot + (slot >> 4)) * 4 + (F.lane & 3)] = cvt_pk_bf16(bflo(q[j]) * 0.08838834764831845f * e0, bfhi(q[j]) * 0.08838834764831845f * e1);
                  kb[(slot + (slot >> 4)) * 4 + (F.lane & 3)] = cvt_pk_bf16(kd0, kd1); }
                }
            run0 += __logf(e0); run1 += __logf(e1);
            LDS_WAIT(); asm volatile("" ::: "memory");
            if (!(mask & 16)) {
#pragma unroll
                for (int i = 0; i < 4; ++i) { const int slot = i * 64 + F.lane; const size_t go = (size_t)I * 2048 + (size_t)slot * 8;
                    if (needq) *(v4u*)(QTd + go) = *(const LAS v4u*)(qb + (slot + (slot >> 4)) * 4); *(v4u*)(KDd + go) = *(const LAS v4u*)(kb + (slot + (slot >> 4)) * 4); } }
            LDS_WAIT(); asm volatile("" ::: "memory");
        }
    }
    *(f32x2*)((float*)(ws + WS_DEC) + (size_t)(c * 2 + d) * 2048 + kc) = (f32x2){run0, run1};
}

__device__ __forceinline__ void p3_prep2(const Ctx& F, const float* const* in, unsigned char* ws, int mask) {
    const bf16* P = (const bf16*)(ws + WS_PROJ); const float* cw = in[9]; const float* cb = in[10];
    bf16* BN = (bf16*)(ws + WS_BN); bf16* CN = (bf16*)(ws + WS_CN); bf16* XT = (bf16*)(ws + WS_XT); bf16* BT = (bf16*)(ws + WS_BT);
    float* DTV = (float*)(ws + WS_DTV); float* ACS = (float*)(ws + WS_ACS);
    constexpr int NT = LT / 64, NS = 24, NCONV = NT * NS, NDT = 130 * 64 / 8, NHG = 128 * 16 * 2 / 8 + 2 * 16 * 2;
    if (mask & 1)
    for (int sb = F.bid % NS; sb < NS; sb += (F.G >= NS ? NS : F.G)) {
        const int nown = F.G >= NS ? (F.G - sb + NS - 1) / NS : 1, rank = F.G >= NS ? F.bid / NS : 0;
        const int tl = F.tid >> 3, cg = F.tid & 7, ch0 = sb * 128 + cg * 16;
        float wk[4][16], bk[16];
#pragma unroll
        for (int i = 0; i < 16; i += 4) { const f32x4 b = *(const f32x4*)(cb + ch0 + i); bk[i] = b[0]; bk[i + 1] = b[1]; bk[i + 2] = b[2]; bk[i + 3] = b[3];
#pragma unroll
            for (int k = 0; k < 4; ++k) { const f32x4 w = *(const f32x4*)(cw + k * 3072 + ch0 + i); wk[k][i] = w[0]; wk[k][i + 1] = w[1]; wk[k][i + 2] = w[2]; wk[k][i + 3] = w[3]; } }
        for (int tt = rank; tt < NT; tt += nown) {
            const int t = tt * 64 + tl;
            const int r0 = t < L ? tt * 64 : L, r1 = t < L ? tt * 64 + 64 : LT;
            float a[16];
#pragma unroll
            for (int i = 0; i < 16; ++i) a[i] = bk[i];
#pragma unroll
            for (int k = 0; k < 4; ++k) { const int ts = t + k - 2;
                if (ts >= r0 && ts < r1) { const v4u u0 = *(const v4u*)(P + pidx((size_t)ts, PC_X + ch0)), u1 = *(const v4u*)(P + pidx((size_t)ts, PC_X + ch0 + 8));
                    const unsigned uu[8] = {u0.x, u0.y, u0.z, u0.w, u1.x, u1.y, u1.z, u1.w};
#pragma unroll
                    for (int i = 0; i < 8; ++i) { a[2 * i] += wk[k][2 * i] * bflo(uu[i]); a[2 * i + 1] += wk[k][2 * i + 1] * bfhi(uu[i]); } } }
            unsigned o[8];
#pragma unroll
            for (int i = 0; i < 8; ++i) o[i] = pk2(silu(a[2 * i]), silu(a[2 * i + 1]));
            if (ch0 >= 2048) { const int cc = ch0 - (ch0 < 2560 ? 2048 : 2560); bf16* dst = (ch0 < 2560 ? BN : CN) + ((((size_t)(t >> 7)) * 4 + (cc >> 7)) * 128 + (t & 127)) * 128 + (cc & 127);
                *(v4u*)dst = (v4u){o[0], o[1], o[2], o[3]}; *(v4u*)(dst + 8) = (v4u){o[4], o[5], o[6], o[7]}; }
            if (sb < 20) {
                LAS bf16* tb = (LAS bf16*)F.lds;
#pragma unroll
                for (int i = 0; i < 8; ++i) { tb[(cg * 16 + 2 * i) * 66 + tl] = (bf16)(o[i] & 0xffffu); tb[(cg * 16 + 2 * i + 1) * 66 + tl] = (bf16)(o[i] >> 16); }
                __syncthreads();
                const int chl = F.tid >> 2, qd = F.tid & 3; const LAS unsigned* rowp = (const LAS unsigned*)(tb + chl * 66 + qd * 16);
                const v4u w0 = {rowp[0], rowp[1], rowp[2], rowp[3]}, w1 = {rowp[4], rowp[5], rowp[6], rowp[7]};
                const int ch = sb * 128 + chl;
                if (ch < 2048) {
                    const int p = ch & 63, ks2 = (tt & 1) * 2 + (qd >> 1), g40 = 2 * (qd & 1);
                    bf16* td = XT + ((size_t)(tt >> 1) * 32 + (ch >> 6)) * 8192 + ((((p >> 4) * 4 + ks2) * 4 + g40) * 16 + (p & 15)) * 8;
                    *(v4u*)td = w0; *(v4u*)(td + 128) = w1;
                } else { bf16* td = BT + ((size_t)(tt >> 1) * 512 + (ch - 2048)) * 128 + (tt & 1) * 64 + qd * 16;
                    *(v4u*)td = w0; *(v4u*)(td + 8) = w1; }
                __syncthreads();
            }
        }
    }
    for (int it = NCONV + F.bid; it < NCONV + NDT + NHG; it += F.G) {
        if (it < NCONV + NDT) {
            if (!(mask & 2)) continue;
            const int wi = (it - NCONV) * 8 + F.wave, c = wi >> 6, dh = wi & 63, d = dh >> 5, t0 = c * 128 + 2 * F.lane;
            const float* dr = (const float*)(ws + WS_DTRAW); const float bias = in[11][dh], A = -expf(in[12][dh]);
            const float x0 = dr[(size_t)t0 * 64 + dh] + bias, x1 = dr[(size_t)(t0 + 1) * 64 + dh] + bias;
            const float d0 = fmaxf(x0, 0.f) + log1pf(expf(-fabsf(x0))), d1 = fmaxf(x1, 0.f) + log1pf(expf(-fabsf(x1)));
            *(f32x2*)(DTV + (size_t)dh * LT + t0) = (f32x2){d0, d1};
            const float a0 = A * d0, a1 = A * d1; float s = a0 + a1, incl = s;
            if (d == 0) {
#pragma unroll
                for (int o = 1; o < 64; o <<= 1) { const float v = __shfl_up(incl, o); if (F.lane >= o) incl += v; }
                const float excl = incl - s; *(f32x2*)(ACS + (size_t)dh * LT + t0) = (f32x2){excl + a0, excl + a0 + a1};
            } else {
#pragma unroll
                for (int o = 1; o < 64; o <<= 1) { const float v = __shfl_down(incl, o); if (F.lane + o < 64) incl += v; }
                const float excl = incl - s; *(f32x2*)(ACS + (size_t)dh * LT + t0) = (f32x2){excl + a0 + a1, excl + a1};
            }
        } else {
            if (!(mask & 4)) continue;
            const int be = it - NCONV - NDT; if (be >= 512 && F.wave != 0) continue;
            const int wi = be < 512 ? be * 8 + F.wave : 4096 + (be - 512), d = wi & 1, h = (wi >> 1) & 15, c = wi >> 5;
            if (d == 0) hg_item<0>(F, in, ws, c, h, mask); else hg_item<1>(F, in, ws, c, h, mask);
        }
    }
}

__device__ __forceinline__ void p4_local(const Ctx& F, unsigned char* ws, int mask) {
    const int g4 = F.lane >> 4, l15 = F.lane & 15;
    const float* DTV = (const float*)(ws + WS_DTV); const float* ACS = (const float*)(ws + WS_ACS);
    constexpr int NS1 = 130 * 4 * 2, NH1 = 130 * 16;
    for (int it = F.bid; it < NS1; it += F.G) {
        {
            if (!(mask & 1)) continue;
            const int d = it & 1, c = it >> 3, g = (it >> 1) & 3, h = 8 * g + F.wave, tok0 = c * 128;
            LAS unsigned char* BTt = F.lds; LAS float* coef = (LAS float*)(F.lds + 32768 + F.wave * 1024);
            load_tile128(BTt, (const bf16*)(ws + WS_BT) + ((size_t)c * 512 + g * 128) * 128, 128, F.tid);
            { const float aend = ACS[(size_t)h * LT + tok0 + 127], rst = ACS[(size_t)(32 + h) * LT + tok0];
#pragma unroll
              for (int q = 0; q < 2; ++q) { const int s = F.lane + 64 * q;
                  coef[s] = DTV[(size_t)h * LT + tok0 + s] * __expf(aend - ACS[(size_t)h * LT + tok0 + s]);
                  coef[128 + s] = DTV[(size_t)(32 + h) * LT + tok0 + s] * __expf(rst - ACS[(size_t)(32 + h) * LT + tok0 + s]); } }
            __syncthreads();
            const bf16* XT = (const bf16*)(ws + WS_XT); bf16* SST = (bf16*)(ws + WS_SST);
#pragma unroll 1
                for (int ph = 0; ph < 2; ++ph) {
                    asm volatile("" ::: "memory");
                    bf16x8 Y[2][4];
#pragma unroll
                    for (int pp = 0; pp < 2; ++pp)
#pragma unroll
                        for (int ks = 0; ks < 4; ++ks) { const v4u raw = *(const v4u*)(XT + ((size_t)c * 32 + h) * 8192 + (((2 * ph + pp) * 4 + ks) * 64 + F.lane) * 8);
                            const f32x4 fa = *(const LAS f32x4*)(coef + d * 128 + ks * 32 + 8 * g4), fb = *(const LAS f32x4*)(coef + d * 128 + ks * 32 + 8 * g4 + 4);
                            Y[pp][ks] = scale8(raw, fa, fb); }
                    f32x4 acc[8][2];
#pragma unroll
                    for (int nt = 0; nt < 8; ++nt) { acc[nt][0] = (f32x4){0.f, 0.f, 0.f, 0.f}; acc[nt][1] = (f32x4){0.f, 0.f, 0.f, 0.f}; }
#pragma unroll
                    for (int nt = 0; nt < 8; ++nt) { asm volatile("" ::: "memory");
#pragma unroll
                        for (int ks = 0; ks < 4; ++ks) { const bf16x8 X = frag(BTt, nt * 16 + l15, ks * 4 + g4); acc[nt][0] = MFMA16(X, Y[0][ks], acc[nt][0]); acc[nt][1] = MFMA16(X, Y[1][ks], acc[nt][1]); } }
#pragma unroll
                    for (int nt = 0; nt < 8; ++nt)
#pragma unroll
                        for (int pp = 0; pp < 2; ++pp)
                            *(v2u*)(SST + (((size_t)c * 32 + h) * 2 + d) * 8192 + (((((2 * ph + pp) * 4 + (nt >> 1)) * 4 + 2 * (nt & 1) + (g4 >> 1)) * 16 + l15) * 8 + 4 * (g4 & 1))) = pack4(acc[nt][pp]);
                }
            __syncthreads();
        }
    }
    for (int it = F.G - 1 - F.bid; it < NH1; it += F.G) {
        {
            if (!(mask & 2)) continue;
            const int hi = it, c = hi >> 4, h = hi & 15, tok0 = c * 128;
            LAS unsigned char* VTt = F.lds; LAS unsigned char* KHf = F.lds + 32768; LAS unsigned char* KHb = F.lds + 65536;
            stage_vimg(VTt, (const bf16*)(ws + WS_PROJ), tok0, h, F.tid);
            { const bf16* kdsrc = (const bf16*)(ws + WS_KD) + (((size_t)c * 16 + h) * 2) * 16384;
#pragma unroll
              for (int p = 0; p < 4; ++p) { const int idx = p * 512 + F.tid; *(LAS v4u*)(KHf + idx * 16) = *(const v4u*)(kdsrc + (size_t)idx * 8); *(LAS v4u*)(KHb + idx * 16) = *(const v4u*)(kdsrc + 16384 + (size_t)idx * 8); } }
            __syncthreads();
            bf16* HST = (bf16*)(ws + WS_HST);
            const LAS unsigned char* trb[2];
            { const int q = l15 >> 2, p = l15 & 3, w = F.wave;
              const unsigned o = (unsigned)((((((g4 >> 1) * 4 + (w >> 1)) * 4 + ((2 * w + (p >> 1)) & 3)) * 16 + 8 * (g4 & 1) + q) * 16) + 8 * (p & 1));
              trb[0] = KHf + o; trb[1] = KHb + o; }
            const LAS unsigned char* va[2][8];
            { const int q = l15 >> 2, p = l15 & 3;
#pragma unroll
              for (int hb = 0; hb < 2; ++hb) { const int T = (p >> 1) ^ ((q << 2) | ((2 * g4 + hb) & 3));
#pragma unroll
                  for (int vt = 0; vt < 8; ++vt) va[hb][vt] = VTt + 256 * (8 * g4 + 4 * hb + q) + 8 * (p & 1) + ((32 * vt) ^ (16 * T)); } }
#pragma unroll 1
            for (int d = 0; d < 2; ++d) { const LAS unsigned char* KH = d ? KHb : KHf;
                f32x4 acc[8];
#pragma unroll
                for (int vt = 0; vt < 8; ++vt) acc[vt] = (f32x4){0.f, 0.f, 0.f, 0.f};
#pragma unroll
                for (int ks = 0; ks < 4; ++ks) { asm volatile("" ::: "memory");
                    const int kk = h * 128 + 16 * F.wave + l15, Ib = 2 * ks + (g4 >> 1);
                    const float gfac = __expf(((const float*)(ws + WS_DEC))[(size_t)(c * 2 + d) * 2048 + kk] - ((const float*)(ws + WS_BETA))[((size_t)(c * 2 + d) * 8 + Ib) * 2048 + kk]);
                    const f32x4 g4v = {gfac, gfac, gfac, gfac};
                    const v2u t0 = vtr(trb[d] + ks * 8192), t1 = vtr(trb[d] + ks * 8192 + 64);
                    const bf16x8 X = scale8((v4u){t0.x, t0.y, t1.x, t1.y}, g4v, g4v);
#pragma unroll
                    for (int vt = 0; vt < 8; ++vt) { const v2u b0 = vtr(va[0][vt] + 8192 * ks), b1 = vtr(va[1][vt] + 8192 * ks); acc[vt] = MFMA16(X, as_frag((v4u){b0.x, b0.y, b1.x, b1.y}), acc[vt]); } }
#pragma unroll
                for (int vt = 0; vt < 8; ++vt) { const int v = 16 * vt + l15, k = 16 * F.wave + 4 * g4;
                    *(v2u*)(HST + ((((size_t)c * 16 + h) * 2 + d) * 128 + v) * 128 + k) = pack4(acc[vt]); }
            }
            __syncthreads();
        }
    }
}

__device__ __forceinline__ void scan_decay(bool ssd, int d, int h, int kc, int c, const float* ACS, const float* DEC, float (&dv)[8]) {
    if (ssd) { const float x = __expf(d == 0 ? ACS[(size_t)h * LT + c * 128 + 127] : ACS[(size_t)(32 + h) * LT + c * 128]);
#pragma unroll
        for (int j = 0; j < 8; ++j) dv[j] = x; }
    else { const f32x4 a = *(const f32x4*)(DEC + (size_t)(c * 2 + d) * 2048 + kc), b = *(const f32x4*)(DEC + (size_t)(c * 2 + d) * 2048 + kc + 4);
        dv[0] = __expf(a[0]); dv[1] = __expf(a[1]); dv[2] = __expf(a[2]); dv[3] = __expf(a[3]); dv[4] = __expf(b[0]); dv[5] = __expf(b[1]); dv[6] = __expf(b[2]); dv[7] = __expf(b[3]); }
}
__device__ __forceinline__ bf16* hsti_chunk(unsigned char* ws, int c) { return (bf16*)(ws + (c < 64 ? WS_HSTI0 : WS_HSTI1)) + (size_t)(c & 63) * 524288; }
__device__ __forceinline__ void p5_scan(const Ctx& F, unsigned char* ws) {
    const float* ACS = (const float*)(ws + WS_ACS); const float* DEC = (const float*)(ws + WS_DEC);
    constexpr size_t CST = 524288;
    for (int u = F.bid * 512 + F.tid; u < 131072; u += F.G * 512) {
        const bool ssd = u < 65536; const int e = ssd ? u : u - 65536;
        int d, h, kc = 0; bf16* base; size_t eoff;
        if (ssd) { const int n8 = e & 15, p = (e >> 4) & 63; d = (e >> 10) & 1; h = e >> 11; eoff = (((size_t)h * 2 + d) * 64 + p) * 128 + n8 * 8; base = (bf16*)(ws + WS_SST) + eoff; }
        else { const int k8 = e & 15, v = (e >> 4) & 127; d = (e >> 11) & 1; h = e >> 12; kc = h * 128 + k8 * 8; eoff = (((size_t)h * 2 + d) * 128 + v) * 128 + k8 * 8; base = (bf16*)(ws + WS_HST) + eoff; }
        float run[8];
#pragma unroll
        for (int j = 0; j < 8; ++j) run[j] = 0.f;
#pragma unroll
        for (int i = 0; i < 2; ++i) { const int c = d == 0 ? 128 + i : 129 - i; float dv[8]; scan_decay(ssd, d, h, kc, c, ACS, DEC, dv); const v4u s = *(const v4u*)(base + (size_t)c * CST);
            const float sv[8] = {bflo(s.x), bfhi(s.x), bflo(s.y), bfhi(s.y), bflo(s.z), bfhi(s.z), bflo(s.w), bfhi(s.w)};
#pragma unroll
            for (int j = 0; j < 8; ++j) run[j] = run[j] * dv[j] + sv[j]; }
#pragma unroll 1
        for (int b = 0; b < 16; ++b) {
            v4u s[8]; float dv[8][8];
#pragma unroll
            for (int i = 0; i < 8; ++i) { const int c = d == 0 ? b * 8 + i : 127 - (b * 8 + i); s[i] = *(const v4u*)(base + (size_t)c * CST); scan_decay(ssd, d, h, kc, c, ACS, DEC, dv[i]); }
#pragma unroll
            for (int i = 0; i < 8; ++i) { const int c = d == 0 ? b * 8 + i : 127 - (b * 8 + i);
                v4u o; o.x = cvt_pk_bf16(run[0], run[1]); o.y = cvt_pk_bf16(run[2], run[3]); o.z = cvt_pk_bf16(run[4], run[5]); o.w = cvt_pk_bf16(run[6], run[7]);
                *(v4u*)((ssd ? (bf16*)(ws + WS_SSTI) + (size_t)c * CST : hsti_chunk(ws, c)) + eoff) = o;
                const float sv[8] = {bflo(s[i].x), bfhi(s[i].x), bflo(s[i].y), bfhi(s[i].y), bflo(s[i].z), bfhi(s[i].z), bflo(s[i].w), bfhi(s[i].w)};
#pragma unroll
                for (int j = 0; j < 8; ++j) run[j] = run[j] * dv[i][j] + sv[j]; }
        }
    }
}

__device__ __forceinline__ void p6_out(const Ctx& F, const float* const* in, unsigned char* ws, int mask) {
    const int g4 = F.lane >> 4, l15 = F.lane & 15;
    const bf16* P = (const bf16*)(ws + WS_PROJ);
    constexpr int NS3 = 128 * 4, NH3 = 128 * 16;
    for (int it = F.bid; it < NS3; it += F.G) {
        {
#ifndef SKIP_S3
            if (!(mask & 1)) continue;
            const int c = it >> 2, g = it & 3, h = 8 * g + F.wave, tok0 = c * 128;
            LAS unsigned char* CNt = F.lds; LAS unsigned char* BNt = F.lds + 32768; LAS float* CB = (LAS float*)(F.lds + 32768);
            LAS float* vec = (LAS float*)(F.lds + 100352 + F.wave * 2048);
            LAS float* ssq = (LAS float*)(F.lds + 116736);
            load_tile128(CNt, (const bf16*)(ws + WS_CN) + ((size_t)c * 4 + g) * 16384, 128, F.tid);
            load_tile128(BNt, (const bf16*)(ws + WS_BN) + ((size_t)c * 4 + g) * 16384, 128, F.tid);
            { const float* ACS = (const float*)(ws + WS_ACS); const float* DTV = (const float*)(ws + WS_DTV);
#pragma unroll
              for (int q = 0; q < 2; ++q) { const int s = F.lane + 64 * q; vec[s] = ACS[(size_t)h * LT + tok0 + s]; vec[128 + s] = ACS[(size_t)(32 + h) * LT + tok0 + s];
                  vec[256 + s] = DTV[(size_t)h * LT + tok0 + s]; vec[384 + s] = DTV[(size_t)(32 + h) * LT + tok0 + s]; } }
            __syncthreads();
            {
                f32x4 acc[8];
#pragma unroll
                for (int st = 0; st < 8; ++st) acc[st] = (f32x4){0.f, 0.f, 0.f, 0.f};
#pragma unroll
                for (int ks = 0; ks < 4; ++ks) { const bf16x8 Yc = frag(CNt, 16 * F.wave + l15, ks * 4 + g4);
#pragma unroll
                    for (int st = 0; st < 8; ++st) acc[st] = MFMA16(frag(BNt, 16 * st + l15, ks * 4 + g4), Yc, acc[st]); }
                __syncthreads();
#pragma unroll
                for (int st = 0; st < 8; ++st) *(LAS f32x4*)(CB + (16 * F.wave + l15) * 132 + 16 * st + 4 * g4) = acc[st];
            }
            __syncthreads();
            const bf16* SST = (const bf16*)(ws + WS_SSTI); const bf16* XT = (const bf16*)(ws + WS_XT); bf16* Y2S = (bf16*)(ws + WS_Y2);
            const float dsk = in[13][h];
#pragma unroll 1
            for (int th = 0; th < 2; ++th) {
                f32x4 y[4][4];
#pragma unroll
                for (int tt = 0; tt < 4; ++tt)
#pragma unroll
                    for (int pt = 0; pt < 4; ++pt) y[tt][pt] = (f32x4){0.f, 0.f, 0.f, 0.f};
#pragma unroll 1
                for (int d = 0; d < 2; ++d) {
                    asm volatile("" ::: "memory");
                    float ev[4];
#pragma unroll
                    for (int tt = 0; tt < 4; ++tt) ev[tt] = __expf(vec[d * 128 + 64 * th + 16 * tt + l15]);
#pragma unroll 1
                    for (int ks = 0; ks < 4; ++ks) {
                        asm volatile("" ::: "memory");
                        bf16x8 Xs[4];
#pragma unroll
                        for (int pt = 0; pt < 4; ++pt) Xs[pt] = as_frag(*(const v4u*)(SST + (((size_t)c * 32 + h) * 2 + d) * 8192 + ((pt * 4 + ks) * 64 + F.lane) * 8));
#pragma unroll
                        for (int tt = 0; tt < 4; ++tt) { const v4u craw = *(const LAS v4u*)(CNt + tile_off(64 * th + 16 * tt + l15, ks * 4 + g4)); const f32x4 e4 = {ev[tt], ev[tt], ev[tt], ev[tt]};
                            const bf16x8 Yc = scale8(craw, e4, e4);
#pragma unroll
                            for (int pt = 0; pt < 4; ++pt) y[tt][pt] = MFMA16(Xs[pt], Yc, y[tt][pt]); }
                    }
                }
#pragma unroll 1
                for (int ks = 0; ks < 4; ++ks) { const int s0 = 32 * ks + 8 * g4;
                    asm volatile("" ::: "memory");
                    bf16x8 Xx[4];
#pragma unroll
                    for (int pt = 0; pt < 4; ++pt) Xx[pt] = as_frag(*(const v4u*)(XT + ((size_t)c * 32 + h) * 8192 + ((pt * 4 + ks) * 64 + F.lane) * 8));
                    f32x4 afs[2], rbs[2], dfs[2], dbs[2];
#pragma unroll
                    for (int hf = 0; hf < 2; ++hf) { afs[hf] = *(const LAS f32x4*)(vec + s0 + 4 * hf); rbs[hf] = *(const LAS f32x4*)(vec + 128 + s0 + 4 * hf); dfs[hf] = *(const LAS f32x4*)(vec + 256 + s0 + 4 * hf); dbs[hf] = *(const LAS f32x4*)(vec + 384 + s0 + 4 * hf); }
#pragma unroll
                    for (int tt = 0; tt < 4; ++tt) { const int tl = 64 * th + 16 * tt + l15; const float aft = vec[tl], rbt = vec[128 + tl]; float m[8];
                        if (ks < 2 * th + (tt >> 1)) {
#pragma unroll
                            for (int hf = 0; hf < 2; ++hf) { const f32x4 cbv = *(const LAS f32x4*)(CB + tl * 132 + s0 + 4 * hf);
#pragma unroll
                                for (int j = 0; j < 4; ++j) m[4 * hf + j] = cbv[j] * dfs[hf][j] * __expf(aft - afs[hf][j]); }
                        } else if (ks > 2 * th + (tt >> 1)) {
#pragma unroll
                            for (int hf = 0; hf < 2; ++hf) { const f32x4 cbv = *(const LAS f32x4*)(CB + tl * 132 + s0 + 4 * hf);
#pragma unroll
                                for (int j = 0; j < 4; ++j) m[4 * hf + j] = cbv[j] * dbs[hf][j] * __expf(rbt - rbs[hf][j]); }
                        } else {
#pragma unroll
                        for (int hf = 0; hf < 2; ++hf) { const f32x4 cbv = *(const LAS f32x4*)(CB + tl * 132 + s0 + 4 * hf);
#pragma unroll
                            for (int j = 0; j < 4; ++j) { const int s = s0 + 4 * hf + j; const float arg = s <= tl ? aft - afs[hf][j] : rbt - rbs[hf][j]; const float cf = s < tl ? dfs[hf][j] : (s > tl ? dbs[hf][j] : dfs[hf][j] + dbs[hf][j]);
                                m[4 * hf + j] = cbv[j] * cf * __expf(arg) + (s == tl ? dsk : 0.f); } }
                        }
                        v4u mp; mp.x = cvt_pk_bf16(m[0], m[1]); mp.y = cvt_pk_bf16(m[2], m[3]); mp.z = cvt_pk_bf16(m[4], m[5]); mp.w = cvt_pk_bf16(m[6], m[7]);
                        const bf16x8 Ym = as_frag(mp);
#pragma unroll
                        for (int pt = 0; pt < 4; ++pt) y[tt][pt] = MFMA16(Xx[pt], Ym, y[tt][pt]); }
                }
                v2u zq[4][4];
#pragma unroll
                for (int tt = 0; tt < 4; ++tt)
#pragma unroll
                    for (int pt = 0; pt < 4; ++pt) zq[tt][pt] = *(const v2u*)(P + pidx((size_t)tok0 + 64 * th + 16 * tt + l15, PC_Z + h * 64 + 16 * pt + 4 * g4));
#pragma unroll
                for (int tt = 0; tt < 4; ++tt) { float ss = 0.f;
#pragma unroll
                    for (int pt = 0; pt < 4; ++pt) { const v2u zz = zq[tt][pt];
                        f32x4 v = y[tt][pt]; v[0] *= silu(bflo(zz.x)); v[1] *= silu(bfhi(zz.x)); v[2] *= silu(bflo(zz.y)); v[3] *= silu(bfhi(zz.y)); y[tt][pt] = v;
                        ss += (v[0] * v[0] + v[1] * v[1]) + (v[2] * v[2] + v[3] * v[3]); }
                    ss += __shfl_xor(ss, 16); ss += __shfl_xor(ss, 32);
                    if (g4 == 0) ssq[F.wave * 64 + 16 * tt + l15] = ss; }
                __syncthreads();
#pragma unroll
                for (int tt = 0; tt < 4; ++tt) { const size_t t = (size_t)tok0 + 64 * th + 16 * tt + l15; float tot = 0.f;
#pragma unroll
                    for (int w = 0; w < 8; ++w) tot += ssq[w * 64 + 16 * tt + l15];
                    const float rstd = 1.0f / sqrtf(tot * (1.0f / 512.0f) + EPS);
#pragma unroll
                    for (int pt = 0; pt < 4; ++pt) { const int ch = h * 64 + 16 * pt + 4 * g4; const f32x4 w = *(const f32x4*)(in[14] + ch);
                        *(v2u*)(Y2S + t * 2048 + ch) = pack4(y[tt][pt] * rstd * w); } }
                __syncthreads();
            }
#endif
        }
    }
    for (int it = F.bid; it < NH3; it += F.G) {
        {
#ifndef SKIP_H3
            if (!(mask & 2)) continue;
            const int hi = it, c = hi >> 4, h = hi & 15, tok0 = c * 128, w = F.wave;
            LAS unsigned char* STf = F.lds; LAS unsigned char* STb = F.lds + 32768; LAS unsigned char* VTt = F.lds + 65536; LAS float* beta = (LAS float*)(F.lds + 98304);
            const bf16* HSTc = hsti_chunk(ws, c);
            const bf16* QT0 = (const bf16*)(ws + WS_QT) + (((size_t)c * 16 + h) * 2) * 16384; const bf16* KD0 = (const bf16*)(ws + WS_KD) + (((size_t)c * 16 + h) * 2) * 16384;
            v4u Qf[2][4];
#pragma unroll
            for (int d = 0; d < 2; ++d)
#pragma unroll
                for (int kk = 0; kk < 4; ++kk) Qf[d][kk] = *(const v4u*)(QT0 + (size_t)d * 16384 + ((w * 4 + kk) * 64 + F.lane) * 8);
            load_tile128(STf, HSTc + ((size_t)h * 2 + 0) * 16384, 128, F.tid);
            load_tile128(STb, HSTc + ((size_t)h * 2 + 1) * 16384, 128, F.tid);
            stage_vimg(VTt, P, tok0, h, F.tid);
            { const int idx = F.tid * 4, d = idx >> 10, I = (idx >> 7) & 7, k = idx & 127;
              *(LAS f32x4*)(beta + idx) = *(const f32x4*)((const float*)(ws + WS_BETA) + ((size_t)(c * 2 + d) * 8 + I) * 2048 + h * 128 + k); }
            __syncthreads();
            const LAS unsigned char* hv[8];
            { const int q = l15 >> 2, p = l15 & 3, T = (p >> 1) ^ ((q << 2) | g4);
#pragma unroll
              for (int vt = 0; vt < 8; ++vt) hv[vt] = VTt + 256 * (4 * g4 + q) + 8 * (p & 1) + ((32 * vt) ^ (16 * T)); }
            f32x4 o[8];
#pragma unroll
            for (int vt = 0; vt < 8; ++vt) o[vt] = (f32x4){0.f, 0.f, 0.f, 0.f};
#pragma unroll
            for (int d = 0; d < 2; ++d) {
                const LAS unsigned char* ST = d ? STb : STf; const LAS float* bw = beta + (d * 8 + w) * 128; const bf16* KDd = KD0 + (size_t)d * 16384;
                v4u kraw[2][2][4];
#define H3_LOADK(buf, ksx) do { _Pragma("unroll") for (int q_ = 0; q_ < 2; ++q_) { const int J_ = 2 * (ksx) + q_; if (d == 0 ? J_ <= w : J_ >= w) { _Pragma("unroll") for (int kk_ = 0; kk_ < 4; ++kk_) \
                        kraw[buf][q_][kk_] = *(const v4u*)(KDd + ((J_ * 4 + kk_) * 64 + F.lane) * 8); } } } while (0)
                H3_LOADK(0, 0);
#pragma unroll
                for (int kk = 0; kk < 4; ++kk) { const f32x4 b0 = *(const LAS f32x4*)(bw + 32 * kk + 8 * g4), b1 = *(const LAS f32x4*)(bw + 32 * kk + 8 * g4 + 4);
                    const f32x4 e0 = {__expf(b0[0]), __expf(b0[1]), __expf(b0[2]), __expf(b0[3])}, e1 = {__expf(b1[0]), __expf(b1[1]), __expf(b1[2]), __expf(b1[3])};
                    const bf16x8 Yq = scale8(Qf[d][kk], e0, e1);
#pragma unroll
                    for (int vt = 0; vt < 8; ++vt) o[vt] = MFMA16(frag(ST, 16 * vt + l15, kk * 4 + g4), Yq, o[vt]); }
#pragma unroll
                for (int ks = 0; ks < 4; ++ks) {
                    if (ks < 3) H3_LOADK((ks + 1) & 1, ks + 1);
                    const int J0 = 2 * ks, J1 = 2 * ks + 1; const bool n0 = d == 0 ? J0 <= w : J0 >= w, n1 = d == 0 ? J1 <= w : J1 >= w;
                    if (n0 || n1) {
                    f32x4 D[2];
#pragma unroll
                    for (int q = 0; q < 2; ++q) { D[q] = (f32x4){0.f, 0.f, 0.f, 0.f}; const int J = 2 * ks + q; const bool need = q ? n1 : n0;
                        if (need) { const LAS float* bj = beta + (d * 8 + J) * 128;
#pragma unroll
                            for (int kk = 0; kk < 4; ++kk) { const v4u raw = kraw[ks & 1][q][kk];
                                bf16x8 Xk;
                                if (J != w) { const f32x4 a0 = *(const LAS f32x4*)(bw + 32 * kk + 8 * g4), a1 = *(const LAS f32x4*)(bw + 32 * kk + 8 * g4 + 4), c0 = *(const LAS f32x4*)(bj + 32 * kk + 8 * g4), c1 = *(const LAS f32x4*)(bj + 32 * kk + 8 * g4 + 4);
                                    const f32x4 f0 = {__expf(a0[0] - c0[0]), __expf(a0[1] - c0[1]), __expf(a0[2] - c0[2]), __expf(a0[3] - c0[3])}, f1 = {__expf(a1[0] - c1[0]), __expf(a1[1] - c1[1]), __expf(a1[2] - c1[2]), __expf(a1[3] - c1[3])};
                                    Xk = scale8(raw, f0, f1); }
                                else Xk = as_frag(raw);
                                D[q] = MFMA16(Xk, as_frag(Qf[d][kk]), D[q]); }
                            if (J == w) {
#pragma unroll
                                for (int r = 0; r < 4; ++r) { const bool keep = d == 0 ? (4 * g4 + r) <= l15 : (4 * g4 + r) >= l15; D[q][r] = keep ? D[q][r] : 0.f; } } } }
                    v4u ap; ap.x = cvt_pk_bf16(D[0][0], D[0][1]); ap.y = cvt_pk_bf16(D[0][2], D[0][3]); ap.z = cvt_pk_bf16(D[1][0], D[1][1]); ap.w = cvt_pk_bf16(D[1][2], D[1][3]);
                    const bf16x8 Ya = as_frag(ap);
#pragma unroll
                    for (int vh = 0; vh < 2; ++vh) { v2u x0[4], x1[4];
#pragma unroll
                        for (int i = 0; i < 4; ++i) { const int vt = 4 * vh + i; x0[i] = vtr(hv[vt] + 8192 * ks); x1[i] = vtr(hv[vt] + 8192 * ks + 4096); }
#pragma unroll
                        for (int i = 0; i < 4; ++i) { const int vt = 4 * vh + i; o[vt] = MFMA16(as_frag((v4u){x0[i].x, x0[i].y, x1[i].x, x1[i].y}), Ya, o[vt]); } }
                    }
                }
#undef H3_LOADK
            }
            { v2u gg[8];
#pragma unroll
              for (int vt = 0; vt < 8; ++vt) gg[vt] = *(const v2u*)(P + pidx((size_t)tok0 + 16 * w + l15, PC_G + h * 128 + 16 * vt + 4 * g4));
              float ss = 0.f;
#pragma unroll
              for (int vt = 0; vt < 8; ++vt) ss += (o[vt][0] * o[vt][0] + o[vt][1] * o[vt][1]) + (o[vt][2] * o[vt][2] + o[vt][3] * o[vt][3]);
              ss += __shfl_xor(ss, 16); ss += __shfl_xor(ss, 32);
              const float rstd = 1.0f / sqrtf(ss * (1.0f / 128.0f) + EPS); const size_t t = (size_t)tok0 + 16 * w + l15; bf16* Y2H = (bf16*)(ws + WS_Y2 + 64 * MiB);
#pragma unroll
              for (int vt = 0; vt < 8; ++vt) { const int vv = 16 * vt + 4 * g4; const f32x4 wn = *(const f32x4*)(in[16] + vv);
                  f32x4 v = o[vt] * rstd * wn; v[0] *= silu(bflo(gg[vt].x)); v[1] *= silu(bfhi(gg[vt].x)); v[2] *= silu(bflo(gg[vt].y)); v[3] *= silu(bfhi(gg[vt].y));
                  *(v2u*)(Y2H + t * 2048 + h * 128 + vv) = pack4(v); } }
            __syncthreads();
#endif
        }
    }
}

struct Args { const float* in[27]; float* out; unsigned char* ws; int ph_lo, ph_hi, mask, pad; };
constexpr int N_PHASES = 15;
__global__ void __launch_bounds__(NWAVES * 64, 2) mega_fwd(Args args) {
    extern __shared__ __attribute__((aligned(16))) unsigned char lds_raw[];
    Ctx F; F.lds = (LAS unsigned char*)lds_raw; F.tid = threadIdx.x; F.lane = F.tid & 63; F.wave = __builtin_amdgcn_readfirstlane(F.tid >> 6); F.G = gridDim.x; F.bid = blockIdx.x;
    unsigned char* ws = args.ws; const float* const* in = args.in;
    volatile LAS unsigned* MISC = (volatile LAS unsigned*)(F.lds + MISC_OFF);
    if (F.tid < 4) MISC[F.tid] = 0u;
    __syncthreads();
    XcdBarrier bar; bar.bar = (unsigned*)(ws + WS_CTL) + CW_BAR; bar.x = 0; bar.st = nullptr;
    if (!MK_PER_PHASE) bar = xcd_barrier_post((unsigned*)(ws + WS_CTL) + CW_BAR, MISC);
    const int lo = args.ph_lo, hi = args.ph_hi;
#define IN(k) (lo <= (k) && (k) < hi)
#ifndef REPEAT_PHASE
#define REPEAT_PHASE -1
#endif
#define REP(k) for (int rep_ = 0; rep_ < ((k) == REPEAT_PHASE ? 2 : 1); ++rep_)
#define SEAM(k) do { if (IN(k) && IN((k) + 1)) xcd_barrier(bar); } while (0)

    if (IN(0)) REP(0) { if (rep_) xcd_barrier(bar); p0_prologue(F, in, ws); } SEAM(0);
    if (IN(1)) REP(1) { if (rep_) xcd_barrier(bar); p1_norm(F, in, ws); p1_router_fold(F, in, ws); } SEAM(1);
    if (IN(2)) REP(2) { if (rep_) xcd_barrier(bar);
        pg8::Gemm g{(const bf16*)(ws + WS_HN), (const bf16*)(ws + WS_WIN), LT, NP, D, nullptr, nullptr}; ConvOrder S; S.init(LT, NP, F.G, F.bid); S.in = in; S.ws = ws; S.scr = (LAS bf16*)(F.lds + CONV_SCR_OFF + F.wave * 2560); S.lane = F.lane; S.stride = F.G * NWAVES; S.cursor = TR_I_HEAD + F.bid * NWAVES + F.wave;
        EpiProj E{(bf16*)(ws + WS_PROJ), (float*)(ws + WS_DTRAW)};
        pg8::gemm_phase<EpiProj, ConvOrder, true, true>(F.lds, g, S, E);
        { const pg8::Unit du{0, 0, 0}; while (S.cursor < TR_I_ALL) S.done(du); }
    } SEAM(2);
#if NAIVE_SCAN
    if (IN(3)) REP(3) { if (rep_) xcd_barrier(bar); p3_prep(F, in, ws); } SEAM(3);
    if (IN(4)) REP(4) { if (rep_) xcd_barrier(bar); p4_ssd_naive(F, in, ws); p5_hgrn_naive(F, in, ws); } SEAM(4);
    SEAM(5);
    if (IN(6)) REP(6) { if (rep_) xcd_barrier(bar); p6_combine_naive(F, in, ws); } SEAM(6);
#else
    if (IN(3)) REP(3) { if (rep_) xcd_barrier(bar); p3_prep2(F, in, ws, args.mask); } SEAM(3);
    if (IN(4)) REP(4) { if (rep_) xcd_barrier(bar); p4_local(F, ws, args.mask); } SEAM(4);
    if (IN(5)) REP(5) { if (rep_) xcd_barrier(bar); p5_scan(F, ws); } SEAM(5);
    if (IN(6)) REP(6) { if (rep_) xcd_barrier(bar); p6_out(F, in, ws, args.mask); } SEAM(6);
#endif
    if (IN(7)) REP(7) { if (rep_) xcd_barrier(bar);
        pg8::Gemm g{(const bf16*)(ws + WS_Y2), (const bf16*)(ws + WS_WBS), L, D, D, (const bf16*)(ws + WS_Y2 + 64 * MiB), (const bf16*)(ws + WS_WBH)}; pg8::PairOrder S; S.init(L, D, F.G, F.bid);
        EpiBranch E{(const bf16*)(ws + WS_PROJ), (bf16*)(ws + WS_YM)};
        pg8::gemm_phase<EpiBranch, pg8::PairOrder, true, true>(F.lds, g, S, E);
    } if (IN(7) && IN(9)) xcd_barrier(bar);
    if (false) {}
    if (IN(9)) REP(9) { if (rep_) xcd_barrier(bar);
        pg8::Gemm g{(const bf16*)(ws + WS_YM), (const bf16*)(ws + WS_WO), L, D, D, nullptr, nullptr}; pg8::StaticOrder S; S.init(L, D, F.G, F.bid);
        EpiOut E{in[0], (const float*)(ws + WS_MOD) + 4096, (bf16*)(ws + WS_H1)};
        pg8::gemm_phase<EpiOut, pg8::StaticOrder, true, true>(F.lds, g, S, E);
    } SEAM(9);
    if (IN(10)) REP(10) { if (rep_) xcd_barrier(bar); p10_route(F, in, ws); } SEAM(10);
    if (IN(11)) REP(11) { if (rep_) xcd_barrier(bar); p11_gather(F, in, ws); } SEAM(11);
    if (IN(12)) REP(12) { if (rep_) xcd_barrier(bar);
        LAS int* blk_e = (LAS int*)(F.lds + MISC_OFF + 1024); LAS int* pad_start = blk_e + MAXBLK; LAS int* nblk_w = pad_start + 32;
        const int nblk = moe_tables(F, ws, blk_e, pad_start, nblk_w);
        pg8::Gemm g{(const bf16*)(ws + WS_XG), (const bf16*)(ws + WS_WGU), MAXSLOT, NEXP * 4096, D, nullptr, nullptr}; pg8::MoeGatherOrder S; S.init(nblk, 16, F.G, F.bid, blk_e);
        { LAS unsigned* rt = (LAS unsigned*)(F.lds + CONV_SCR_OFF); const int* TOK = (const int*)(ws + WS_ROUTE) + 4 * NASSIGN + MAXSLOT; pg8::Unit u;
          for (int i = 0; i < ROWTAB_UNITS && S.next(i, u); ++i) if (F.tid < 256) { const unsigned tk = (unsigned)TOK[u.pm * 256 + F.tid]; rt[i * 256 + F.tid] = (tk < (unsigned)L ? tk : 0u) * (unsigned)(D * 2); }
          S.rowtab = rt; __syncthreads(); }
        EpiMoe1 E{in[23], (bf16*)(ws + WS_ACT)};
        pg8::gemm_phase<EpiMoe1, pg8::MoeGatherOrder, true, true>(F.lds, g, S, E);
    } SEAM(12);
    if (IN(13)) REP(13) { if (rep_) xcd_barrier(bar);
        LAS int* blk_e = (LAS int*)(F.lds + MISC_OFF + 1024); LAS int* pad_start = blk_e + MAXBLK; LAS int* nblk_w = pad_start + 32;
        const int nblk = moe_tables(F, ws, blk_e, pad_start, nblk_w);
        pg8::Gemm g{(const bf16*)(ws + WS_ACT), (const bf16*)(ws + WS_WDN), MAXSLOT, NEXP * 2048, D, nullptr, nullptr}; pg8::MoeOrder S; S.init(nblk, 8, F.G, F.bid, blk_e);
        EpiMoe2 E{in[25], (const float*)(ws + WS_ROUTE) + 4 * NASSIGN, (bf16*)(ws + WS_Y2M)};
        pg8::gemm_phase<EpiMoe2, pg8::MoeOrder, true, true>(F.lds, g, S, E);
    } SEAM(13);
    if (IN(14)) REP(14) { if (rep_) xcd_barrier(bar); p14_final(F, in, args.out, ws); }
#undef IN
#undef SEAM
}

extern "C" void kernel_launch(void* const* d_in, const int* in_sizes, int n_in, void* d_out, int out_size, void* d_ws, size_t ws_size, hipStream_t stream) {
    static int grid = 0;
    if (grid == 0) {
        if (n_in != 27 || in_sizes[0] != L * D || out_size != L * D || ws_size < WS_END) { fprintf(stderr, "kernel_launch: unexpected shapes (n_in %d, in0 %d, out %d, ws %zu < %zu)\n", n_in, n_in > 0 ? in_sizes[0] : -1, out_size, ws_size, (size_t)WS_END); grid = -1; return; }
        int dev = 0, cus = 0, per_cu = 0;
        if (hipGetDevice(&dev) != hipSuccess || hipDeviceGetAttribute(&cus, hipDeviceAttributeMultiprocessorCount, dev) != hipSuccess) { grid = -1; return; }
        if (hipFuncSetAttribute((const void*)mega_fwd, hipFuncAttributeMaxDynamicSharedMemorySize, LDS_BYTES) != hipSuccess) { fprintf(stderr, "kernel_launch: hipFuncSetAttribute failed\n"); grid = -1; return; }
        if (hipOccupancyMaxActiveBlocksPerMultiprocessor(&per_cu, (const void*)mega_fwd, NWAVES * 64, LDS_BYTES) != hipSuccess || per_cu < 1) { fprintf(stderr, "kernel_launch: occupancy query reports %d\n", per_cu); }
        (void)hipGetLastError();
        grid = cus;
    }
    if (grid < 0) return;
    if (hipMemsetAsync((char*)d_ws + WS_CTL, 0, CTL_ZERO_BYTES, stream) != hipSuccess) return;
    Args a{};
    for (int i = 0; i < 27; ++i) a.in[i] = (const float*)d_in[i];
    a.out = (float*)d_out; a.ws = (unsigned char*)d_ws; a.mask = 7;
#if MK_PER_PHASE
    for (int p = 0; p < 15; ++p) { a.ph_lo = p; a.ph_hi = p + 1; hipLaunchKernelGGL(mega_fwd, dim3(grid), dim3(NWAVES * 64), LDS_BYTES, stream, a); }
#else
    a.ph_lo = 0; a.ph_hi = 15; hipLaunchKernelGGL(mega_fwd, dim3(grid), dim3(NWAVES * 64), LDS_BYTES, stream, a);
#endif
#if PROBE_PHASE >= 0
    a.ph_lo = PROBE_PHASE; a.ph_hi = PROBE_PHASE + 1; a.mask = PROBE_MASK; hipLaunchKernelGGL(mega_fwd, dim3(grid), dim3(NWAVES * 64), LDS_BYTES, stream, a);
#endif
}
```

```cpp
#include <hip/hip_runtime.h>
#include <cstdio>
#include <cstdint>

#ifndef NAIVE_SCAN
#define NAIVE_SCAN 0
#endif
#ifndef PROBE_PHASE
#define PROBE_PHASE -1
#endif
#ifndef PROBE_MASK
#define PROBE_MASK 7
#endif
#ifndef MK_PER_PHASE
#define MK_PER_PHASE 0
#endif

#define GAS __attribute__((address_space(1)))
#define LAS __attribute__((address_space(3)))
#define PG8_LAS __attribute__((address_space(3)))
typedef unsigned short bf16;
typedef unsigned v4u __attribute__((ext_vector_type(4)));
typedef unsigned v2u __attribute__((ext_vector_type(2)));
typedef float f32x4 __attribute__((ext_vector_type(4)));
typedef float f32x2 __attribute__((ext_vector_type(2)));
typedef short bf16x8 __attribute__((ext_vector_type(8)));

namespace pg8 {
typedef unsigned short bf16_t;
typedef unsigned u32x4 __attribute__((ext_vector_type(4)));
constexpr int BM = 256, BK = 64, HALF = 128, HTB = HALF * BK * 2  , STAGE_BYTES = 8 * HTB, NXCD = 8, WGM = 8;

__host__ __device__ __forceinline__ int lds_byte(int r, int c) { const int st = (r >> 4) * 2 + (c >> 5), rr = r & 15, cc = c & 31, ob = rr * 64 + cc * 2; return st * 1024 + (ob ^ (((ob >> 9) & 1) << 5)); }
__host__ __device__ __forceinline__ void stage_rc(int b, int& R, int& C) { const int st = b / 1024, sb = b % 1024, swz = sb ^ (((sb >> 9) & 1) << 5); R = (st >> 1) * 16 + swz / 64; C = (st & 1) * 32 + (swz % 64) / 2; }
__host__ __device__ __forceinline__ int perm32(int rho) { const int n = rho >> 4, i = rho & 15; return 8 * (i >> 2) + 4 * n + (i & 3); }

struct Unit { int pm, pn, sel; };
struct Gemm { const bf16_t* A; const bf16_t* Bt; int M, N, K; const bf16_t* A2; const bf16_t* Bt2; };

struct StaticOrder {
    static constexpr bool GATHER = false;
    int nM, nN, nwg, G, c;
    __host__ __device__ void init(int M, int N, int G_, int c_) { nM = M / BM; nN = N / BM; nwg = nM * nN; G = G_; c = c_; }
    __host__ __device__ bool next(int i, Unit& u) const {
        const long L = (long)i * G + c; if (L >= nwg) return false;
        int wgid = (int)L; { const int q = nwg / NXCD, r = nwg % NXCD, xcd = wgid % NXCD, off = wgid / NXCD; wgid = (xcd < r ? xcd * (q + 1) : r * (q + 1) + (xcd - r) * q) + off; }
        const int nig = WGM * nN, gid = wgid / nig, fm = gid * WGM, gsz = (nM - fm) < WGM ? (nM - fm) : WGM;
        u.pm = fm + ((wgid % nig) % gsz); u.pn = (wgid % nig) / gsz; u.sel = 0; return true;
    }
    __device__ __forceinline__ void a_ready(const Unit&) const {}
    __device__ __forceinline__ void done(const Unit&) const {}
};
struct PairOrder : StaticOrder {
    __device__ bool next(int i, Unit& u) const { const bool ok = StaticOrder::next(i >> 1, u); u.sel = i & 1; return ok; }
};
struct MoeOrder {
    static constexpr bool GATHER = false;
    int nM, nN, nwg, G, c; const LAS int* blk_e;
    __device__ void init(int nblk, int NT, int G_, int c_, const LAS int* tbl) { nM = nblk; nN = NT; nwg = nM * nN; G = G_; c = c_; blk_e = tbl; }
    __device__ __forceinline__ bool next(int i, Unit& u) const {
        const long L = (long)i * G + c; if (L >= nwg) return false;
        int wgid = (int)L; { const int q = nwg / NXCD, r = nwg % NXCD, xcd = wgid % NXCD, off = wgid / NXCD; wgid = (xcd < r ? xcd * (q + 1) : r * (q + 1) + (xcd - r) * q) + off; }
        const int nig = WGM * nN, gid = wgid / nig, fm = gid * WGM, gsz = (nM - fm) < WGM ? (nM - fm) : WGM;
        u.pm = fm + ((wgid % nig) % gsz); u.pn = blk_e[u.pm] * nN + (wgid % nig) / gsz; u.sel = 0; return true;
    }
    __device__ __forceinline__ void a_ready(const Unit&) const {}
    __device__ __forceinline__ void done(const Unit&) const {}
};

struct MoeGatherOrder : MoeOrder { static constexpr bool GATHER = true; const LAS unsigned* rowtab; };

typedef __bf16 bf16x2_t __attribute__((ext_vector_type(2)));
typedef float f32x2_t __attribute__((ext_vector_type(2)));
__device__ __forceinline__ unsigned cvt_pk_bf16(float lo, float hi) { const f32x2_t v = {lo, hi}; const bf16x2_t r = __builtin_convertvector(v, bf16x2_t); return __builtin_bit_cast(unsigned, r); }

template <class Epi, class Sched, bool ALIGN_EPI = false, bool SP2 = false>
__device__ __forceinline__ void gemm_phase(PG8_LAS unsigned char* lds, const Gemm g, const Sched& S, const Epi& E) {
    const int tid = threadIdx.x, wid = __builtin_amdgcn_readfirstlane(tid >> 6), lane = tid & 63, wr = wid >> 2, wc = wid & 3, fr = lane & 15, fq = lane >> 4;
    const int K = g.K, nt = K / BK;
    unsigned voffA[2], voffB[2];
#pragma unroll
    for (int i = 0; i < 2; ++i) { int R, C; stage_rc(tid * 16 + i * 8192, R, C); const int Rb = Epi::PERM ? ((R & ~31) + perm32(R & 31)) : R;
        voffA[i] = (unsigned)(R * K + C) * 2u; voffB[i] = (unsigned)(Rb * K + C) * 2u; }
    unsigned vC[2][2] = {{0u, 0u}, {0u, 0u}}, vN[2][2] = {{0u, 0u}, {0u, 0u}};
#define PG8_ROWOFF(dst, unit_) do { _Pragma("unroll") for (int i_ = 0; i_ < 2; ++i_) { int R_, C_; stage_rc(tid * 16 + i_ * 8192, R_, C_); \
        dst[0][i_] = S.rowtab[(unit_) * 256 + R_] + (unsigned)C_ * 2u; dst[1][i_] = S.rowtab[(unit_) * 256 + 128 + R_] + (unsigned)C_ * 2u; } } while (0)
    const size_t kstep = (size_t)(BK * 2);
    const size_t hstep = (size_t)HALF * K * 2;
    const size_t tstep = 2 * hstep;
    const size_t tstepA = Sched::GATHER ? (size_t)0 : tstep;
    const unsigned ldsw = (unsigned)wid * 1024u;
    const int aoff = lds_byte(wr * 64 + fr, fq * 8), boff = lds_byte(wc * 32 + fr, fq * 8);
#define PG8_SA(b, h) (((b) * 2 + (h)) * HTB)
#define PG8_SB(b, h) ((4 + (b) * 2 + (h)) * HTB)
#define PG8_STAGE(bufoff, gbase, voff) do { _Pragma("unroll") for (int _i = 0; _i < 2; ++_i) \
        __builtin_amdgcn_global_load_lds((const unsigned*)((const char*)(gbase) + (voff)[_i]), (PG8_LAS unsigned*)(lds + (bufoff) + ldsw + _i * 8192), 16, 0, 0); } while (0)
#define PG8_STAGE_A(bufoff, kptr, half, nx) do { if constexpr (Sched::GATHER) { _Pragma("unroll") for (int _i = 0; _i < 2; ++_i) \
        __builtin_amdgcn_global_load_lds((const unsigned*)((const char*)(kptr) + ((nx) ? vN[half][_i] : vC[half][_i])), (PG8_LAS unsigned*)(lds + (bufoff) + ldsw + _i * 8192), 16, 0, 0); } \
    else { PG8_STAGE(bufoff, (kptr) + ((half) ? hstep : (size_t)0), voffA); } } while (0)
#define PG8_LDA(dst, b, h) do { _Pragma("unroll") for (int m = 0; m < 4; ++m) _Pragma("unroll") for (int k = 0; k < 2; ++k) dst[m][k] = *(const PG8_LAS bf16x8*)(lds + PG8_SA(b, h) + aoff + m * 2048 + k * 1024); } while (0)
#define PG8_LDB(dst, b, h) do { _Pragma("unroll") for (int n = 0; n < 2; ++n) _Pragma("unroll") for (int k = 0; k < 2; ++k) dst[n][k] = *(const PG8_LAS bf16x8*)(lds + PG8_SB(b, h) + boff + n * 2048 + k * 1024); } while (0)
#define PG8_MMA(ai, bj, At, Bt) do { __builtin_amdgcn_s_setprio(1); _Pragma("unroll") for (int m = 0; m < 4; ++m) _Pragma("unroll") for (int n = 0; n < 2; ++n) _Pragma("unroll") for (int k = 0; k < 2; ++k) \
        acc[ai][bj][m][n] = __builtin_amdgcn_mfma_f32_16x16x32_bf16(Bt[n][k], At[m][k], acc[ai][bj][m][n], 0, 0, 0); __builtin_amdgcn_s_setprio(0); } while (0)
#define PG8_WAIT_V(n) asm volatile("s_waitcnt vmcnt(" #n ")" ::: "memory")
#define PG8_WAIT_L(n) asm volatile("s_waitcnt lgkmcnt(" #n ")" ::: "memory")
#define PG8_BAR __builtin_amdgcn_s_barrier()
#define PG8_SCHED __builtin_amdgcn_sched_barrier(0)
    Unit cur, nxt; int ui = 0;
    if (!S.next(0, cur)) return;
    f32x4 acc[2][2][4][2];
#pragma unroll
    for (int a = 0; a < 2; ++a)
#pragma unroll
        for (int b = 0; b < 2; ++b)
#pragma unroll
            for (int m = 0; m < 4; ++m)
#pragma unroll
                for (int n = 0; n < 2; ++n) acc[a][b][m][n] = (f32x4){0.f, 0.f, 0.f, 0.f};
    bf16x8 At[4][2], B0[2][2], B1[2][2];
    const char* cA = (const char*)(cur.sel ? g.A2 : g.A) + (size_t)cur.pm * tstepA; const char* cB = (const char*)(cur.sel ? g.Bt2 : g.Bt) + (size_t)cur.pn * tstep;
    if constexpr (Sched::GATHER) PG8_ROWOFF(vC, 0);
    S.a_ready(cur);
    if constexpr (SP2) {
        PG8_STAGE(PG8_SB(0, 0), cB, voffB); PG8_STAGE(PG8_SB(0, 1), cB + hstep, voffB); PG8_STAGE_A(PG8_SA(0, 0), cA, 0, false); PG8_STAGE_A(PG8_SA(0, 1), cA, 1, false);
        if (wr == 1) PG8_BAR;
        PG8_WAIT_V(2); PG8_BAR;
        PG8_STAGE(PG8_SB(1, 0), cB + kstep, voffB); PG8_STAGE_A(PG8_SA(1, 0), cA + kstep, 0, false); PG8_STAGE(PG8_SB(1, 1), cB + hstep + kstep, voffB);
        PG8_WAIT_V(6); PG8_BAR;
    } else {
        PG8_STAGE(PG8_SB(0, 0), cB, voffB); PG8_STAGE(PG8_SA(0, 0), cA, voffA); PG8_STAGE(PG8_SB(0, 1), cB + hstep, voffB); PG8_STAGE(PG8_SA(0, 1), cA + hstep, voffA);
        if (wr == 1) PG8_BAR;
        PG8_WAIT_V(4); PG8_BAR;
        PG8_STAGE(PG8_SB(1, 0), cB + kstep, voffB); PG8_STAGE(PG8_SA(1, 0), cA + kstep, voffA); PG8_STAGE(PG8_SB(1, 1), cB + hstep + kstep, voffB);
        PG8_WAIT_V(6); PG8_BAR;
    }
    for (;;) {
        const bool has_next = S.next(ui + 1, nxt);
        if constexpr (Sched::GATHER) { if (has_next) PG8_ROWOFF(vN, ui + 1); else { vN[0][0] = vC[0][0]; vN[0][1] = vC[0][1]; vN[1][0] = vC[1][0]; vN[1][1] = vC[1][1]; } }
        const char* nA = has_next ? (const char*)(nxt.sel ? g.A2 : g.A) + (size_t)nxt.pm * tstepA : cA; const char* nB = has_next ? (const char*)(nxt.sel ? g.Bt2 : g.Bt) + (size_t)nxt.pn * tstep : cB;
        for (int t = 0; t < nt; t += 2) {
            const bool last = (t == nt - 2);
            const char* a1 = cA + (size_t)(t + 1) * kstep;
            const char* a2 = last ? nA : cA + (size_t)(t + 2) * kstep; const char* b2 = last ? nB : cB + (size_t)(t + 2) * kstep;
            const char* a3 = a2 + kstep; const char* b3 = b2 + kstep;
            if (last && has_next) S.a_ready(nxt);
            if constexpr (SP2) {
            PG8_LDB(B0, 0, 0); PG8_LDB(B1, 0, 1); PG8_SCHED; PG8_LDA(At, 0, 0); PG8_STAGE_A(PG8_SA(1, 1), a1, 1, false);
            PG8_WAIT_V(8); PG8_WAIT_L(0); PG8_BAR; PG8_MMA(0, 0, At, B0); PG8_MMA(0, 1, At, B1); PG8_BAR; PG8_SCHED;
            PG8_LDA(At, 0, 1); PG8_STAGE(PG8_SB(0, 0), b2, voffB); PG8_STAGE(PG8_SB(0, 1), b2 + hstep, voffB); PG8_STAGE_A(PG8_SA(0, 0), a2, 0, last);
            PG8_WAIT_V(8); PG8_WAIT_L(0); PG8_BAR; PG8_MMA(1, 0, At, B0); PG8_MMA(1, 1, At, B1); PG8_BAR; PG8_SCHED;
            PG8_LDB(B0, 1, 0); PG8_LDB(B1, 1, 1); PG8_SCHED; PG8_LDA(At, 1, 0); PG8_STAGE_A(PG8_SA(0, 1), a2, 1, last);
            PG8_WAIT_V(8); PG8_WAIT_L(0); PG8_BAR; PG8_MMA(0, 0, At, B0); PG8_MMA(0, 1, At, B1); PG8_BAR; PG8_SCHED;
            PG8_LDA(At, 1, 1); PG8_STAGE(PG8_SB(1, 0), b3, voffB); PG8_STAGE(PG8_SB(1, 1), b3 + hstep, voffB); PG8_STAGE_A(PG8_SA(1, 0), a3, 0, last);
            PG8_WAIT_V(8); PG8_WAIT_L(0); PG8_BAR; PG8_MMA(1, 0, At, B0); PG8_MMA(1, 1, At, B1); PG8_BAR; PG8_SCHED;
            } else {
            PG8_LDB(B0, 0, 0); PG8_SCHED; PG8_LDA(At, 0, 0); PG8_STAGE(PG8_SA(1, 1), a1 + hstep, voffA);
            PG8_WAIT_L(8); PG8_BAR; PG8_WAIT_L(0); PG8_MMA(0, 0, At, B0); PG8_BAR; PG8_SCHED;
            PG8_LDB(B1, 0, 1); PG8_STAGE(PG8_SB(0, 0), b2, voffB);
            PG8_BAR; PG8_WAIT_L(0); PG8_MMA(0, 1, At, B1); PG8_BAR;
            PG8_LDA(At, 0, 1); PG8_STAGE(PG8_SA(0, 0), a2, voffA);
            PG8_BAR; PG8_WAIT_L(0); PG8_MMA(1, 0, At, B0); PG8_BAR; PG8_SCHED;
            PG8_STAGE(PG8_SB(0, 1), b2 + hstep, voffB);
            PG8_WAIT_V(6); PG8_BAR; PG8_MMA(1, 1, At, B1); PG8_BAR;
            PG8_LDB(B0, 1, 0); PG8_SCHED; PG8_LDA(At, 1, 0); PG8_STAGE(PG8_SA(0, 1), a2 + hstep, voffA);
            PG8_WAIT_L(8); PG8_BAR; PG8_WAIT_L(0); PG8_MMA(0, 0, At, B0); PG8_BAR; PG8_SCHED;
            PG8_LDB(B1, 1, 1); PG8_STAGE(PG8_SB(1, 0), b3, voffB);
            PG8_BAR; PG8_WAIT_L(0); PG8_MMA(0, 1, At, B1); PG8_BAR;
            PG8_LDA(At, 1, 1); PG8_STAGE(PG8_SA(1, 0), a3, voffA);
            PG8_BAR; PG8_WAIT_L(0); PG8_MMA(1, 0, At, B0); PG8_BAR; PG8_SCHED;
            PG8_STAGE(PG8_SB(1, 1), b3 + hstep, voffB);
            PG8_WAIT_V(6); PG8_BAR; PG8_MMA(1, 1, At, B1); PG8_BAR;
            }
        }
        if constexpr (ALIGN_EPI) { if (wr == 0) PG8_BAR; }
        bool keep = false;
        if constexpr (!Epi::AFTER_DRAIN) { if constexpr (Epi::CHAIN) keep = E.chain(acc, cur, wr, wc, fr, fq); else E(acc, cur, wr, wc, fr, fq); S.done(cur); }
        if (!has_next) break;
        if (!keep) {
#pragma unroll
        for (int a = 0; a < 2; ++a)
#pragma unroll
            for (int b = 0; b < 2; ++b)
#pragma unroll
                for (int m = 0; m < 4; ++m)
#pragma unroll
                    for (int n = 0; n < 2; ++n) acc[a][b][m][n] = (f32x4){0.f, 0.f, 0.f, 0.f};
        }
        cur = nxt; cA = nA; cB = nB; ++ui; vC[0][0] = vN[0][0]; vC[0][1] = vN[0][1]; vC[1][0] = vN[1][0]; vC[1][1] = vN[1][1];
        if constexpr (ALIGN_EPI) { if (wr == 1) PG8_BAR; }
    }
    PG8_WAIT_V(0);
    if constexpr (!ALIGN_EPI) { if (wr == 0) PG8_BAR; }
    PG8_BAR;
    if constexpr (Epi::AFTER_DRAIN) { E.fused(acc, cur, wr, wc, fr, fq, lds, wid, lane); S.done(cur); }
#undef PG8_SA
#undef PG8_SB
#undef PG8_STAGE
#undef PG8_LDA
#undef PG8_LDB
#undef PG8_MMA
#undef PG8_WAIT_V
#undef PG8_WAIT_L
#undef PG8_BAR
#undef PG8_SCHED
#undef PG8_STAGE_A
#undef PG8_ROWOFF
}

}

constexpr int D = 2048, L = 16384, LC = 256, LT = L + LC;
constexpr int NP = 19712;
constexpr int PW = 19456;
constexpr int PC_Z = 0, PC_X = 2048, PC_B = 4096, PC_C = 4608, PC_Q = 5120, PC_FF = 7168, PC_FB = 9216, PC_I = 11264, PC_G = 13312, PC_GS = 15360, PC_GH = 17408, PC_DT = 19456;
constexpr int NEXP = 32, TOPK = 4, NASSIGN = L * TOPK, MAXBLK = 288, MAXSLOT = MAXBLK * 256;
constexpr float EPS = 1e-6f;
__device__ __forceinline__ size_t pidx(size_t t, int col) { return ((size_t)(col >> 7) * LT + t) * 128 + (size_t)(col & 127); }

constexpr size_t MiB = 1u << 20;
constexpr size_t WS_CTL = 0, CTL_ZERO_BYTES = 65536;
constexpr size_t WS_MOD = 1 * MiB;
constexpr size_t WS_WR2 = WS_MOD + 131072;
constexpr size_t WS_RSTD = WS_MOD + 524288;
constexpr size_t WS_WIN = 2 * MiB;
constexpr size_t WS_WBS = 80 * MiB, WS_WBH = 88 * MiB, WS_WO = 96 * MiB;
constexpr size_t WS_WGU = 104 * MiB;
constexpr size_t WS_WDN = 616 * MiB;
constexpr size_t WS_HN = 872 * MiB;
constexpr size_t WS_PROJ = 937 * MiB;
constexpr size_t WS_DTRAW = 1555 * MiB;
constexpr size_t WS_XS = 1560 * MiB;
constexpr size_t WS_BN = 1625 * MiB, WS_CN = 1642 * MiB;
constexpr size_t WS_DTV = 1659 * MiB;
constexpr size_t WS_XT = 1664 * MiB;
constexpr size_t WS_BT = 1729 * MiB;
constexpr size_t WS_YF = 1746 * MiB, WS_YB = 1874 * MiB, WS_OF = 2002 * MiB, WS_OB = 2130 * MiB;
constexpr size_t WS_ACS = 1746 * MiB;
constexpr size_t WS_SST = 1751 * MiB;
constexpr size_t WS_HST = 1881 * MiB;
constexpr size_t WS_BETA = 2011 * MiB;
constexpr size_t WS_DEC = 2028 * MiB;
constexpr size_t WS_VT = 2031 * MiB;
constexpr size_t WS_QT = 2096 * MiB;
constexpr size_t WS_Y2 = 2258 * MiB;
constexpr size_t WS_PART = 2386 * MiB;
constexpr size_t WS_YM = 2514 * MiB;
constexpr size_t WS_H1 = 2578 * MiB;
constexpr size_t WS_HN2 = 2706 * MiB;
constexpr size_t WS_ROUTE = 2770 * MiB;
constexpr size_t WS_XG = 2772 * MiB, WS_ACT = 3060 * MiB, WS_Y2M = 3348 * MiB;
constexpr size_t WS_KD = 3636 * MiB;
constexpr size_t WS_KHT = 3766 * MiB;
constexpr size_t WS_SSTI = 3896 * MiB;
constexpr size_t WS_HSTI0 = WS_XS, WS_HSTI1 = 4024 * MiB;
constexpr size_t WS_END = 4088 * MiB;
static_assert(WS_WIN + (size_t)NP * D * 2 <= WS_WBS && WS_PROJ + (size_t)LT * PW * 2 <= WS_DTRAW && WS_DTRAW + (size_t)LT * 64 * 4 <= WS_XS && WS_BN + (size_t)LT * 512 * 2 <= WS_CN &&
              WS_CN + (size_t)LT * 512 * 2 <= WS_DTV && WS_DTV + (size_t)LT * 64 * 4 <= WS_XT && WS_BT + (size_t)LT * 512 * 2 <= WS_YF && WS_XG + (size_t)MAXSLOT * D * 2 <= WS_ACT, "d_ws map");
constexpr int CW_BAR = 4096;
constexpr int CW_GCNT = 8192;

constexpr int RING_BYTES = 131072;
constexpr int MISC_OFF = RING_BYTES;
constexpr int LDS_BYTES = 163840;
constexpr int ROWTAB_UNITS = (LDS_BYTES - RING_BYTES - 4096) / 1024;
constexpr int CONV_SCR_OFF = RING_BYTES + 4096;
constexpr int NWAVES = 8;

#define LDS_WAIT() asm volatile("s_waitcnt lgkmcnt(0)" ::: "memory")
#define VM_WAIT() asm volatile("s_waitcnt vmcnt(0)" ::: "memory")
__device__ __forceinline__ unsigned f2bf(float f) { unsigned u = __float_as_uint(f); return (u + 0x7fffu + ((u >> 16) & 1u)) >> 16; }
__device__ __forceinline__ unsigned pk2(float lo, float hi) { return f2bf(lo) | (f2bf(hi) << 16); }
__device__ __forceinline__ float bflo(unsigned w) { return __uint_as_float(w << 16); }
__device__ __forceinline__ float bfhi(unsigned w) { return __uint_as_float(w & 0xffff0000u); }
__device__ __forceinline__ float bf1(bf16 h) { return __uint_as_float(((unsigned)h) << 16); }
__device__ __forceinline__ float sigm(float x) { return __builtin_amdgcn_rcpf(1.f + __expf(-x)); }
__device__ __forceinline__ float silu(float x) { return x * __builtin_amdgcn_rcpf(1.f + __expf(-x)); }
__device__ __forceinline__ float wave_sum(float v) {
#pragma unroll
    for (int o = 1; o < 64; o <<= 1) v += __shfl_xor(v, o);
    return v;
}

#define XB_TMO      128
#define XB_XCNT(j)  (256  + 64 * (j))
#define XB_XSUB(j)  (1280 + 64 * (j))
#define XB_XGEN(j)  (2304 + 64 * (j))
#define XB_TOP      3328
#define XB_TOPGEN   3392
#define XCD_BAR_WORDS 3456
#define XB_SPIN_CAP (1u << 18)

__device__ __forceinline__ unsigned xb_ld(unsigned* p)              { return __hip_atomic_load(p, __ATOMIC_RELAXED, __HIP_MEMORY_SCOPE_AGENT); }
__device__ __forceinline__ unsigned xb_add(unsigned* p, unsigned v) { return __hip_atomic_fetch_add(p, v, __ATOMIC_RELAXED, __HIP_MEMORY_SCOPE_AGENT); }
__device__ __forceinline__ unsigned xb_xcc_id() { return (unsigned)__builtin_amdgcn_s_getreg((3 << 11) | 20) & 0xFu; }
#define XB_SPIN(cond, bar) do { unsigned _sp = 0; while (cond) { __builtin_amdgcn_s_sleep(1); \
    if ((++_sp & 255u) == 0u) { if (xb_ld(&(bar)[XB_TMO])) break; if (_sp > XB_SPIN_CAP) { atomicAdd(&(bar)[XB_TMO], 1u); break; } } } } while (0)

struct XcdBarrier {
    unsigned* bar; unsigned x;
    volatile LAS unsigned* st;
};

__device__ __forceinline__ XcdBarrier xcd_barrier_post(unsigned* bar, volatile LAS unsigned* st) {
    XcdBarrier b; b.bar = bar; b.x = xb_xcc_id(); b.st = st;
    if (threadIdx.x == 0) (void)xb_add(&bar[XB_XCNT(b.x)], 1u);
    return b;
}
__device__ __forceinline__ void xcd_barrier_complete(unsigned* bar, unsigned x, unsigned& nloc, unsigned& nx) {
    const unsigned G = gridDim.x * gridDim.y * gridDim.z;
    unsigned sum, cnt, mine, sp = 0u;
    for (;;) {
        sum = 0u; cnt = 0u; mine = 0u;
#pragma unroll
        for (unsigned j = 0; j < 16; ++j) { const unsigned c = xb_ld(&bar[XB_XCNT(j)]); sum += c; cnt += (c > 0u) ? 1u : 0u; mine = (j == x) ? c : mine; }
        if (sum == G) break;
        __builtin_amdgcn_s_sleep(1);
        if ((++sp & 255u) == 0u) { if (xb_ld(&bar[XB_TMO])) break; if (sp > XB_SPIN_CAP) { atomicAdd(&bar[XB_TMO], 1u); break; } }
    }
    nloc = mine > 0u ? mine : 1u; nx = cnt > 0u ? cnt : 1u;
}

__device__ __forceinline__ void xcd_barrier(const XcdBarrier& b) {
    asm volatile("s_waitcnt vmcnt(0)" ::: "memory");
    __syncthreads();
    if (threadIdx.x == 0) {
        unsigned* bar = b.bar;
        __builtin_amdgcn_s_waitcnt(0);
        unsigned nloc = b.st[0], nx = b.st[1];
        if (nloc == 0u) { xcd_barrier_complete(bar, b.x, nloc, nx); b.st[0] = nloc; b.st[1] = nx; }
        const unsigned old = xb_add(&bar[XB_XSUB(b.x)], 1u);
        const unsigned gen = old / nloc;
        if (old + 1u == (gen + 1u) * nloc) {
            __builtin_amdgcn_fence(__ATOMIC_RELEASE, "agent");
            asm volatile("s_waitcnt vmcnt(0)" ::: "memory");
            const unsigned og = xb_add(&bar[XB_TOP], 1u);
            const unsigned tg = og / nx;
            if (og + 1u == (tg + 1u) * nx) xb_add(&bar[XB_TOPGEN], 1u);
            else XB_SPIN(xb_ld(&bar[XB_TOPGEN]) == tg, bar);
            __builtin_amdgcn_fence(__ATOMIC_ACQUIRE, "agent");
            xb_add(&bar[XB_XGEN(b.x)], 1u);
            asm volatile("s_waitcnt vmcnt(0)" ::: "memory");
        } else {
            XB_SPIN(xb_ld(&bar[XB_XGEN(b.x)]) == gen, bar);
            __builtin_amdgcn_fence(__ATOMIC_ACQUIRE, "agent");
            asm volatile("s_waitcnt vmcnt(0)" ::: "memory");
        }
    }
    __syncthreads();
}

using pg8::Unit; using pg8::cvt_pk_bf16;
struct EpiProj {
    static constexpr bool PERM = true, AFTER_DRAIN = false, CHAIN = false;
    bf16* P; float* dtraw;
    __device__ __forceinline__ void operator()(const f32x4 (&acc)[2][2][4][2], const Unit& u, int wr, int wc, int fr, int fq) const {
        const int row0 = u.pm * 256 + wr * 64 + fr;
        if (u.pn < PW / 256) {
            const int col0 = u.pn * 256 + wc * 32 + 8 * fq; const bool si = u.pn >= PC_I / 256 && u.pn < (PC_I + 2048) / 256;
#pragma unroll
            for (int ai = 0; ai < 2; ++ai)
#pragma unroll
                for (int m = 0; m < 4; ++m) { bf16* rowp = P + pidx((size_t)(row0 + ai * 128 + m * 16), col0);
#pragma unroll
                    for (int bj = 0; bj < 2; ++bj) { f32x4 v0 = acc[ai][bj][m][0], v1 = acc[ai][bj][m][1];
                        if (si) {
#pragma unroll
                            for (int e_ = 0; e_ < 4; ++e_) { v0[e_] = silu(v0[e_]); v1[e_] = silu(v1[e_]); } }
                        v4u w; w.x = cvt_pk_bf16(v0[0], v0[1]); w.y = cvt_pk_bf16(v0[2], v0[3]); w.z = cvt_pk_bf16(v1[0], v1[1]); w.w = cvt_pk_bf16(v1[2], v1[3]);
                        *(v4u*)(rowp + (size_t)bj * LT * 128) = w; } }
        } else if (wc < 2) {
#pragma unroll
            for (int ai = 0; ai < 2; ++ai)
#pragma unroll
                for (int m = 0; m < 4; ++m) { float* rp = dtraw + (size_t)(row0 + ai * 128 + m * 16) * 64 + wc * 32 + 8 * fq;
                    *(f32x4*)rp = acc[ai][0][m][0]; *(f32x4*)(rp + 4) = acc[ai][0][m][1]; }
        }
    }
};
struct EpiBranch {
    static constexpr bool PERM = true, AFTER_DRAIN = false, CHAIN = true;
    const bf16* P; bf16* ym;
    __device__ __forceinline__ bool chain(f32x4 (&acc)[2][2][4][2], const Unit& u, int wr, int wc, int fr, int fq) const { if (u.sel == 0) { mid(acc, u, wr, wc, fr, fq); return true; } fin(acc, u, wr, wc, fr, fq); return false; }
    __device__ __forceinline__ void mid(f32x4 (&acc)[2][2][4][2], const Unit& u, int wr, int wc, int fr, int fq) const {
        const int row0 = u.pm * 256 + wr * 64 + fr, col0 = u.pn * 256 + wc * 32 + 8 * fq;
#pragma unroll
        for (int ai = 0; ai < 2; ++ai) { v4u gs[4][2], gh[4][2];
#pragma unroll
            for (int m = 0; m < 4; ++m)
#pragma unroll
                for (int bj = 0; bj < 2; ++bj) { const size_t r = (size_t)(row0 + ai * 128 + m * 16); gs[m][bj] = *(const v4u*)(P + pidx(r, PC_GS + col0 + bj * 128)); gh[m][bj] = *(const v4u*)(P + pidx(r, PC_GH + col0 + bj * 128)); }
#pragma unroll
            for (int m = 0; m < 4; ++m)
#pragma unroll
                for (int bj = 0; bj < 2; ++bj) { const unsigned gsw[4] = {gs[m][bj].x, gs[m][bj].y, gs[m][bj].z, gs[m][bj].w}, ghw[4] = {gh[m][bj].x, gh[m][bj].y, gh[m][bj].z, gh[m][bj].w};
#pragma unroll
                    for (int q = 0; q < 4; ++q) { const float r0 = (1.f + __expf(-bflo(ghw[q]))) * __builtin_amdgcn_rcpf(1.f + __expf(-bflo(gsw[q]))), r1 = (1.f + __expf(-bfhi(ghw[q]))) * __builtin_amdgcn_rcpf(1.f + __expf(-bfhi(gsw[q])));
                        acc[ai][bj][m][q >> 1][2 * (q & 1)] *= r0; acc[ai][bj][m][q >> 1][2 * (q & 1) + 1] *= r1; } }
            asm volatile("" ::: "memory"); }
    }
    __device__ __forceinline__ void fin(const f32x4 (&acc)[2][2][4][2], const Unit& u, int wr, int wc, int fr, int fq) const {
        const int row0 = u.pm * 256 + wr * 64 + fr, col0 = u.pn * 256 + wc * 32 + 8 * fq;
#pragma unroll
        for (int ai = 0; ai < 2; ++ai) { v4u gh[4][2];
#pragma unroll
            for (int m = 0; m < 4; ++m)
#pragma unroll
                for (int bj = 0; bj < 2; ++bj) gh[m][bj] = *(const v4u*)(P + pidx((size_t)(row0 + ai * 128 + m * 16), PC_GH + col0 + bj * 128));
#pragma unroll
            for (int m = 0; m < 4; ++m) { const size_t r = (size_t)(row0 + ai * 128 + m * 16);
#pragma unroll
                for (int bj = 0; bj < 2; ++bj) { const int c = col0 + bj * 128; const v4u g = gh[m][bj];
                    f32x4 v0 = acc[ai][bj][m][0], v1 = acc[ai][bj][m][1];
                    v0[0] *= sigm(bflo(g.x)); v0[1] *= sigm(bfhi(g.x)); v0[2] *= sigm(bflo(g.y)); v0[3] *= sigm(bfhi(g.y));
                    v1[0] *= sigm(bflo(g.z)); v1[1] *= sigm(bfhi(g.z)); v1[2] *= sigm(bflo(g.w)); v1[3] *= sigm(bfhi(g.w));
                    v4u w; w.x = cvt_pk_bf16(v0[0], v0[1]); w.y = cvt_pk_bf16(v0[2], v0[3]); w.z = cvt_pk_bf16(v1[0], v1[1]); w.w = cvt_pk_bf16(v1[2], v1[3]);
                    *(v4u*)(ym + r * D + c) = w; } }
            asm volatile("" ::: "memory"); }
    }
};
struct EpiOut {
    static constexpr bool PERM = true, AFTER_DRAIN = false, CHAIN = false;
    const float* x; const float* g1; bf16* h1;
    __device__ __forceinline__ void operator()(const f32x4 (&acc)[2][2][4][2], const Unit& u, int wr, int wc, int fr, int fq) const {
        const int row0 = u.pm * 256 + wr * 64 + fr, col0 = u.pn * 256 + wc * 32 + 8 * fq;
        f32x4 gv[2][2];
#pragma unroll
        for (int bj = 0; bj < 2; ++bj) { gv[bj][0] = *(const f32x4*)(g1 + col0 + bj * 128); gv[bj][1] = *(const f32x4*)(g1 + col0 + bj * 128 + 4); }
#pragma unroll
        for (int ai = 0; ai < 2; ++ai) { f32x4 xv[4][2][2];
#pragma unroll
            for (int m = 0; m < 4; ++m)
#pragma unroll
                for (int bj = 0; bj < 2; ++bj) { const float* xp = x + (size_t)(row0 + ai * 128 + m * 16) * D + col0 + bj * 128; xv[m][bj][0] = *(const f32x4*)xp; xv[m][bj][1] = *(const f32x4*)(xp + 4); }
#pragma unroll
            for (int m = 0; m < 4; ++m) { const size_t r = (size_t)(row0 + ai * 128 + m * 16);
#pragma unroll
                for (int bj = 0; bj < 2; ++bj) { const int c = col0 + bj * 128;
                    const f32x4 o0 = xv[m][bj][0] + gv[bj][0] * acc[ai][bj][m][0], o1 = xv[m][bj][1] + gv[bj][1] * acc[ai][bj][m][1];
                    v4u w; w.x = cvt_pk_bf16(o0[0], o0[1]); w.y = cvt_pk_bf16(o0[2], o0[3]); w.z = cvt_pk_bf16(o1[0], o1[1]); w.w = cvt_pk_bf16(o1[2], o1[3]);
                    *(v4u*)(h1 + r * D + c) = w; } }
            asm volatile("" ::: "memory"); }
    }
};
struct EpiMoe1 {
    static constexpr bool PERM = true, AFTER_DRAIN = false, CHAIN = false;
    const float* bgu; bf16* act;
    __device__ __forceinline__ void operator()(const f32x4 (&acc)[2][2][4][2], const Unit& u, int wr, int wc, int fr, int fq) const {
        const int e = u.pn >> 4, j = u.pn & 15, row0 = u.pm * 256 + wr * 64 + fr, gcol = 128 * j + wc * 32 + 8 * fq;
        const float* bb = bgu + (size_t)e * 4096 + gcol;
        f32x4 bg[2], bu[2];
        bg[0] = *(const f32x4*)bb; bg[1] = *(const f32x4*)(bb + 4); bu[0] = *(const f32x4*)(bb + 2048); bu[1] = *(const f32x4*)(bb + 2052);
#pragma unroll
        for (int ai = 0; ai < 2; ++ai)
#pragma unroll
            for (int m = 0; m < 4; ++m) { const size_t r = (size_t)(row0 + ai * 128 + m * 16); float o[8];
#pragma unroll
                for (int n = 0; n < 2; ++n)
#pragma unroll
                    for (int i = 0; i < 4; ++i) { float gt = acc[ai][0][m][n][i] + bg[n][i], up = acc[ai][1][m][n][i] + bu[n][i];
                        gt = fminf(gt, 7.0f); up = fminf(fmaxf(up, -7.0f), 7.0f);
                        const float glu = gt * sigm(1.702f * gt); o[4 * n + i] = (up + 1.0f) * glu; }
                v4u w; w.x = cvt_pk_bf16(o[0], o[1]); w.y = cvt_pk_bf16(o[2], o[3]); w.z = cvt_pk_bf16(o[4], o[5]); w.w = cvt_pk_bf16(o[6], o[7]);
                *(v4u*)(act + r * D + gcol) = w; }
    }
};
struct EpiMoe2 {
    static constexpr bool PERM = true, AFTER_DRAIN = false, CHAIN = false;
    const float* bdn; const float* rowp; bf16* y2m;
    __device__ __forceinline__ void operator()(const f32x4 (&acc)[2][2][4][2], const Unit& u, int wr, int wc, int fr, int fq) const {
        const int e = u.pn >> 3, j = u.pn & 7, row0 = u.pm * 256 + wr * 64 + fr, col0 = 256 * j + wc * 32 + 8 * fq;
        f32x4 bv[2][2];
#pragma unroll
        for (int bj = 0; bj < 2; ++bj) { bv[bj][0] = *(const f32x4*)(bdn + (size_t)e * D + col0 + bj * 128); bv[bj][1] = *(const f32x4*)(bdn + (size_t)e * D + col0 + bj * 128 + 4); }
        float pv[2][4];
#pragma unroll
        for (int ai = 0; ai < 2; ++ai)
#pragma unroll
            for (int m = 0; m < 4; ++m) pv[ai][m] = rowp[row0 + ai * 128 + m * 16];
#pragma unroll
        for (int ai = 0; ai < 2; ++ai)
#pragma unroll
            for (int m = 0; m < 4; ++m) { const size_t r = (size_t)(row0 + ai * 128 + m * 16); const float p = pv[ai][m];
#pragma unroll
                for (int bj = 0; bj < 2; ++bj) { const f32x4 v0 = (acc[ai][bj][m][0] + bv[bj][0]) * p, v1 = (acc[ai][bj][m][1] + bv[bj][1]) * p;
                    v4u w; w.x = cvt_pk_bf16(v0[0], v0[1]); w.y = cvt_pk_bf16(v0[2], v0[3]); w.z = cvt_pk_bf16(v1[0], v1[1]); w.w = cvt_pk_bf16(v1[2], v1[3]);
                    *(v4u*)(y2m + r * D + col0 + bj * 128) = w; } }
    }
};

struct Ctx {
    LAS unsigned char* lds; int tid, lane, wave, G, bid;
};

struct TrDesc { const float* src; bf16* dst; int ldsrc, k0, srccol0, K, dstrow0; };
__device__ __forceinline__ TrDesc tr_decode(int it, const float* const* in, unsigned char* ws) {
    constexpr int I_IN = 32 * (NP / 32), I_SQ = 32 * 64, I_GU = 32 * 128, I_DN = 32 * 64;
    TrDesc t; int r = it;
    if (r < I_IN) { const int nblk = NP / 32, kb = r / nblk, nb = r % nblk, n0 = 32 * nb;
        t.srccol0 = n0 < 5120 ? n0 : (n0 < PC_DT ? n0 + 64 : (n0 < PC_DT + 64 ? n0 - PC_DT + 5120 : -1));
        t.src = in[8]; t.ldsrc = 19520; t.k0 = 64 * kb; t.dst = (bf16*)(ws + WS_WIN); t.K = D; t.dstrow0 = n0; return t; } r -= I_IN;
    if (r < 3 * I_SQ) { const int w = r / I_SQ, rr = r % I_SQ, kb = rr / 64, nb = rr % 64;
        t.src = in[17 + w]; t.ldsrc = D; t.k0 = 64 * kb; t.srccol0 = 32 * nb; t.dst = (bf16*)(ws + (w == 0 ? WS_WBS : (w == 1 ? WS_WBH : WS_WO))); t.K = D; t.dstrow0 = 32 * nb; return t; } r -= 3 * I_SQ;
    if (r < NEXP * I_GU) { const int e = r / I_GU, rr = r % I_GU, kb = rr / 128, nb = rr % 128, n0 = 32 * nb, j = n0 >> 8, q = n0 & 255;
        t.srccol0 = q < 128 ? 128 * j + q : 2048 + 128 * j + (q - 128);
        t.src = in[22] + (size_t)e * D * 4096; t.ldsrc = 4096; t.k0 = 64 * kb; t.dst = (bf16*)(ws + WS_WGU); t.K = D; t.dstrow0 = e * 4096 + n0; return t; } r -= NEXP * I_GU;
    { const int e = r / I_DN, rr = r % I_DN, kb = rr / 64, nb = rr % 64;
        t.src = in[24] + (size_t)e * D * D; t.ldsrc = D; t.k0 = 64 * kb; t.srccol0 = 32 * nb; t.dst = (bf16*)(ws + WS_WDN); t.K = D; t.dstrow0 = e * D + 32 * nb; return t; }
}
__device__ __forceinline__ void tr_load(const TrDesc& t, f32x4 (&v)[8], int lane) {
    if (t.srccol0 >= 0) {
#pragma unroll
        for (int j = 0; j < 8; ++j) v[j] = *(const f32x4*)(t.src + (size_t)(t.k0 + 16 * (j >> 1) + 2 * (lane >> 3) + (j & 1)) * t.ldsrc + t.srccol0 + 4 * (lane & 7));
    } else {
#pragma unroll
        for (int j = 0; j < 8; ++j) v[j] = (f32x4){0.f, 0.f, 0.f, 0.f};
    }
}
__device__ __forceinline__ void tr_store(const TrDesc& t, const f32x4 (&v)[8], LAS bf16* scr, int lane) {
    const int kr = lane >> 3, n4 = lane & 7;
#pragma unroll
    for (int hf = 0; hf < 2; ++hf) {
#pragma unroll
        for (int m = 0; m < 2; ++m) { const f32x4 x0 = v[4 * hf + 2 * m], x1 = v[4 * hf + 2 * m + 1]; LAS unsigned* s32 = (LAS unsigned*)scr;
#pragma unroll
            for (int c = 0; c < 4; ++c) s32[(4 * n4 + c) * 20 + 8 * m + kr] = pg8::cvt_pk_bf16(x0[c], x1[c]); }
        LDS_WAIT(); asm volatile("" ::: "memory");
        const int n = lane >> 2, q = lane & 3;
        const v4u a = *(const LAS v4u*)(scr + n * 40 + q * 8), b = *(const LAS v4u*)(scr + (16 + n) * 40 + q * 8);
        bf16* dp = t.dst + (size_t)(t.dstrow0 + n) * t.K + t.k0 + 32 * hf + 8 * q;
        *(v4u*)dp = a; *(v4u*)(dp + (size_t)16 * t.K) = b;
        LDS_WAIT(); asm volatile("" ::: "memory");
    }
}
constexpr int TR_I_HEAD = 32 * (NP / 32) + 3 * 32 * 64;
constexpr int TR_I_ALL = TR_I_HEAD + NEXP * 32 * 128 + NEXP * 32 * 64;
__device__ __forceinline__ int tr_run(int first, int stride, int last, const float* const* in, unsigned char* ws, LAS bf16* scr, int lane) {
    int i0 = first, i1 = first + stride, i2 = first + 2 * stride; TrDesc d0, d1, d2; f32x4 a[8], b[8], c[8];
    d0 = tr_decode(i0 < last ? i0 : first, in, ws); d1 = d0; d2 = d0;
    if (i0 < last) tr_load(d0, a, lane);
    if (i1 < last) { d1 = tr_decode(i1, in, ws); tr_load(d1, b, lane); }
    if (i2 < last) { d2 = tr_decode(i2, in, ws); tr_load(d2, c, lane); }
#pragma unroll 1
    while (i0 < last) {
        tr_store(d0, a, scr, lane); i0 += 3 * stride; if (i0 < last) { d0 = tr_decode(i0, in, ws); tr_load(d0, a, lane); }
        if (i1 < last) { tr_store(d1, b, scr, lane); i1 += 3 * stride; if (i1 < last) { d1 = tr_decode(i1, in, ws); tr_load(d1, b, lane); } }
        if (i2 < last) { tr_store(d2, c, scr, lane); i2 += 3 * stride; if (i2 < last) { d2 = tr_decode(i2, in, ws); tr_load(d2, c, lane); } }
    }
    return i0;
}
struct ConvOrder : pg8::StaticOrder {
    const float* const* in; unsigned char* ws; LAS bf16* scr; int lane, stride; mutable int cursor;
    __device__ __forceinline__ void done(const pg8::Unit&) const {
        constexpr int IPU = 6;
        if (cursor >= TR_I_ALL) return;
        const int last = cursor + IPU * stride < TR_I_ALL ? cursor + IPU * stride : TR_I_ALL;
        (void)tr_run(cursor, stride, last, in, ws, scr, lane); cursor += IPU * stride;
        asm volatile("s_waitcnt vmcnt(0)" ::: "memory");
    }
};

__device__ __forceinline__ void p0_prologue(const Ctx& F, const float* const* in, unsigned char* ws) {
    {
        const float* cvec = in[1]; const float* cctx = in[3]; const float* w_ada = in[4]; const float* b_ada = in[5];
        float* mod = (float*)(ws + WS_MOD); float* modc = mod + 12288;
        LAS float* s1 = (LAS float*)F.lds; LAS float* s2 = s1 + 2048; LAS float* red = s2 + 2048;
        for (int k = F.tid; k < 2048; k += 512) { s1[k] = silu(cvec[k]); s2[k] = silu(cctx[k]); }
        __syncthreads();
        for (int cg = F.bid; cg < 256; cg += F.G) {
            const int q = F.tid % 12, kg = F.tid / 12;
            f32x4 a1 = {0.f, 0.f, 0.f, 0.f}, a2 = {0.f, 0.f, 0.f, 0.f};
            if (kg < 42) for (int k = kg; k < 2048; k += 42) { const f32x4 w = *(const f32x4*)(w_ada + (size_t)k * 12288 + cg * 48 + 4 * q); a1 += w * s1[k]; a2 += w * s2[k]; }
            if (kg < 42) {
#pragma unroll
                for (int i = 0; i < 4; ++i) { red[(0 * 42 + kg) * 48 + 4 * q + i] = a1[i]; red[(1 * 42 + kg) * 48 + 4 * q + i] = a2[i]; } }
            __syncthreads();
            if (F.tid < 96) { const int which = F.tid / 48, col = F.tid % 48; float s = 0.f; for (int g = 0; g < 42; ++g) s += red[(which * 42 + g) * 48 + col];
                s += b_ada[cg * 48 + col]; (which ? modc : mod)[cg * 48 + col] = s; }
            __syncthreads();
        }
    }
    LAS bf16* scr = (LAS bf16*)(F.lds + 40960 + F.wave * 2560);
    const int gw = F.bid * NWAVES + F.wave, NGW = F.G * NWAVES;
    constexpr int NITEMS = TR_I_HEAD;
    (void)tr_run(gw, NGW, NITEMS, in, ws, scr, F.lane);
}

__device__ __forceinline__ void p1_rows(const Ctx& F, const float* src0, const float* sh, const float* sc, const float* w1, bf16* hn0, int nrows) {
    const int gw = F.bid * NWAVES + F.wave, NGW = F.G * NWAVES;
    if (gw >= nrows) return;
    f32x4 sv[4][2], hv[4][2];
#pragma unroll
    for (int j = 0; j < 4; ++j)
#pragma unroll
        for (int q = 0; q < 2; ++q) { const int col = 8 * F.lane + 512 * j + 4 * q; sv[j][q] = *(const f32x4*)(w1 + col) * (*(const f32x4*)(sc + col) + 1.0f); hv[j][q] = *(const f32x4*)(sh + col); }
    for (int row = gw; row < nrows; row += NGW) {
        const float* src = src0 + (size_t)row * D; f32x4 v[4][2]; float ss = 0.f;
#pragma unroll
        for (int j = 0; j < 4; ++j)
#pragma unroll
            for (int q = 0; q < 2; ++q) { v[j][q] = *(const f32x4*)(src + 8 * F.lane + 512 * j + 4 * q); ss += (v[j][q][0] * v[j][q][0] + v[j][q][1] * v[j][q][1]) + (v[j][q][2] * v[j][q][2] + v[j][q][3] * v[j][q][3]); }
        const float rstd = 1.0f / sqrtf(wave_sum(ss) * (1.0f / D) + EPS);
#pragma unroll
        for (int j = 0; j < 4; ++j) { const f32x4 o0 = v[j][0] * rstd * sv[j][0] + hv[j][0], o1 = v[j][1] * rstd * sv[j][1] + hv[j][1];
            v4u pk; pk.x = pg8::cvt_pk_bf16(o0[0], o0[1]); pk.y = pg8::cvt_pk_bf16(o0[2], o0[3]); pk.z = pg8::cvt_pk_bf16(o1[0], o1[1]); pk.w = pg8::cvt_pk_bf16(o1[2], o1[3]);
            *(v4u*)(hn0 + (size_t)row * D + 8 * F.lane + 512 * j) = pk; }
    }
}
__device__ __forceinline__ void p1_norm(const Ctx& F, const float* const* in, unsigned char* ws) {
    const float* mod = (const float*)(ws + WS_MOD); const float* modc = mod + 12288; bf16* hn = (bf16*)(ws + WS_HN);
    p1_rows(F, in[0], mod, mod + 2048, in[6], hn, L);
    p1_rows(F, in[2], modc, modc + 2048, in[6], hn + (size_t)L * D, LC);
}

__device__ __forceinline__ void p1_router_fold(const Ctx& F, const float* const* in, unsigned char* ws) {
    const float* mod = (const float*)(ws + WS_MOD); const float* sh2 = mod + 6144; const float* sc2 = mod + 8192; const float* w2 = in[7]; const float* wr = in[20];
    f32x4* W2 = (f32x4*)(ws + WS_WR2); float* cvec = (float*)(ws + WS_WR2 + 262144);
    for (int u = F.bid * 512 + F.tid; u < 16384; u += F.G * 512) { const int e = u & 31, hf = (u >> 5) & 1, kq = (u >> 6) & 3, j = u >> 8; f32x4 o;
#pragma unroll
        for (int i = 0; i < 4; ++i) { const int k = 32 * j + 8 * kq + 4 * hf + i; o[i] = w2[k] * (1.0f + sc2[k]) * wr[k * 32 + e]; }
        W2[u] = o; }
    { const int e = F.bid * NWAVES + F.wave;
      if (e < NEXP) { float s = 0.f;
#pragma unroll 8
          for (int j = 0; j < 32; ++j) { const int k = F.lane + 64 * j; s += sh2[k] * wr[k * 32 + e]; }
          s = wave_sum(s); if (F.lane == 0) cvec[e] = s + in[21][e]; } }
}

__device__ __forceinline__ void p3_prep(const Ctx& F, const float* const* in, unsigned char* ws) {
    const bf16* P = (const bf16*)(ws + WS_PROJ); const float* cw = in[9]; const float* cb = in[10];
    bf16* XS = (bf16*)(ws + WS_XS); bf16* BN = (bf16*)(ws + WS_BN); bf16* CN = (bf16*)(ws + WS_CN);
    constexpr int NT = LT / 64, NS = 24, NCONV = NT * NS;
    for (int it = F.bid; it < NCONV + NT; it += F.G) {
        if (it < NCONV) {
            const int tt = it / NS, sb = it % NS, tl = F.tid >> 3, cg = F.tid & 7, t = tt * 64 + tl, ch0 = sb * 128 + cg * 16;
            const int r0 = t < L ? tt * 64 : L, r1 = t < L ? tt * 64 + 64 : LT;
            float a[16];
#pragma unroll
            for (int i = 0; i < 16; i += 4) { const f32x4 b = *(const f32x4*)(cb + ch0 + i); a[i] = b[0]; a[i + 1] = b[1]; a[i + 2] = b[2]; a[i + 3] = b[3]; }
#pragma unroll
            for (int k = 0; k < 4; ++k) { const int ts = t + k - 2;
                if (ts >= r0 && ts < r1) { const v4u u0 = *(const v4u*)(P + pidx((size_t)ts, PC_X + ch0)), u1 = *(const v4u*)(P + pidx((size_t)ts, PC_X + ch0 + 8));
                    const unsigned uu[8] = {u0.x, u0.y, u0.z, u0.w, u1.x, u1.y, u1.z, u1.w};
#pragma unroll
                    for (int i = 0; i < 8; ++i) { const float w0 = cw[k * 3072 + ch0 + 2 * i], w1 = cw[k * 3072 + ch0 + 2 * i + 1]; a[2 * i] += w0 * bflo(uu[i]); a[2 * i + 1] += w1 * bfhi(uu[i]); } } }
            v4u o0, o1;
            o0.x = pk2(silu(a[0]), silu(a[1])); o0.y = pk2(silu(a[2]), silu(a[3])); o0.z = pk2(silu(a[4]), silu(a[5])); o0.w = pk2(silu(a[6]), silu(a[7]));
            o1.x = pk2(silu(a[8]), silu(a[9])); o1.y = pk2(silu(a[10]), silu(a[11])); o1.z = pk2(silu(a[12]), silu(a[13])); o1.w = pk2(silu(a[14]), silu(a[15]));
            bf16* dst = ch0 < 2048 ? XS + (size_t)t * 2048 + ch0 : (ch0 < 2560 ? BN + (size_t)t * 512 + (ch0 - 2048) : CN + (size_t)t * 512 + (ch0 - 2560));
            *(v4u*)dst = o0; *(v4u*)(dst + 8) = o1;
        } else {
            const int tt = it - NCONV, t = tt * 64 + (F.tid >> 3), dh0 = (F.tid & 7) * 8;
            const float* dr = (const float*)(ws + WS_DTRAW) + (size_t)t * 64 + dh0; float* dtv = (float*)(ws + WS_DTV);
#pragma unroll
            for (int i = 0; i < 8; ++i) { const float xx = dr[i] + in[11][dh0 + i]; const float sp = fmaxf(xx, 0.f) + log1pf(expf(-fabsf(xx))); dtv[(size_t)(dh0 + i) * LT + t] = sp; }
        }
    }
}

__device__ __forceinline__ void p4_ssd_naive(const Ctx& F, const float* const* in, unsigned char* ws) {
    const bf16* XS = (const bf16*)(ws + WS_XS); const bf16* BN = (const bf16*)(ws + WS_BN); const bf16* CN = (const bf16*)(ws + WS_CN); const float* DTV = (const float*)(ws + WS_DTV);
    for (int u = F.bid * 512 + F.tid; u < 131072; u += F.G * 512) {
        const int nq = u & 31, p = (u >> 5) & 63, h = (u >> 11) & 31, d = u >> 16, g = h >> 3;
        const float A = -expf(in[12][d * 32 + h]);
        float* Y = (float*)(ws + (d ? WS_YB : WS_YF));
        const float* dtp = DTV + (size_t)(d * 32 + h) * LT;
        float S0 = 0.f, S1 = 0.f, S2 = 0.f, S3 = 0.f;
        for (int i = 0; i < LT; ++i) {
            const int tok = d == 0 ? (i < LC ? L + i : i - LC) : (i < LC ? LT - 1 - i : L - 1 - (i - LC));
            const float dt = dtp[tok], dec = __expf(A * dt), xv = bf1(XS[(size_t)tok * 2048 + h * 64 + p]) * dt;
            const v2u bq = *(const v2u*)(BN + (size_t)tok * 512 + g * 128 + 4 * nq), cq = *(const v2u*)(CN + (size_t)tok * 512 + g * 128 + 4 * nq);
            S0 = S0 * dec + xv * bflo(bq.x); S1 = S1 * dec + xv * bfhi(bq.x); S2 = S2 * dec + xv * bflo(bq.y); S3 = S3 * dec + xv * bfhi(bq.y);
            float y = (bflo(cq.x) * S0 + bfhi(cq.x) * S1) + (bflo(cq.y) * S2 + bfhi(cq.y) * S3);
            y += __shfl_xor(y, 1); y += __shfl_xor(y, 2); y += __shfl_xor(y, 4); y += __shfl_xor(y, 8); y += __shfl_xor(y, 16);
            if (nq == 0 && tok < L) Y[(size_t)tok * 2048 + h * 64 + p] = y;
        }
    }
}
__device__ __forceinline__ void p5_hgrn_naive(const Ctx& F, const float* const* in, unsigned char* ws) {
    const bf16* P = (const bf16*)(ws + WS_PROJ);
    for (int u = F.bid * 512 + F.tid; u < 131072; u += F.G * 512) {
        const int kq = u & 31, v = (u >> 5) & 127, h = (u >> 12) & 15, d = u >> 16;
        float* O = (float*)(ws + (d ? WS_OB : WS_OF));
        float lb[4];
#pragma unroll
        for (int j = 0; j < 4; ++j) { const int k = h * 128 + 4 * kq + j; lb[j] = 1.0f / (1.0f + expf(in[15][(d * 2 + 1) * 2048 + k] - in[15][(d * 2 + 0) * 2048 + k])); }
        float S[4] = {0.f, 0.f, 0.f, 0.f};
        const int fcol = (d ? PC_FB : PC_FF) + h * 128 + 4 * kq, qcol = PC_Q + h * 128 + 4 * kq, icol = PC_I + h * 128 + v;
        for (int i = 0; i < LT; ++i) {
            const int tok = d == 0 ? (i < LC ? L + i : i - LC) : (i < LC ? LT - 1 - i : L - 1 - (i - LC));
            const v2u fq = *(const v2u*)(P + pidx((size_t)tok, fcol)), qq = *(const v2u*)(P + pidx((size_t)tok, qcol)); const float vv = silu(bf1(P[pidx((size_t)tok, icol)]));
            const float fr[4] = {bflo(fq.x), bfhi(fq.x), bflo(fq.y), bfhi(fq.y)}; const float qv[4] = {bflo(qq.x), bfhi(qq.x), bflo(qq.y), bfhi(qq.y)};
            float o = 0.f;
#pragma unroll
            for (int j = 0; j < 4; ++j) { const float kin = (1.0f - lb[j]) * sigm(-fr[j]), f = 1.0f - kin; S[j] = f * S[j] + kin * vv; o += qv[j] * S[j]; }
            o += __shfl_xor(o, 1); o += __shfl_xor(o, 2); o += __shfl_xor(o, 4); o += __shfl_xor(o, 8); o += __shfl_xor(o, 16);
            if (kq == 0 && tok < L) O[(size_t)tok * 2048 + h * 128 + v] = o * 0.08838834764831845f;
        }
    }
}
__device__ __forceinline__ void p6_combine_naive(const Ctx& F, const float* const* in, unsigned char* ws) {
    const bf16* P = (const bf16*)(ws + WS_PROJ); const bf16* XS = (const bf16*)(ws + WS_XS);
    const float* YF = (const float*)(ws + WS_YF); const float* YB = (const float*)(ws + WS_YB); const float* OF = (const float*)(ws + WS_OF); const float* OB = (const float*)(ws + WS_OB);
    bf16* Y2S = (bf16*)(ws + WS_Y2); bf16* Y2H = (bf16*)(ws + WS_Y2 + 64 * MiB);
    const int gw = F.bid * NWAVES + F.wave, NGW = F.G * NWAVES;
    for (int t = gw; t < L; t += NGW) {
        f32x4 y[8]; float part[8];
#pragma unroll
        for (int j = 0; j < 8; ++j) { const int col = 4 * F.lane + 256 * j; const size_t o = (size_t)t * 2048 + col;
            const f32x4 a = *(const f32x4*)(YF + o), b = *(const f32x4*)(YB + o); const v2u xs = *(const v2u*)(XS + o), zz = *(const v2u*)(P + pidx((size_t)t, PC_Z + col));
            const float dsk = in[13][col >> 6];
            f32x4 v; v[0] = a[0] + b[0] + dsk * bflo(xs.x); v[1] = a[1] + b[1] + dsk * bfhi(xs.x); v[2] = a[2] + b[2] + dsk * bflo(xs.y); v[3] = a[3] + b[3] + dsk * bfhi(xs.y);
            v[0] *= silu(bflo(zz.x)); v[1] *= silu(bfhi(zz.x)); v[2] *= silu(bflo(zz.y)); v[3] *= silu(bfhi(zz.y));
            y[j] = v; part[j] = (v[0] * v[0] + v[1] * v[1]) + (v[2] * v[2] + v[3] * v[3]); }
#pragma unroll
        for (int g = 0; g < 4; ++g) { const float ss = wave_sum(part[2 * g] + part[2 * g + 1]); const float rstd = 1.0f / sqrtf(ss * (1.0f / 512.0f) + EPS);
#pragma unroll
            for (int jj = 0; jj < 2; ++jj) { const int j = 2 * g + jj, col = 4 * F.lane + 256 * j; const f32x4 w = *(const f32x4*)(in[14] + col); const f32x4 o = y[j] * rstd * w;
                v2u pk; pk.x = pk2(o[0], o[1]); pk.y = pk2(o[2], o[3]); *(v2u*)(Y2S + (size_t)t * 2048 + col) = pk; } }
#pragma unroll
        for (int j = 0; j < 8; ++j) { const int col = 4 * F.lane + 256 * j; const size_t o = (size_t)t * 2048 + col;
            const f32x4 a = *(const f32x4*)(OF + o), b = *(const f32x4*)(OB + o); f32x4 v = a + b;
            float ss = (v[0] * v[0] + v[1] * v[1]) + (v[2] * v[2] + v[3] * v[3]);
            ss += __shfl_xor(ss, 1); ss += __shfl_xor(ss, 2); ss += __shfl_xor(ss, 4); ss += __shfl_xor(ss, 8); ss += __shfl_xor(ss, 16);
            const float rstd = 1.0f / sqrtf(ss * (1.0f / 128.0f) + EPS);
            const f32x4 w = *(const f32x4*)(in[16] + (col & 127)); const v2u gg = *(const v2u*)(P + pidx((size_t)t, PC_G + col));
            v = v * rstd * w; v[0] *= silu(bflo(gg.x)); v[1] *= silu(bfhi(gg.x)); v[2] *= silu(bflo(gg.y)); v[3] *= silu(bfhi(gg.y));
            v2u pk; pk.x = pk2(v[0], v[1]); pk.y = pk2(v[2], v[3]); *(v2u*)(Y2H + (size_t)t * 2048 + col) = pk; }
    }
}

__device__ __forceinline__ void p10_route(const Ctx& F, const float* const* in, unsigned char* ws) {
    const bf16* H1 = (const bf16*)(ws + WS_H1); const f32x4* W2 = (const f32x4*)(ws + WS_WR2); const float* cvec = (const float*)(ws + WS_WR2 + 262144);
    unsigned* gcnt = (unsigned*)(ws + WS_CTL) + CW_GCNT; float* RSTD = (float*)(ws + WS_RSTD);
    int* A_E = (int*)(ws + WS_ROUTE); int* A_POS = A_E + NASSIGN; float* A_P = (float*)(A_POS + NASSIGN);
    LAS float* part = (LAS float*)F.lds;
    LAS int* lcnt = (LAS int*)(F.lds + 16384); LAS int* lbase = lcnt + 32; LAS int* rec_e = lbase + 32; LAS int* rec_lp = rec_e + 256; LAS float* rec_p = (LAS float*)(rec_lp + 256);
    const int l15 = F.lane & 15, g4 = F.lane >> 4, tg = F.wave & 3, kh = F.wave >> 2;
    for (int tb = F.bid; tb < L / 64; tb += F.G) {
        if (F.tid < 32) lcnt[F.tid] = 0;
        const int tok = tb * 64 + tg * 16 + l15;
        f32x4 acc0 = {0.f, 0.f, 0.f, 0.f}, acc1 = {0.f, 0.f, 0.f, 0.f}; float ss = 0.f;
        const bf16* hp = H1 + (size_t)tok * D + 8 * g4;
#pragma unroll 2
        for (int j = kh * 32; j < kh * 32 + 32; ++j) {
            const v4u raw = *(const v4u*)(hp + 32 * j); const f32x4* wq = W2 + ((j * 4 + g4) * 2) * 32;
            const f32x4 a4 = {bflo(raw.x), bfhi(raw.x), bflo(raw.y), bfhi(raw.y)}, a5 = {bflo(raw.z), bfhi(raw.z), bflo(raw.w), bfhi(raw.w)};
            const f32x4 b0 = wq[l15], b1 = wq[16 + l15], b2 = wq[32 + l15], b3 = wq[48 + l15];
            ss += ((a4[0] * a4[0] + a4[1] * a4[1]) + (a4[2] * a4[2] + a4[3] * a4[3])) + ((a5[0] * a5[0] + a5[1] * a5[1]) + (a5[2] * a5[2] + a5[3] * a5[3]));
#pragma unroll
            for (int i = 0; i < 4; ++i) { acc0 = __builtin_amdgcn_mfma_f32_16x16x4f32(a4[i], b0[i], acc0, 0, 0, 0); acc1 = __builtin_amdgcn_mfma_f32_16x16x4f32(a4[i], b1[i], acc1, 0, 0, 0); }
#pragma unroll
            for (int i = 0; i < 4; ++i) { acc0 = __builtin_amdgcn_mfma_f32_16x16x4f32(a5[i], b2[i], acc0, 0, 0, 0); acc1 = __builtin_amdgcn_mfma_f32_16x16x4f32(a5[i], b3[i], acc1, 0, 0, 0); }
        }
        ss += __shfl_xor(ss, 16); ss += __shfl_xor(ss, 32);
        if (kh == 1) {
#pragma unroll
            for (int r = 0; r < 4; ++r) { part[(tg * 9 + r) * 64 + F.lane] = acc0[r]; part[(tg * 9 + 4 + r) * 64 + F.lane] = acc1[r]; }
            part[(tg * 9 + 8) * 64 + F.lane] = ss; }
        __syncthreads();
        if (kh == 0) {
#pragma unroll
            for (int r = 0; r < 4; ++r) { acc0[r] += part[(tg * 9 + r) * 64 + F.lane]; acc1[r] += part[(tg * 9 + 4 + r) * 64 + F.lane]; }
            ss += part[(tg * 9 + 8) * 64 + F.lane];
            const float rstd = 1.0f / sqrtf(ss * (1.0f / D) + EPS);
            if (g4 == 0) RSTD[tok] = rstd;
            const float c0 = cvec[l15], c1 = cvec[16 + l15];
#pragma unroll
            for (int r = 0; r < 4; ++r) { const float rs = __shfl(rstd, 4 * g4 + r);
                float v0 = acc0[r] * rs + c0, v1 = acc1[r] * rs + c1; int te[4]; float tv[4];
#pragma unroll
                for (int i = 0; i < 4; ++i) { float bv = v0 >= v1 ? v0 : v1; int bi = v0 >= v1 ? l15 : 16 + l15;
#pragma unroll
                    for (int o = 1; o < 16; o <<= 1) { const float ov = __shfl_xor(bv, o); const int oi = __shfl_xor(bi, o); const bool take = ov > bv || (ov == bv && oi < bi); bv = take ? ov : bv; bi = take ? oi : bi; }
                    bi = (bi < 0 || bi > 31) ? i : bi;
                    te[i] = bi; tv[i] = bv; if (bi == l15) v0 = -__builtin_inff(); if (bi == 16 + l15) v1 = -__builtin_inff(); }
                const float e1 = expf(tv[1] - tv[0]), e2 = expf(tv[2] - tv[0]), e3 = expf(tv[3] - tv[0]); const float inv = 1.0f / (1.0f + e1 + e2 + e3);
                const float pr[4] = {inv, e1 * inv, e2 * inv, e3 * inv};
                if (l15 == 0) { const int tl = tg * 16 + 4 * g4 + r;
#pragma unroll
                    for (int i = 0; i < 4; ++i) { const int lp = __hip_atomic_fetch_add(&lcnt[te[i]], 1, __ATOMIC_RELAXED, __HIP_MEMORY_SCOPE_WORKGROUP); rec_e[tl * 4 + i] = te[i]; rec_lp[tl * 4 + i] = lp; rec_p[tl * 4 + i] = pr[i]; } } }
        }
        __syncthreads();
        if (F.tid < 32) { const int c = lcnt[F.tid]; lbase[F.tid] = c ? (int)__hip_atomic_fetch_add(gcnt + F.tid * 64, (unsigned)c, __ATOMIC_RELAXED, __HIP_MEMORY_SCOPE_AGENT) : 0; }
        __syncthreads();
        if (F.tid < 256) { const int a = F.tid, t = tb * 64 + (a >> 2), ee = rec_e[a]; A_E[4 * t + (a & 3)] = ee; A_POS[4 * t + (a & 3)] = lbase[ee] + rec_lp[a]; A_P[4 * t + (a & 3)] = rec_p[a]; }
        __syncthreads();
    }
}
__device__ __forceinline__ int moe_tables(const Ctx& F, unsigned char* ws, LAS int* blk_e, LAS int* pad_start, LAS int* nblk_w) {
    const unsigned* gcnt = (const unsigned*)(ws + WS_CTL) + CW_GCNT;
    if (F.tid < 64) { const int e = F.lane & 31; const int c = (int)__hip_atomic_load(gcnt + e * 64, __ATOMIC_RELAXED, __HIP_MEMORY_SCOPE_AGENT); const int nbe = (c + 255) >> 8;
        int incl = nbe;
#pragma unroll
        for (int o = 1; o < 32; o <<= 1) { const int v = __shfl_up(incl, o, 32); if (e >= o) incl += v; }
        const int start = incl - nbe;
        if (F.lane < 32) { pad_start[e] = start * 256; for (int j = 0; j < nbe && start + j < MAXBLK; ++j) blk_e[start + j] = e; if (e == 31) nblk_w[0] = incl < MAXBLK ? incl : MAXBLK; } }
    __syncthreads();
    return nblk_w[0];
}
typedef int i32x4 __attribute__((ext_vector_type(4)));
__device__ __forceinline__ void p11_gather(const Ctx& F, const float* const* in, unsigned char* ws) {
    LAS int* blk_e = (LAS int*)(F.lds + MISC_OFF + 1024); LAS int* pad_start = blk_e + MAXBLK; LAS int* nblk_w = pad_start + 32;
    (void)moe_tables(F, ws, blk_e, pad_start, nblk_w);
    const int* A_E = (const int*)(ws + WS_ROUTE); const int* A_POS = A_E + NASSIGN; const float* A_P = (const float*)(A_POS + NASSIGN); int* SLOT = (int*)(A_P + NASSIGN); float* ROWP = (float*)(SLOT + NASSIGN); int* TOK = (int*)(ROWP + MAXSLOT);
    const bf16* H1 = (const bf16*)(ws + WS_H1); const float* RSTD = (const float*)(ws + WS_RSTD); bf16* HN2 = (bf16*)(ws + WS_XG);
    const float* mod = (const float*)(ws + WS_MOD); const float* sh2 = mod + 6144; const float* sc2 = mod + 8192; const float* w2 = in[7];
    const int gw = F.bid * NWAVES + F.wave, NGW = F.G * NWAVES;
    f32x4 sv[4][2], hv[4][2];
#pragma unroll
    for (int j = 0; j < 4; ++j)
#pragma unroll
        for (int q = 0; q < 2; ++q) { const int col = 8 * F.lane + 512 * j + 4 * q; sv[j][q] = *(const f32x4*)(w2 + col) * (*(const f32x4*)(sc2 + col) + 1.0f); hv[j][q] = *(const f32x4*)(sh2 + col); }
    for (int t = gw; t < L; t += NGW) {
        const float rstd = RSTD[t]; const i32x4 ae = *(const i32x4*)(A_E + 4 * t), ap = *(const i32x4*)(A_POS + 4 * t); const f32x4 pp = *(const f32x4*)(A_P + 4 * t);
        i32x4 slot; slot[0] = pad_start[ae[0]] + ap[0]; slot[1] = pad_start[ae[1]] + ap[1]; slot[2] = pad_start[ae[2]] + ap[2]; slot[3] = pad_start[ae[3]] + ap[3];
        if (F.lane == 0) { *(i32x4*)(SLOT + 4 * t) = slot; ROWP[slot[0]] = pp[0]; ROWP[slot[1]] = pp[1]; ROWP[slot[2]] = pp[2]; ROWP[slot[3]] = pp[3]; TOK[slot[0]] = t; TOK[slot[1]] = t; TOK[slot[2]] = t; TOK[slot[3]] = t; }
#pragma unroll
        for (int j = 0; j < 4; ++j) { const int col = 8 * F.lane + 512 * j; const v4u hr = *(const v4u*)(H1 + (size_t)t * D + col); const f32x4 v0 = {bflo(hr.x), bfhi(hr.x), bflo(hr.y), bfhi(hr.y)}, v1 = {bflo(hr.z), bfhi(hr.z), bflo(hr.w), bfhi(hr.w)};
            const f32x4 o0 = v0 * rstd * sv[j][0] + hv[j][0], o1 = v1 * rstd * sv[j][1] + hv[j][1];
            v4u pk; pk.x = pg8::cvt_pk_bf16(o0[0], o0[1]); pk.y = pg8::cvt_pk_bf16(o0[2], o0[3]); pk.z = pg8::cvt_pk_bf16(o1[0], o1[1]); pk.w = pg8::cvt_pk_bf16(o1[2], o1[3]);
            *(v4u*)(HN2 + (size_t)t * D + col) = pk; }
    }
}
__device__ __forceinline__ void p14_final(const Ctx& F, const float* const* in, float* out, unsigned char* ws) {
    const bf16* H1 = (const bf16*)(ws + WS_H1); const bf16* Y2M = (const bf16*)(ws + WS_Y2M); const float* g2 = (const float*)(ws + WS_MOD) + 10240; const float* fw = in[26];
    const int* SLOT = (const int*)(ws + WS_ROUTE) + 3 * NASSIGN;
    const int gw = F.bid * NWAVES + F.wave, NGW = F.G * NWAVES;
    f32x4 gv[4][2], fv[4][2];
#pragma unroll
    for (int j = 0; j < 4; ++j)
#pragma unroll
        for (int q = 0; q < 2; ++q) { const int col = 8 * F.lane + 512 * j + 4 * q; gv[j][q] = *(const f32x4*)(g2 + col); fv[j][q] = *(const f32x4*)(fw + col); }
    for (int t = gw; t < L; t += NGW) {
        const i32x4 sl = *(const i32x4*)(SLOT + 4 * t);
        f32x4 v[4][2]; float ss = 0.f;
#pragma unroll
        for (int j = 0; j < 4; ++j) { const int col = 8 * F.lane + 512 * j;
            const v4u a = *(const v4u*)(Y2M + (size_t)sl[0] * D + col), b = *(const v4u*)(Y2M + (size_t)sl[1] * D + col), c = *(const v4u*)(Y2M + (size_t)sl[2] * D + col), d = *(const v4u*)(Y2M + (size_t)sl[3] * D + col);
            f32x4 m0, m1;
            m0[0] = (bflo(a.x) + bflo(b.x)) + (bflo(c.x) + bflo(d.x)); m0[1] = (bfhi(a.x) + bfhi(b.x)) + (bfhi(c.x) + bfhi(d.x)); m0[2] = (bflo(a.y) + bflo(b.y)) + (bflo(c.y) + bflo(d.y)); m0[3] = (bfhi(a.y) + bfhi(b.y)) + (bfhi(c.y) + bfhi(d.y));
            m1[0] = (bflo(a.z) + bflo(b.z)) + (bflo(c.z) + bflo(d.z)); m1[1] = (bfhi(a.z) + bfhi(b.z)) + (bfhi(c.z) + bfhi(d.z)); m1[2] = (bflo(a.w) + bflo(b.w)) + (bflo(c.w) + bflo(d.w)); m1[3] = (bfhi(a.w) + bfhi(b.w)) + (bfhi(c.w) + bfhi(d.w));
            const v4u hr = *(const v4u*)(H1 + (size_t)t * D + col); const f32x4 h0 = {bflo(hr.x), bfhi(hr.x), bflo(hr.y), bfhi(hr.y)}, h1v = {bflo(hr.z), bfhi(hr.z), bflo(hr.w), bfhi(hr.w)};
            v[j][0] = h0 + gv[j][0] * m0; v[j][1] = h1v + gv[j][1] * m1;
            ss += (v[j][0][0] * v[j][0][0] + v[j][0][1] * v[j][0][1]) + (v[j][0][2] * v[j][0][2] + v[j][0][3] * v[j][0][3]) + (v[j][1][0] * v[j][1][0] + v[j][1][1] * v[j][1][1]) + (v[j][1][2] * v[j][1][2] + v[j][1][3] * v[j][1][3]); }
        const float rstd = 1.0f / sqrtf(wave_sum(ss) * (1.0f / D) + EPS);
#pragma unroll
        for (int j = 0; j < 4; ++j) { const int col = 8 * F.lane + 512 * j; *(f32x4*)(out + (size_t)t * D + col) = v[j][0] * rstd * fv[j][0]; *(f32x4*)(out + (size_t)t * D + col + 4) = v[j][1] * rstd * fv[j][1]; }
    }
}

__device__ __forceinline__ unsigned tile_off(int r, int ch) { return (unsigned)(r * 256 + ((ch ^ (r & 15)) << 4)); }
__device__ __forceinline__ void load_tile128(LAS unsigned char* dst, const bf16* src, size_t pitch, int tid) {
#pragma unroll
    for (int p = 0; p < 4; ++p) { const int idx = p * 512 + tid, r = idx >> 4, ch = idx & 15; const v4u v = *(const v4u*)(src + (size_t)r * pitch + ch * 8); *(LAS v4u*)(dst + tile_off(r, ch)) = v; }
}
__device__ __forceinline__ bf16x8 frag(const LAS unsigned char* tile, int row, int chunk) { return *(const LAS bf16x8*)(tile + tile_off(row, chunk)); }
__device__ __forceinline__ bf16x8 as_frag(v4u v) { return __builtin_bit_cast(bf16x8, v); }
typedef short s16x4 __attribute__((ext_vector_type(4)));
__device__ __forceinline__ unsigned vimg_off(int r, int ch) { return 256u * (unsigned)r + 16u * (unsigned)(ch ^ (((r & 3) << 2) | ((r >> 2) & 3))); }
__device__ __forceinline__ void stage_vimg(LAS unsigned char* img, const bf16* P, int tok0, int h, int tid) {
#pragma unroll
    for (int p = 0; p < 4; ++p) { const int idx = p * 512 + tid, r = idx >> 4, ch = idx & 15; *(LAS v4u*)(img + vimg_off(r, ch)) = *(const v4u*)(P + pidx((size_t)(tok0 + r), PC_I + h * 128 + 8 * ch)); }
}
__device__ __forceinline__ v2u vtr(const LAS unsigned char* a) { return __builtin_bit_cast(v2u, __builtin_amdgcn_ds_read_tr16_b64_v4i16((LAS s16x4*)a)); }
__device__ __forceinline__ bf16x8 scale8(v4u raw, const f32x4 fa, const f32x4 fb) {
    v4u o; o.x = cvt_pk_bf16(bflo(raw.x) * fa[0], bfhi(raw.x) * fa[1]); o.y = cvt_pk_bf16(bflo(raw.y) * fa[2], bfhi(raw.y) * fa[3]);
    o.z = cvt_pk_bf16(bflo(raw.z) * fb[0], bfhi(raw.z) * fb[1]); o.w = cvt_pk_bf16(bflo(raw.w) * fb[2], bfhi(raw.w) * fb[3]); return __builtin_bit_cast(bf16x8, o);
}
#define MFMA16(a, b, c) __builtin_amdgcn_mfma_f32_16x16x32_bf16((a), (b), (c), 0, 0, 0)
__device__ __forceinline__ v2u pack4(const f32x4 v) { v2u o; o.x = cvt_pk_bf16(v[0], v[1]); o.y = cvt_pk_bf16(v[2], v[3]); return o; }

template <int DIR> __device__ __forceinline__ void hg_item(const Ctx& F, const float* const* in, unsigned char* ws, int c, int h, int mask) {
    const bf16* P = (const bf16*)(ws + WS_PROJ);
    constexpr int d = DIR; const int kc = h * 128 + 2 * F.lane, tokc = c * 128, fc = (d ? PC_FB : PC_FF) + kc;
    const float oml0 = 1.0f - 1.0f / (1.0f + expf(in[15][(d * 2 + 1) * 2048 + kc] - in[15][(d * 2 + 0) * 2048 + kc]));
    const float oml1 = 1.0f - 1.0f / (1.0f + expf(in[15][(d * 2 + 1) * 2048 + kc + 1] - in[15][(d * 2 + 0) * 2048 + kc + 1]));
    const bf16* Pf = P + pidx((size_t)tokc, fc); const bf16* Pq = P + pidx((size_t)tokc, PC_Q + kc);
    const size_t tile = (((size_t)c * 16 + h) * 2 + d) * 16384;
    bf16* QTd = (bf16*)(ws + WS_QT) + tile; bf16* KDd = (bf16*)(ws + WS_KD) + tile;
    const bool needq = c < 128;
    float run0 = 0.f, run1 = 0.f;
    LAS unsigned* qb = (LAS unsigned*)(F.lds + F.wave * 16384); LAS unsigned* kb = qb + 1088;
    const int fslot = (F.lane >> 4) * 64 + ((F.lane >> 2) & 3) * 16;
#pragma unroll 1
    for (int half = 0; half < 2; ++half) {
#pragma unroll
        for (int b4 = 0; b4 < 4; ++b4) { const int Ii = half * 4 + b4, I = d ? 7 - Ii : Ii;
            unsigned u[16], q[16];
#pragma unroll
            for (int j = 0; j < 16; ++j) { u[j] = *(const unsigned*)(Pf + (16 * I + j) * 128); q[j] = needq ? *(const unsigned*)(Pq + (16 * I + j) * 128) : 0u; }
            *(f32x2*)((float*)(ws + WS_BETA) + ((size_t)(c * 2 + d) * 8 + I) * 2048 + kc) = (f32x2){run0, run1};
            float e0 = 1.0f, e1 = 1.0f;
#pragma unroll
            for (int jj = 0; jj < 16; ++jj) { const int j = DIR ? 15 - jj : jj;
                const float k0 = oml0 * sigm(-bflo(u[j])), k1 = oml1 * sigm(-bfhi(u[j]));
                e0 = fmaxf(e0 * (1.0f - k0), 1e-30f); e1 = fmaxf(e1 * (1.0f - k1), 1e-30f);
                const float kd0 = k0 * __builtin_amdgcn_rcpf(e0), kd1 = k1 * __builtin_amdgcn_rcpf(e1);
                { const int slot = fslot + j; qb[(slot + (slot >> 4)) * 4 + (F.lane & 3)] = cvt_pk_bf16(bflo(q[j]) * 0.08838834764831845f * e0, bfhi(q[j]) * 0.08838834764831845f * e1);
                  kb[(slot + (slot >> 4)) * 4 + (F.lane & 3)] = cvt_pk_bf16(kd0, kd1); }
                }
            run0 += __logf(e0); run1 += __logf(e1);
            LDS_WAIT(); asm volatile("" ::: "memory");
            if (!(mask & 16)) {
#pragma unroll
                for (int i = 0; i < 4; ++i) { const int slot = i * 64 + F.lane; const size_t go = (size_t)I * 2048 + (size_t)slot * 8;
                    if (needq) *(v4u*)(QTd + go) = *(const LAS v4u*)(qb + (slot + (slot >> 4)) * 4); *(v4u*)(KDd + go) = *(const LAS v4u*)(kb + (slot + (slot >> 4)) * 4); } }
            LDS_WAIT(); asm volatile("" ::: "memory");
        }
    }
    *(f32x2*)((float*)(ws + WS_DEC) + (size_t)(c * 2 + d) * 2048 + kc) = (f32x2){run0, run1};
}

__device__ __forceinline__ void p3_prep2(const Ctx& F, const float* const* in, unsigned char* ws, int mask) {
    const bf16* P = (const bf16*)(ws + WS_PROJ); const float* cw = in[9]; const float* cb = in[10];
    bf16* BN = (bf16*)(ws + WS_BN); bf16* CN = (bf16*)(ws + WS_CN); bf16* XT = (bf16*)(ws + WS_XT); bf16* BT = (bf16*)(ws + WS_BT);
    float* DTV = (float*)(ws + WS_DTV); float* ACS = (float*)(ws + WS_ACS);
    constexpr int NT = LT / 64, NS = 24, NCONV = NT * NS, NDT = 130 * 64 / 8, NHG = 128 * 16 * 2 / 8 + 2 * 16 * 2;
    if (mask & 1)
    for (int sb = F.bid % NS; sb < NS; sb += (F.G >= NS ? NS : F.G)) {
        const int nown = F.G >= NS ? (F.G - sb + NS - 1) / NS : 1, rank = F.G >= NS ? F.bid / NS : 0;
        const int tl = F.tid >> 3, cg = F.tid & 7, ch0 = sb * 128 + cg * 16;
        float wk[4][16], bk[16];
#pragma unroll
        for (int i = 0; i < 16; i += 4) { const f32x4 b = *(const f32x4*)(cb + ch0 + i); bk[i] = b[0]; bk[i + 1] = b[1]; bk[i + 2] = b[2]; bk[i + 3] = b[3];
#pragma unroll
            for (int k = 0; k < 4; ++k) { const f32x4 w = *(const f32x4*)(cw + k * 3072 + ch0 + i); wk[k][i] = w[0]; wk[k][i + 1] = w[1]; wk[k][i + 2] = w[2]; wk[k][i + 3] = w[3]; } }
        for (int tt = rank; tt < NT; tt += nown) {
            const int t = tt * 64 + tl;
            const int r0 = t < L ? tt * 64 : L, r1 = t < L ? tt * 64 + 64 : LT;
            float a[16];
#pragma unroll
            for (int i = 0; i < 16; ++i) a[i] = bk[i];
#pragma unroll
            for (int k = 0; k < 4; ++k) { const int ts = t + k - 2;
                if (ts >= r0 && ts < r1) { const v4u u0 = *(const v4u*)(P + pidx((size_t)ts, PC_X + ch0)), u1 = *(const v4u*)(P + pidx((size_t)ts, PC_X + ch0 + 8));
                    const unsigned uu[8] = {u0.x, u0.y, u0.z, u0.w, u1.x, u1.y, u1.z, u1.w};
#pragma unroll
                    for (int i = 0; i < 8; ++i) { a[2 * i] += wk[k][2 * i] * bflo(uu[i]); a[2 * i + 1] += wk[k][2 * i + 1] * bfhi(uu[i]); } } }
            unsigned o[8];
#pragma unroll
            for (int i = 0; i < 8; ++i) o[i] = pk2(silu(a[2 * i]), silu(a[2 * i + 1]));
            if (ch0 >= 2048) { const int cc = ch0 - (ch0 < 2560 ? 2048 : 2560); bf16* dst = (ch0 < 2560 ? BN : CN) + ((((size_t)(t >> 7)) * 4 + (cc >> 7)) * 128 + (t & 127)) * 128 + (cc & 127);
                *(v4u*)dst = (v4u){o[0], o[1], o[2], o[3]}; *(v4u*)(dst + 8) = (v4u){o[4], o[5], o[6], o[7]}; }
            if (sb < 20) {
                LAS bf16* tb = (LAS bf16*)F.lds;
#pragma unroll
                for (int i = 0; i < 8; ++i) { tb[(cg * 16 + 2 * i) * 66 + tl] = (bf16)(o[i] & 0xffffu); tb[(cg * 16 + 2 * i + 1) * 66 + tl] = (bf16)(o[i] >> 16); }
                __syncthreads();
                const int chl = F.tid >> 2, qd = F.tid & 3; const LAS unsigned* rowp = (const LAS unsigned*)(tb + chl * 66 + qd * 16);
                const v4u w0 = {rowp[0], rowp[1], rowp[2], rowp[3]}, w1 = {rowp[4], rowp[5], rowp[6], rowp[7]};
                const int ch = sb * 128 + chl;
                if (ch < 2048) {
                    const int p = ch & 63, ks2 = (tt & 1) * 2 + (qd >> 1), g40 = 2 * (qd & 1);
                    bf16* td = XT + ((size_t)(tt >> 1) * 32 + (ch >> 6)) * 8192 + ((((p >> 4) * 4 + ks2) * 4 + g40) * 16 + (p & 15)) * 8;
                    *(v4u*)td = w0; *(v4u*)(td + 128) = w1;
                } else { bf16* td = BT + ((size_t)(tt >> 1) * 512 + (ch - 2048)) * 128 + (tt & 1) * 64 + qd * 16;
                    *(v4u*)td = w0; *(v4u*)(td + 8) = w1; }
                __syncthreads();
            }
        }
    }
    for (int it = NCONV + F.bid; it < NCONV + NDT + NHG; it += F.G) {
        if (it < NCONV + NDT) {
            if (!(mask & 2)) continue;
            const int wi = (it - NCONV) * 8 + F.wave, c = wi >> 6, dh = wi & 63, d = dh >> 5, t0 = c * 128 + 2 * F.lane;
            const float* dr = (const float*)(ws + WS_DTRAW); const float bias = in[11][dh], A = -expf(in[12][dh]);
            const float x0 = dr[(size_t)t0 * 64 + dh] + bias, x1 = dr[(size_t)(t0 + 1) * 64 + dh] + bias;
            const float d0 = fmaxf(x0, 0.f) + log1pf(expf(-fabsf(x0))), d1 = fmaxf(x1, 0.f) + log1pf(expf(-fabsf(x1)));
            *(f32x2*)(DTV + (size_t)dh * LT + t0) = (f32x2){d0, d1};
            const float a0 = A * d0, a1 = A * d1; float s = a0 + a1, incl = s;
            if (d == 0) {
#pragma unroll
                for (int o = 1; o < 64; o <<= 1) { const float v = __shfl_up(incl, o); if (F.lane >= o) incl += v; }
                const float excl = incl - s; *(f32x2*)(ACS + (size_t)dh * LT + t0) = (f32x2){excl + a0, excl + a0 + a1};
            } else {
#pragma unroll
                for (int o = 1; o < 64; o <<= 1) { const float v = __shfl_down(incl, o); if (F.lane + o < 64) incl += v; }
                const float excl = incl - s; *(f32x2*)(ACS + (size_t)dh * LT + t0) = (f32x2){excl + a0 + a1, excl + a1};
            }
        } else {
            if (!(mask & 4)) continue;
            const int be = it - NCONV - NDT; if (be >= 512 && F.wave != 0) continue;
            const int wi = be < 512 ? be * 8 + F.wave : 4096 + (be - 512), d = wi & 1, h = (wi >> 1) & 15, c = wi >> 5;
            if (d == 0) hg_item<0>(F, in, ws, c, h, mask); else hg_item<1>(F, in, ws, c, h, mask);
        }
    }
}

__device__ __forceinline__ void p4_local(const Ctx& F, unsigned char* ws, int mask) {
    const int g4 = F.lane >> 4, l15 = F.lane & 15;
    const float* DTV = (const float*)(ws + WS_DTV); const float* ACS = (const float*)(ws + WS_ACS);
    constexpr int NS1 = 130 * 4 * 2, NH1 = 130 * 16;
    for (int it = F.bid; it < NS1; it += F.G) {
        {
            if (!(mask & 1)) continue;
            const int d = it & 1, c = it >> 3, g = (it >> 1) & 3, h = 8 * g + F.wave, tok0 = c * 128;
            LAS unsigned char* BTt = F.lds; LAS float* coef = (LAS float*)(F.lds + 32768 + F.wave * 1024);
            load_tile128(BTt, (const bf16*)(ws + WS_BT) + ((size_t)c * 512 + g * 128) * 128, 128, F.tid);
            { const float aend = ACS[(size_t)h * LT + tok0 + 127], rst = ACS[(size_t)(32 + h) * LT + tok0];
#pragma unroll
              for (int q = 0; q < 2; ++q) { const int s = F.lane + 64 * q;
                  coef[s] = DTV[(size_t)h * LT + tok0 + s] * __expf(aend - ACS[(size_t)h * LT + tok0 + s]);
                  coef[128 + s] = DTV[(size_t)(32 + h) * LT + tok0 + s] * __expf(rst - ACS[(size_t)(32 + h) * LT + tok0 + s]); } }
            __syncthreads();
            const bf16* XT = (const bf16*)(ws + WS_XT); bf16* SST = (bf16*)(ws + WS_SST);
#pragma unroll 1
                for (int ph = 0; ph < 2; ++ph) {
                    asm volatile("" ::: "memory");
                    bf16x8 Y[2][4];
#pragma unroll
                    for (int pp = 0; pp < 2; ++pp)
#pragma unroll
                        for (int ks = 0; ks < 4; ++ks) { const v4u raw = *(const v4u*)(XT + ((size_t)c * 32 + h) * 8192 + (((2 * ph + pp) * 4 + ks) * 64 + F.lane) * 8);
                            const f32x4 fa = *(const LAS f32x4*)(coef + d * 128 + ks * 32 + 8 * g4), fb = *(const LAS f32x4*)(coef + d * 128 + ks * 32 + 8 * g4 + 4);
                            Y[pp][ks] = scale8(raw, fa, fb); }
                    f32x4 acc[8][2];
#pragma unroll
                    for (int nt = 0; nt < 8; ++nt) { acc[nt][0] = (f32x4){0.f, 0.f, 0.f, 0.f}; acc[nt][1] = (f32x4){0.f, 0.f, 0.f, 0.f}; }
#pragma unroll
                    for (int nt = 0; nt < 8; ++nt) { asm volatile("" ::: "memory");
#pragma unroll
                        for (int ks = 0; ks < 4; ++ks) { const bf16x8 X = frag(BTt, nt * 16 + l15, ks * 4 + g4); acc[nt][0] = MFMA16(X, Y[0][ks], acc[nt][0]); acc[nt][1] = MFMA16(X, Y[1][ks], acc[nt][1]); } }
#pragma unroll
                    for (int nt = 0; nt < 8; ++nt)
#pragma unroll
                        for (int pp = 0; pp < 2; ++pp)
                            *(v2u*)(SST + (((size_t)c * 32 + h) * 2 + d) * 8192 + (((((2 * ph + pp) * 4 + (nt >> 1)) * 4 + 2 * (nt & 1) + (g4 >> 1)) * 16 + l15) * 8 + 4 * (g4 & 1))) = pack4(acc[nt][pp]);
                }
            __syncthreads();
        }
    }
    for (int it = F.G - 1 - F.bid; it < NH1; it += F.G) {
        {
            if (!(mask & 2)) continue;
            const int hi = it, c = hi >> 4, h = hi & 15, tok0 = c * 128;
            LAS unsigned char* VTt = F.lds; LAS unsigned char* KHf = F.lds + 32768; LAS unsigned char* KHb = F.lds + 65536;
            stage_vimg(VTt, (const bf16*)(ws + WS_PROJ), tok0, h, F.tid);
            { const bf16* kdsrc = (const bf16*)(ws + WS_KD) + (((size_t)c * 16 + h) * 2) * 16384;
#pragma unroll
              for (int p = 0; p < 4; ++p) { const int idx = p * 512 + F.tid; *(LAS v4u*)(KHf + idx * 16) = *(const v4u*)(kdsrc + (size_t)idx * 8); *(LAS v4u*)(KHb + idx * 16) = *(const v4u*)(kdsrc + 16384 + (size_t)idx * 8); } }
            __syncthreads();
            bf16* HST = (bf16*)(ws + WS_HST);
            const LAS unsigned char* trb[2];
            { const int q = l15 >> 2, p = l15 & 3, w = F.wave;
              const unsigned o = (unsigned)((((((g4 >> 1) * 4 + (w >> 1)) * 4 + ((2 * w + (p >> 1)) & 3)) * 16 + 8 * (g4 & 1) + q) * 16) + 8 * (p & 1));
              trb[0] = KHf + o; trb[1] = KHb + o; }
            const LAS unsigned char* va[2][8];
            { const int q = l15 >> 2, p = l15 & 3;
#pragma unroll
              for (int hb = 0; hb < 2; ++hb) { const int T = (p >> 1) ^ ((q << 2) | ((2 * g4 + hb) & 3));
#pragma unroll
                  for (int vt = 0; vt < 8; ++vt) va[hb][vt] = VTt + 256 * (8 * g4 + 4 * hb + q) + 8 * (p & 1) + ((32 * vt) ^ (16 * T)); } }
#pragma unroll 1
            for (int d = 0; d < 2; ++d) { const LAS unsigned char* KH = d ? KHb : KHf;
                f32x4 acc[8];
#pragma unroll
                for (int vt = 0; vt < 8; ++vt) acc[vt] = (f32x4){0.f, 0.f, 0.f, 0.f};
#pragma unroll
                for (int ks = 0; ks < 4; ++ks) { asm volatile("" ::: "memory");
                    const int kk = h * 128 + 16 * F.wave + l15, Ib = 2 * ks + (g4 >> 1);
                    const float gfac = __expf(((const float*)(ws + WS_DEC))[(size_t)(c * 2 + d) * 2048 + kk] - ((const float*)(ws + WS_BETA))[((size_t)(c * 2 + d) * 8 + Ib) * 2048 + kk]);
                    const f32x4 g4v = {gfac, gfac, gfac, gfac};
                    const v2u t0 = vtr(trb[d] + ks * 8192), t1 = vtr(trb[d] + ks * 8192 + 64);
                    const bf16x8 X = scale8((v4u){t0.x, t0.y, t1.x, t1.y}, g4v, g4v);
#pragma unroll
                    for (int vt = 0; vt < 8; ++vt) { const v2u b0 = vtr(va[0][vt] + 8192 * ks), b1 = vtr(va[1][vt] + 8192 * ks); acc[vt] = MFMA16(X, as_frag((v4u){b0.x, b0.y, b1.x, b1.y}), acc[vt]); } }
#pragma unroll
                for (int vt = 0; vt < 8; ++vt) { const int v = 16 * vt + l15, k = 16 * F.wave + 4 * g4;
                    *(v2u*)(HST + ((((size_t)c * 16 + h) * 2 + d) * 128 + v) * 128 + k) = pack4(acc[vt]); }
            }
            __syncthreads();
        }
    }
}

__device__ __forceinline__ void scan_decay(bool ssd, int d, int h, int kc, int c, const float* ACS, const float* DEC, float (&dv)[8]) {
    if (ssd) { const float x = __expf(d == 0 ? ACS[(size_t)h * LT + c * 128 + 127] : ACS[(size_t)(32 + h) * LT + c * 128]);
#pragma unroll
        for (int j = 0; j < 8; ++j) dv[j] = x; }
    else { const f32x4 a = *(const f32x4*)(DEC + (size_t)(c * 2 + d) * 2048 + kc), b = *(const f32x4*)(DEC + (size_t)(c * 2 + d) * 2048 + kc + 4);
        dv[0] = __expf(a[0]); dv[1] = __expf(a[1]); dv[2] = __expf(a[2]); dv[3] = __expf(a[3]); dv[4] = __expf(b[0]); dv[5] = __expf(b[1]); dv[6] = __expf(b[2]); dv[7] = __expf(b[3]); }
}
__device__ __forceinline__ bf16* hsti_chunk(unsigned char* ws, int c) { return (bf16*)(ws + (c < 64 ? WS_HSTI0 : WS_HSTI1)) + (size_t)(c & 63) * 524288; }
__device__ __forceinline__ void p5_scan(const Ctx& F, unsigned char* ws) {
    const float* ACS = (const float*)(ws + WS_ACS); const float* DEC = (const float*)(ws + WS_DEC);
    constexpr size_t CST = 524288;
    for (int u = F.bid * 512 + F.tid; u < 131072; u += F.G * 512) {
        const bool ssd = u < 65536; const int e = ssd ? u : u - 65536;
        int d, h, kc = 0; bf16* base; size_t eoff;
        if (ssd) { const int n8 = e & 15, p = (e >> 4) & 63; d = (e >> 10) & 1; h = e >> 11; eoff = (((size_t)h * 2 + d) * 64 + p) * 128 + n8 * 8; base = (bf16*)(ws + WS_SST) + eoff; }
        else { const int k8 = e & 15, v = (e >> 4) & 127; d = (e >> 11) & 1; h = e >> 12; kc = h * 128 + k8 * 8; eoff = (((size_t)h * 2 + d) * 128 + v) * 128 + k8 * 8; base = (bf16*)(ws + WS_HST) + eoff; }
        float run[8];
#pragma unroll
        for (int j = 0; j < 8; ++j) run[j] = 0.f;
#pragma unroll
        for (int i = 0; i < 2; ++i) { const int c = d == 0 ? 128 + i : 129 - i; float dv[8]; scan_decay(ssd, d, h, kc, c, ACS, DEC, dv); const v4u s = *(const v4u*)(base + (size_t)c * CST);
            const float sv[8] = {bflo(s.x), bfhi(s.x), bflo(s.y), bfhi(s.y), bflo(s.z), bfhi(s.z), bflo(s.w), bfhi(s.w)};
#pragma unroll
            for (int j = 0; j < 8; ++j) run[j] = run[j] * dv[j] + sv[j]; }
#pragma unroll 1
        for (int b = 0; b < 16; ++b) {
            v4u s[8]; float dv[8][8];
#pragma unroll
            for (int i = 0; i < 8; ++i) { const int c = d == 0 ? b * 8 + i : 127 - (b * 8 + i); s[i] = *(const v4u*)(base + (size_t)c * CST); scan_decay(ssd, d, h, kc, c, ACS, DEC, dv[i]); }
#pragma unroll
            for (int i = 0; i < 8; ++i) { const int c = d == 0 ? b * 8 + i : 127 - (b * 8 + i);
                v4u o; o.x = cvt_pk_bf16(run[0], run[1]); o.y = cvt_pk_bf16(run[2], run[3]); o.z = cvt_pk_bf16(run[4], run[5]); o.w = cvt_pk_bf16(run[6], run[7]);
                *(v4u*)((ssd ? (bf16*)(ws + WS_SSTI) + (size_t)c * CST : hsti_chunk(ws, c)) + eoff) = o;
                const float sv[8] = {bflo(s[i].x), bfhi(s[i].x), bflo(s[i].y), bfhi(s[i].y), bflo(s[i].z), bfhi(s[i].z), bflo(s[i].w), bfhi(s[i].w)};
#pragma unroll
                for (int j = 0; j < 8; ++j) run[j] = run[j] * dv[i][j] + sv[j]; }
        }
    }
}

__device__ __forceinline__ void p6_out(const Ctx& F, const float* const* in, unsigned char* ws, int mask) {
    const int g4 = F.lane >> 4, l15 = F.lane & 15;
    const bf16* P = (const bf16*)(ws + WS_PROJ);
    constexpr int NS3 = 128 * 4, NH3 = 128 * 16;
    for (int it = F.bid; it < NS3; it += F.G) {
        {
#ifndef SKIP_S3
            if (!(mask & 1)) continue;
            const int c = it >> 2, g = it & 3, h = 8 * g + F.wave, tok0 = c * 128;
            LAS unsigned char* CNt = F.lds; LAS unsigned char* BNt = F.lds + 32768; LAS float* CB = (LAS float*)(F.lds + 32768);
            LAS float* vec = (LAS float*)(F.lds + 100352 + F.wave * 2048);
            LAS float* ssq = (LAS float*)(F.lds + 116736);
            load_tile128(CNt, (const bf16*)(ws + WS_CN) + ((size_t)c * 4 + g) * 16384, 128, F.tid);
            load_tile128(BNt, (const bf16*)(ws + WS_BN) + ((size_t)c * 4 + g) * 16384, 128, F.tid);
            { const float* ACS = (const float*)(ws + WS_ACS); const float* DTV = (const float*)(ws + WS_DTV);
#pragma unroll
              for (int q = 0; q < 2; ++q) { const int s = F.lane + 64 * q; vec[s] = ACS[(size_t)h * LT + tok0 + s]; vec[128 + s] = ACS[(size_t)(32 + h) * LT + tok0 + s];
                  vec[256 + s] = DTV[(size_t)h * LT + tok0 + s]; vec[384 + s] = DTV[(size_t)(32 + h) * LT + tok0 + s]; } }
            __syncthreads();
            {
                f32x4 acc[8];
#pragma unroll
                for (int st = 0; st < 8; ++st) acc[st] = (f32x4){0.f, 0.f, 0.f, 0.f};
#pragma unroll
                for (int ks = 0; ks < 4; ++ks) { const bf16x8 Yc = frag(CNt, 16 * F.wave + l15, ks * 4 + g4);
#pragma unroll
                    for (int st = 0; st < 8; ++st) acc[st] = MFMA16(frag(BNt, 16 * st + l15, ks * 4 + g4), Yc, acc[st]); }
                __syncthreads();
#pragma unroll
                for (int st = 0; st < 8; ++st) *(LAS f32x4*)(CB + (16 * F.wave + l15) * 132 + 16 * st + 4 * g4) = acc[st];
            }
            __syncthreads();
            const bf16* SST = (const bf16*)(ws + WS_SSTI); const bf16* XT = (const bf16*)(ws + WS_XT); bf16* Y2S = (bf16*)(ws + WS_Y2);
            const float dsk = in[13][h];
#pragma unroll 1
            for (int th = 0; th < 2; ++th) {
                f32x4 y[4][4];
#pragma unroll
                for (int tt = 0; tt < 4; ++tt)
#pragma unroll
                    for (int pt = 0; pt < 4; ++pt) y[tt][pt] = (f32x4){0.f, 0.f, 0.f, 0.f};
#pragma unroll 1
                for (int d = 0; d < 2; ++d) {
                    asm volatile("" ::: "memory");
                    float ev[4];
#pragma unroll
                    for (int tt = 0; tt < 4; ++tt) ev[tt] = __expf(vec[d * 128 + 64 * th + 16 * tt + l15]);
#pragma unroll 1
                    for (int ks = 0; ks < 4; ++ks) {
                        asm volatile("" ::: "memory");
                        bf16x8 Xs[4];
#pragma unroll
                        for (int pt = 0; pt < 4; ++pt) Xs[pt] = as_frag(*(const v4u*)(SST + (((size_t)c * 32 + h) * 2 + d) * 8192 + ((pt * 4 + ks) * 64 + F.lane) * 8));
#pragma unroll
                        for (int tt = 0; tt < 4; ++tt) { const v4u craw = *(const LAS v4u*)(CNt + tile_off(64 * th + 16 * tt + l15, ks * 4 + g4)); const f32x4 e4 = {ev[tt], ev[tt], ev[tt], ev[tt]};
                            const bf16x8 Yc = scale8(craw, e4, e4);
#pragma unroll
                            for (int pt = 0; pt < 4; ++pt) y[tt][pt] = MFMA16(Xs[pt], Yc, y[tt][pt]); }
                    }
                }
#pragma unroll 1
                for (int ks = 0; ks < 4; ++ks) { const int s0 = 32 * ks + 8 * g4;
                    asm volatile("" ::: "memory");
                    bf16x8 Xx[4];
#pragma unroll
                    for (int pt = 0; pt < 4; ++pt) Xx[pt] = as_frag(*(const v4u*)(XT + ((size_t)c * 32 + h) * 8192 + ((pt * 4 + ks) * 64 + F.lane) * 8));
                    f32x4 afs[2], rbs[2], dfs[2], dbs[2];
#pragma unroll
                    for (int hf = 0; hf < 2; ++hf) { afs[hf] = *(const LAS f32x4*)(vec + s0 + 4 * hf); rbs[hf] = *(const LAS f32x4*)(vec + 128 + s0 + 4 * hf); dfs[hf] = *(const LAS f32x4*)(vec + 256 + s0 + 4 * hf); dbs[hf] = *(const LAS f32x4*)(vec + 384 + s0 + 4 * hf); }
#pragma unroll
                    for (int tt = 0; tt < 4; ++tt) { const int tl = 64 * th + 16 * tt + l15; const float aft = vec[tl], rbt = vec[128 + tl]; float m[8];
                        if (ks < 2 * th + (tt >> 1)) {
#pragma unroll
                            for (int hf = 0; hf < 2; ++hf) { const f32x4 cbv = *(const LAS f32x4*)(CB + tl * 132 + s0 + 4 * hf);
#pragma unroll
                                for (int j = 0; j < 4; ++j) m[4 * hf + j] = cbv[j] * dfs[hf][j] * __expf(aft - afs[hf][j]); }
                        } else if (ks > 2 * th + (tt >> 1)) {
#pragma unroll
                            for (int hf = 0; hf < 2; ++hf) { const f32x4 cbv = *(const LAS f32x4*)(CB + tl * 132 + s0 + 4 * hf);
#pragma unroll
                                for (int j = 0; j < 4; ++j) m[4 * hf + j] = cbv[j] * dbs[hf][j] * __expf(rbt - rbs[hf][j]); }
                        } else {
#pragma unroll
                        for (int hf = 0; hf < 2; ++hf) { const f32x4 cbv = *(const LAS f32x4*)(CB + tl * 132 + s0 + 4 * hf);
#pragma unroll
                            for (int j = 0; j < 4; ++j) { const int s = s0 + 4 * hf + j; const float arg = s <= tl ? aft - afs[hf][j] : rbt - rbs[hf][j]; const float cf = s < tl ? dfs[hf][j] : (s > tl ? dbs[hf][j] : dfs[hf][j] + dbs[hf][j]);
                                m[4 * hf + j] = cbv[j] * cf * __expf(arg) + (s == tl ? dsk : 0.f); } }
                        }
                        v4u mp; mp.x = cvt_pk_bf16(m[0], m[1]); mp.y = cvt_pk_bf16(m[2], m[3]); mp.z = cvt_pk_bf16(m[4], m[5]); mp.w = cvt_pk_bf16(m[6], m[7]);
                        const bf16x8 Ym = as_frag(mp);
#pragma unroll
                        for (int pt = 0; pt < 4; ++pt) y[tt][pt] = MFMA16(Xx[pt], Ym, y[tt][pt]); }
                }
                v2u zq[4][4];
#pragma unroll
                for (int tt = 0; tt < 4; ++tt)
#pragma unroll
                    for (int pt = 0; pt < 4; ++pt) zq[tt][pt] = *(const v2u*)(P + pidx((size_t)tok0 + 64 * th + 16 * tt + l15, PC_Z + h * 64 + 16 * pt + 4 * g4));
#pragma unroll
                for (int tt = 0; tt < 4; ++tt) { float ss = 0.f;
#pragma unroll
                    for (int pt = 0; pt < 4; ++pt) { const v2u zz = zq[tt][pt];
                        f32x4 v = y[tt][pt]; v[0] *= silu(bflo(zz.x)); v[1] *= silu(bfhi(zz.x)); v[2] *= silu(bflo(zz.y)); v[3] *= silu(bfhi(zz.y)); y[tt][pt] = v;
                        ss += (v[0] * v[0] + v[1] * v[1]) + (v[2] * v[2] + v[3] * v[3]); }
                    ss += __shfl_xor(ss, 16); ss += __shfl_xor(ss, 32);
                    if (g4 == 0) ssq[F.wave * 64 + 16 * tt + l15] = ss; }
                __syncthreads();
#pragma unroll
                for (int tt = 0; tt < 4; ++tt) { const size_t t = (size_t)tok0 + 64 * th + 16 * tt + l15; float tot = 0.f;
#pragma unroll
                    for (int w = 0; w < 8; ++w) tot += ssq[w * 64 + 16 * tt + l15];
                    const float rstd = 1.0f / sqrtf(tot * (1.0f / 512.0f) + EPS);
#pragma unroll
                    for (int pt = 0; pt < 4; ++pt) { const int ch = h * 64 + 16 * pt + 4 * g4; const f32x4 w = *(const f32x4*)(in[14] + ch);
                        *(v2u*)(Y2S + t * 2048 + ch) = pack4(y[tt][pt] * rstd * w); } }
                __syncthreads();
            }
#endif
        }
    }
    for (int it = F.bid; it < NH3; it += F.G) {
        {
#ifndef SKIP_H3
            if (!(mask & 2)) continue;
            const int hi = it, c = hi >> 4, h = hi & 15, tok0 = c * 128, w = F.wave;
            LAS unsigned char* STf = F.lds; LAS unsigned char* STb = F.lds + 32768; LAS unsigned char* VTt = F.lds + 65536; LAS float* beta = (LAS float*)(F.lds + 98304);
            const bf16* HSTc = hsti_chunk(ws, c);
            const bf16* QT0 = (const bf16*)(ws + WS_QT) + (((size_t)c * 16 + h) * 2) * 16384; const bf16* KD0 = (const bf16*)(ws + WS_KD) + (((size_t)c * 16 + h) * 2) * 16384;
            v4u Qf[2][4]; v2u gg[8];
#pragma unroll
            for (int d = 0; d < 2; ++d)
#pragma unroll
                for (int kk = 0; kk < 4; ++kk) Qf[d][kk] = *(const v4u*)(QT0 + (size_t)d * 16384 + ((w * 4 + kk) * 64 + F.lane) * 8);
#pragma unroll
            for (int vt = 0; vt < 8; ++vt) gg[vt] = *(const v2u*)(P + pidx((size_t)tok0 + 16 * w + l15, PC_G + h * 128 + 16 * vt + 4 * g4));
            load_tile128(STf, HSTc + ((size_t)h * 2 + 0) * 16384, 128, F.tid);
            load_tile128(STb, HSTc + ((size_t)h * 2 + 1) * 16384, 128, F.tid);
            stage_vimg(VTt, P, tok0, h, F.tid);
            { const int idx = F.tid * 4, d = idx >> 10, I = (idx >> 7) & 7, k = idx & 127;
              *(LAS f32x4*)(beta + idx) = *(const f32x4*)((const float*)(ws + WS_BETA) + ((size_t)(c * 2 + d) * 8 + I) * 2048 + h * 128 + k); }
            __syncthreads();
            const LAS unsigned char* hv[8];
            { const int q = l15 >> 2, p = l15 & 3, T = (p >> 1) ^ ((q << 2) | g4);
#pragma unroll
              for (int vt = 0; vt < 8; ++vt) hv[vt] = VTt + 256 * (4 * g4 + q) + 8 * (p & 1) + ((32 * vt) ^ (16 * T)); }
            f32x4 o[8];
#pragma unroll
            for (int vt = 0; vt < 8; ++vt) o[vt] = (f32x4){0.f, 0.f, 0.f, 0.f};
#pragma unroll
            for (int d = 0; d < 2; ++d) {
                const LAS unsigned char* ST = d ? STb : STf; const LAS float* bw = beta + (d * 8 + w) * 128; const bf16* KDd = KD0 + (size_t)d * 16384;
                v4u kraw[2][2][4];
#define H3_LOADK(buf, ksx) do { _Pragma("unroll") for (int q_ = 0; q_ < 2; ++q_) { const int J_ = 2 * (ksx) + q_; if (d == 0 ? J_ <= w : J_ >= w) { _Pragma("unroll") for (int kk_ = 0; kk_ < 4; ++kk_) \
                        kraw[buf][q_][kk_] = *(const v4u*)(KDd + ((J_ * 4 + kk_) * 64 + F.lane) * 8); } } } while (0)
                H3_LOADK(0, 0);
#pragma unroll
                for (int kk = 0; kk < 4; ++kk) { const f32x4 b0 = *(const LAS f32x4*)(bw + 32 * kk + 8 * g4), b1 = *(const LAS f32x4*)(bw + 32 * kk + 8 * g4 + 4);
                    const f32x4 e0 = {__expf(b0[0]), __expf(b0[1]), __expf(b0[2]), __expf(b0[3])}, e1 = {__expf(b1[0]), __expf(b1[1]), __expf(b1[2]), __expf(b1[3])};
                    const bf16x8 Yq = scale8(Qf[d][kk], e0, e1);
#pragma unroll
                    for (int vt = 0; vt < 8; ++vt) o[vt] = MFMA16(frag(ST, 16 * vt + l15, kk * 4 + g4), Yq, o[vt]); }
#pragma unroll
                for (int ks = 0; ks < 4; ++ks) {
                    if (ks < 3) H3_LOADK((ks + 1) & 1, ks + 1);
                    const int J0 = 2 * ks, J1 = 2 * ks + 1; const bool n0 = d == 0 ? J0 <= w : J0 >= w, n1 = d == 0 ? J1 <= w : J1 >= w;
                    if (n0 || n1) {
                    f32x4 D[2];
#pragma unroll
                    for (int q = 0; q < 2; ++q) { D[q] = (f32x4){0.f, 0.f, 0.f, 0.f}; const int J = 2 * ks + q; const bool need = q ? n1 : n0;
                        if (need) { const LAS float* bj = beta + (d * 8 + J) * 128;
#pragma unroll
                            for (int kk = 0; kk < 4; ++kk) { const v4u raw = kraw[ks & 1][q][kk];
                                bf16x8 Xk;
                                if (J != w) { const f32x4 a0 = *(const LAS f32x4*)(bw + 32 * kk + 8 * g4), a1 = *(const LAS f32x4*)(bw + 32 * kk + 8 * g4 + 4), c0 = *(const LAS f32x4*)(bj + 32 * kk + 8 * g4), c1 = *(const LAS f32x4*)(bj + 32 * kk + 8 * g4 + 4);
                                    const f32x4 f0 = {__expf(a0[0] - c0[0]), __expf(a0[1] - c0[1]), __expf(a0[2] - c0[2]), __expf(a0[3] - c0[3])}, f1 = {__expf(a1[0] - c1[0]), __expf(a1[1] - c1[1]), __expf(a1[2] - c1[2]), __expf(a1[3] - c1[3])};
                                    Xk = scale8(raw, f0, f1); }
                                else Xk = as_frag(raw);
                                D[q] = MFMA16(Xk, as_frag(Qf[d][kk]), D[q]); }
                            if (J == w) {
#pragma unroll
                                for (int r = 0; r < 4; ++r) { const bool keep = d == 0 ? (4 * g4 + r) <= l15 : (4 * g4 + r) >= l15; D[q][r] = keep ? D[q][r] : 0.f; } } } }
                    v4u ap; ap.x = cvt_pk_bf16(D[0][0], D[0][1]); ap.y = cvt_pk_bf16(D[0][2], D[0][3]); ap.z = cvt_pk_bf16(D[1][0], D[1][1]); ap.w = cvt_pk_bf16(D[1][2], D[1][3]);
                    const bf16x8 Ya = as_frag(ap);
#pragma unroll
                    for (int vh = 0; vh < 2; ++vh) { v2u x0[4], x1[4];
#pragma unroll
                        for (int i = 0; i < 4; ++i) { const int vt = 4 * vh + i; x0[i] = vtr(hv[vt] + 8192 * ks); x1[i] = vtr(hv[vt] + 8192 * ks + 4096); }
#pragma unroll
                        for (int i = 0; i < 4; ++i) { const int vt = 4 * vh + i; o[vt] = MFMA16(as_frag((v4u){x0[i].x, x0[i].y, x1[i].x, x1[i].y}), Ya, o[vt]); } }
                    }
                }
#undef H3_LOADK
            }
            { float ss = 0.f;
#pragma unroll
              for (int vt = 0; vt < 8; ++vt) ss += (o[vt][0] * o[vt][0] + o[vt][1] * o[vt][1]) + (o[vt][2] * o[vt][2] + o[vt][3] * o[vt][3]);
              ss += __shfl_xor(ss, 16); ss += __shfl_xor(ss, 32);
              const float rstd = 1.0f / sqrtf(ss * (1.0f / 128.0f) + EPS); const size_t t = (size_t)tok0 + 16 * w + l15; bf16* Y2H = (bf16*)(ws + WS_Y2 + 64 * MiB);
#pragma unroll
              for (int vt = 0; vt < 8; ++vt) { const int vv = 16 * vt + 4 * g4; const f32x4 wn = *(const f32x4*)(in[16] + vv);
                  f32x4 v = o[vt] * rstd * wn; v[0] *= silu(bflo(gg[vt].x)); v[1] *= silu(bfhi(gg[vt].x)); v[2] *= silu(bflo(gg[vt].y)); v[3] *= silu(bfhi(gg[vt].y));
                  *(v2u*)(Y2H + t * 2048 + h * 128 + vv) = pack4(v); } }
            __syncthreads();
#endif
        }
    }
}

struct Args { const float* in[27]; float* out; unsigned char* ws; int ph_lo, ph_hi, mask, pad; };
constexpr int N_PHASES = 15;
__global__ void __launch_bounds__(NWAVES * 64, 2) mega_fwd(Args args) {
    extern __shared__ __attribute__((aligned(16))) unsigned char lds_raw[];
    Ctx F; F.lds = (LAS unsigned char*)lds_raw; F.tid = threadIdx.x; F.lane = F.tid & 63; F.wave = __builtin_amdgcn_readfirstlane(F.tid >> 6); F.G = gridDim.x; F.bid = blockIdx.x;
    unsigned char* ws = args.ws; const float* const* in = args.in;
    volatile LAS unsigned* MISC = (volatile LAS unsigned*)(F.lds + MISC_OFF);
    if (F.tid < 4) MISC[F.tid] = 0u;
    __syncthreads();
    XcdBarrier bar; bar.bar = (unsigned*)(ws + WS_CTL) + CW_BAR; bar.x = 0; bar.st = nullptr;
    if (!MK_PER_PHASE) bar = xcd_barrier_post((unsigned*)(ws + WS_CTL) + CW_BAR, MISC);
    const int lo = args.ph_lo, hi = args.ph_hi;
#define IN(k) (lo <= (k) && (k) < hi)
#ifndef REPEAT_PHASE
#define REPEAT_PHASE -1
#endif
#define REP(k) for (int rep_ = 0; rep_ < ((k) == REPEAT_PHASE ? 2 : 1); ++rep_)
#define SEAM(k) do { if (IN(k) && IN((k) + 1)) xcd_barrier(bar); } while (0)

    if (IN(0)) REP(0) { if (rep_) xcd_barrier(bar); p0_prologue(F, in, ws); } SEAM(0);
    if (IN(1)) REP(1) { if (rep_) xcd_barrier(bar); p1_norm(F, in, ws); p1_router_fold(F, in, ws); } SEAM(1);
    if (IN(2)) REP(2) { if (rep_) xcd_barrier(bar);
        pg8::Gemm g{(const bf16*)(ws + WS_HN), (const bf16*)(ws + WS_WIN), LT, NP, D, nullptr, nullptr}; ConvOrder S; S.init(LT, NP, F.G, F.bid); S.in = in; S.ws = ws; S.scr = (LAS bf16*)(F.lds + CONV_SCR_OFF + F.wave * 2560); S.lane = F.lane; S.stride = F.G * NWAVES; S.cursor = TR_I_HEAD + F.bid * NWAVES + F.wave;
        EpiProj E{(bf16*)(ws + WS_PROJ), (float*)(ws + WS_DTRAW)};
        pg8::gemm_phase<EpiProj, ConvOrder, true, true>(F.lds, g, S, E);
        { const pg8::Unit du{0, 0, 0}; while (S.cursor < TR_I_ALL) S.done(du); }
    } SEAM(2);
#if NAIVE_SCAN
    if (IN(3)) REP(3) { if (rep_) xcd_barrier(bar); p3_prep(F, in, ws); } SEAM(3);
    if (IN(4)) REP(4) { if (rep_) xcd_barrier(bar); p4_ssd_naive(F, in, ws); p5_hgrn_naive(F, in, ws); } SEAM(4);
    SEAM(5);
    if (IN(6)) REP(6) { if (rep_) xcd_barrier(bar); p6_combine_naive(F, in, ws); } SEAM(6);
#else
    if (IN(3)) REP(3) { if (rep_) xcd_barrier(bar); p3_prep2(F, in, ws, args.mask); } SEAM(3);
    if (IN(4)) REP(4) { if (rep_) xcd_barrier(bar); p4_local(F, ws, args.mask); } SEAM(4);
    if (IN(5)) REP(5) { if (rep_) xcd_barrier(bar); p5_scan(F, ws); } SEAM(5);
    if (IN(6)) REP(6) { if (rep_) xcd_barrier(bar); p6_out(F, in, ws, args.mask); } SEAM(6);
#endif
    if (IN(7)) REP(7) { if (rep_) xcd_barrier(bar);
        pg8::Gemm g{(const bf16*)(ws + WS_Y2), (const bf16*)(ws + WS_WBS), L, D, D, (const bf16*)(ws + WS_Y2 + 64 * MiB), (const bf16*)(ws + WS_WBH)}; pg8::PairOrder S; S.init(L, D, F.G, F.bid);
        EpiBranch E{(const bf16*)(ws + WS_PROJ), (bf16*)(ws + WS_YM)};
        pg8::gemm_phase<EpiBranch, pg8::PairOrder, true, true>(F.lds, g, S, E);
    } if (IN(7) && IN(9)) xcd_barrier(bar);
    if (false) {}
    if (IN(9)) REP(9) { if (rep_) xcd_barrier(bar);
        pg8::Gemm g{(const bf16*)(ws + WS_YM), (const bf16*)(ws + WS_WO), L, D, D, nullptr, nullptr}; pg8::StaticOrder S; S.init(L, D, F.G, F.bid);
        EpiOut E{in[0], (const float*)(ws + WS_MOD) + 4096, (bf16*)(ws + WS_H1)};
        pg8::gemm_phase<EpiOut, pg8::StaticOrder, true, true>(F.lds, g, S, E);
    } SEAM(9);
    if (IN(10)) REP(10) { if (rep_) xcd_barrier(bar); p10_route(F, in, ws); } SEAM(10);
    if (IN(11)) REP(11) { if (rep_) xcd_barrier(bar); p11_gather(F, in, ws); } SEAM(11);
    if (IN(12)) REP(12) { if (rep_) xcd_barrier(bar);
        LAS int* blk_e = (LAS int*)(F.lds + MISC_OFF + 1024); LAS int* pad_start = blk_e + MAXBLK; LAS int* nblk_w = pad_start + 32;
        const int nblk = moe_tables(F, ws, blk_e, pad_start, nblk_w);
        pg8::Gemm g{(const bf16*)(ws + WS_XG), (const bf16*)(ws + WS_WGU), MAXSLOT, NEXP * 4096, D, nullptr, nullptr}; pg8::MoeGatherOrder S; S.init(nblk, 16, F.G, F.bid, blk_e);
        { LAS unsigned* rt = (LAS unsigned*)(F.lds + CONV_SCR_OFF); const int* TOK = (const int*)(ws + WS_ROUTE) + 4 * NASSIGN + MAXSLOT; pg8::Unit u;
          for (int i = 0; i < ROWTAB_UNITS && S.next(i, u); ++i) if (F.tid < 256) { const unsigned tk = (unsigned)TOK[u.pm * 256 + F.tid]; rt[i * 256 + F.tid] = (tk < (unsigned)L ? tk : 0u) * (unsigned)(D * 2); }
          S.rowtab = rt; __syncthreads(); }
        EpiMoe1 E{in[23], (bf16*)(ws + WS_ACT)};
        pg8::gemm_phase<EpiMoe1, pg8::MoeGatherOrder, true, true>(F.lds, g, S, E);
    } SEAM(12);
    if (IN(13)) REP(13) { if (rep_) xcd_barrier(bar);
        LAS int* blk_e = (LAS int*)(F.lds + MISC_OFF + 1024); LAS int* pad_start = blk_e + MAXBLK; LAS int* nblk_w = pad_start + 32;
        const int nblk = moe_tables(F, ws, blk_e, pad_start, nblk_w);
        pg8::Gemm g{(const bf16*)(ws + WS_ACT), (const bf16*)(ws + WS_WDN), MAXSLOT, NEXP * 2048, D, nullptr, nullptr}; pg8::MoeOrder S; S.init(nblk, 8, F.G, F.bid, blk_e);
        EpiMoe2 E{in[25], (const float*)(ws + WS_ROUTE) + 4 * NASSIGN, (bf16*)(ws + WS_Y2M)};
        pg8::gemm_phase<EpiMoe2, pg8::MoeOrder, true, true>(F.lds, g, S, E);
    } SEAM(13);
    if (IN(14)) REP(14) { if (rep_) xcd_barrier(bar); p14_final(F, in, args.out, ws); }
#undef IN
#undef SEAM
}

extern "C" void kernel_launch(void* const* d_in, const int* in_sizes, int n_in, void* d_out, int out_size, void* d_ws, size_t ws_size, hipStream_t stream) {
    static int grid = 0;
    if (grid == 0) {
        if (n_in != 27 || in_sizes[0] != L * D || out_size != L * D || ws_size < WS_END) { fprintf(stderr, "kernel_launch: unexpected shapes (n_in %d, in0 %d, out %d, ws %zu < %zu)\n", n_in, n_in > 0 ? in_sizes[0] : -1, out_size, ws_size, (size_t)WS_END); grid = -1; return; }
        int dev = 0, cus = 0, per_cu = 0;
        if (hipGetDevice(&dev) != hipSuccess || hipDeviceGetAttribute(&cus, hipDeviceAttributeMultiprocessorCount, dev) != hipSuccess) { grid = -1; return; }
        if (hipFuncSetAttribute((const void*)mega_fwd, hipFuncAttributeMaxDynamicSharedMemorySize, LDS_BYTES) != hipSuccess) { fprintf(stderr, "kernel_launch: hipFuncSetAttribute failed\n"); grid = -1; return; }
        if (hipOccupancyMaxActiveBlocksPerMultiprocessor(&per_cu, (const void*)mega_fwd, NWAVES * 64, LDS_BYTES) != hipSuccess || per_cu < 1) { fprintf(stderr, "kernel_launch: occupancy query reports %d\n", per_cu); }
        (void)hipGetLastError();
        grid = cus;
    }
    if (grid < 0) return;
    if (hipMemsetAsync((char*)d_ws + WS_CTL, 0, CTL_ZERO_BYTES, stream) != hipSuccess) return;
    Args a{};
    for (int i = 0; i < 27; ++i) a.in[i] = (const float*)d_in[i];
    a.out = (float*)d_out; a.ws = (unsigned char*)d_ws; a.mask = 7;
#if MK_PER_PHASE
    for (int p = 0; p < 15; ++p) { a.ph_lo = p; a.ph_hi = p + 1; hipLaunchKernelGGL(mega_fwd, dim3(grid), dim3(NWAVES * 64), LDS_BYTES, stream, a); }
#else
    a.ph_lo = 0; a.ph_hi = 15; hipLaunchKernelGGL(mega_fwd, dim3(grid), dim3(NWAVES * 64), LDS_BYTES, stream, a);
#endif
#if PROBE_PHASE >= 0
    a.ph_lo = PROBE_PHASE; a.ph_hi = PROBE_PHASE + 1; a.mask = PROBE_MASK; hipLaunchKernelGGL(mega_fwd, dim3(grid), dim3(NWAVES * 64), LDS_BYTES, stream, a);
#endif
}
```

```cpp
#include <hip/hip_runtime.h>
#include <cstdio>
#include <cstdint>

#ifndef NAIVE_SCAN
#define NAIVE_SCAN 0
#endif
#ifndef PROBE_PHASE
#define PROBE_PHASE -1
#endif
#ifndef PROBE_MASK
#define PROBE_MASK 7
#endif
#ifndef MK_PER_PHASE
#define MK_PER_PHASE 0
#endif

#define GAS __attribute__((address_space(1)))
#define LAS __attribute__((address_space(3)))
#define PG8_LAS __attribute__((address_space(3)))
typedef unsigned short bf16;
typedef unsigned v4u __attribute__((ext_vector_type(4)));
typedef unsigned v2u __attribute__((ext_vector_type(2)));
typedef float f32x4 __attribute__((ext_vector_type(4)));
typedef float f32x2 __attribute__((ext_vector_type(2)));
typedef short bf16x8 __attribute__((ext_vector_type(8)));

namespace pg8 {
typedef unsigned short bf16_t;
typedef unsigned u32x4 __attribute__((ext_vector_type(4)));
constexpr int BM = 256, BK = 64, HALF = 128, HTB = HALF * BK * 2  , STAGE_BYTES = 8 * HTB, NXCD = 8, WGM = 8;

__host__ __device__ __forceinline__ int lds_byte(int r, int c) { const int st = (r >> 4) * 2 + (c >> 5), rr = r & 15, cc = c & 31, ob = rr * 64 + cc * 2; return st * 1024 + (ob ^ (((ob >> 9) & 1) << 5)); }
__host__ __device__ __forceinline__ void stage_rc(int b, int& R, int& C) { const int st = b / 1024, sb = b % 1024, swz = sb ^ (((sb >> 9) & 1) << 5); R = (st >> 1) * 16 + swz / 64; C = (st & 1) * 32 + (swz % 64) / 2; }
__host__ __device__ __forceinline__ int perm32(int rho) { const int n = rho >> 4, i = rho & 15; return 8 * (i >> 2) + 4 * n + (i & 3); }

struct Unit { int pm, pn, sel; };
struct Gemm { const bf16_t* A; const bf16_t* Bt; int M, N, K; const bf16_t* A2; const bf16_t* Bt2; };

struct StaticOrder {
    static constexpr bool GATHER = false;
    int nM, nN, nwg, G, c;
    __host__ __device__ void init(int M, int N, int G_, int c_) { nM = M / BM; nN = N / BM; nwg = nM * nN; G = G_; c = c_; }
    __host__ __device__ bool next(int i, Unit& u) const {
        const long L = (long)i * G + c; if (L >= nwg) return false;
        int wgid = (int)L; { const int q = nwg / NXCD, r = nwg % NXCD, xcd = wgid % NXCD, off = wgid / NXCD; wgid = (xcd < r ? xcd * (q + 1) : r * (q + 1) + (xcd - r) * q) + off; }
        const int nig = WGM * nN, gid = wgid / nig, fm = gid * WGM, gsz = (nM - fm) < WGM ? (nM - fm) : WGM;
        u.pm = fm + ((wgid % nig) % gsz); u.pn = (wgid % nig) / gsz; u.sel = 0; return true;
    }
    __device__ __forceinline__ void a_ready(const Unit&) const {}
    __device__ __forceinline__ void done(const Unit&) const {}
};
struct PairOrder : StaticOrder {
    __device__ bool next(int i, Unit& u) const { const bool ok = StaticOrder::next(i >> 1, u); u.sel = i & 1; return ok; }
};
struct MoeOrder {
    static constexpr bool GATHER = false;
    int nM, nN, nwg, G, c; const LAS int* blk_e;
    __device__ void init(int nblk, int NT, int G_, int c_, const LAS int* tbl) { nM = nblk; nN = NT; nwg = nM * nN; G = G_; c = c_; blk_e = tbl; }
    __device__ __forceinline__ bool next(int i, Unit& u) const {
        const long L = (long)i * G + c; if (L >= nwg) return false;
        int wgid = (int)L; { const int q = nwg / NXCD, r = nwg % NXCD, xcd = wgid % NXCD, off = wgid / NXCD; wgid = (xcd < r ? xcd * (q + 1) : r * (q + 1) + (xcd - r) * q) + off; }
        const int nig = WGM * nN, gid = wgid / nig, fm = gid * WGM, gsz = (nM - fm) < WGM ? (nM - fm) : WGM;
        u.pm = fm + ((wgid % nig) % gsz); u.pn = blk_e[u.pm] * nN + (wgid % nig) / gsz; u.sel = 0; return true;
    }
    __device__ __forceinline__ void a_ready(const Unit&) const {}
    __device__ __forceinline__ void done(const Unit&) const {}
};

struct MoeGatherOrder : MoeOrder { static constexpr bool GATHER = true; const LAS unsigned* rowtab; };

typedef __bf16 bf16x2_t __attribute__((ext_vector_type(2)));
typedef float f32x2_t __attribute__((ext_vector_type(2)));
__device__ __forceinline__ unsigned cvt_pk_bf16(float lo, float hi) { const f32x2_t v = {lo, hi}; const bf16x2_t r = __builtin_convertvector(v, bf16x2_t); return __builtin_bit_cast(unsigned, r); }

template <class Epi, class Sched, bool ALIGN_EPI = false, bool SP2 = false>
__device__ __forceinline__ void gemm_phase(PG8_LAS unsigned char* lds, const Gemm g, const Sched& S, const Epi& E) {
    const int tid = threadIdx.x, wid = __builtin_amdgcn_readfirstlane(tid >> 6), lane = tid & 63, wr = wid >> 2, wc = wid & 3, fr = lane & 15, fq = lane >> 4;
    const int K = g.K, nt = K / BK;
    unsigned voffA[2], voffB[2];
#pragma unroll
    for (int i = 0; i < 2; ++i) { int R, C; stage_rc(tid * 16 + i * 8192, R, C); const int Rb = Epi::PERM ? ((R & ~31) + perm32(R & 31)) : R;
        voffA[i] = (unsigned)(R * K + C) * 2u; voffB[i] = (unsigned)(Rb * K + C) * 2u; }
    unsigned vC[2][2] = {{0u, 0u}, {0u, 0u}}, vN[2][2] = {{0u, 0u}, {0u, 0u}};
#define PG8_ROWOFF(dst, unit_) do { _Pragma("unroll") for (int i_ = 0; i_ < 2; ++i_) { int R_, C_; stage_rc(tid * 16 + i_ * 8192, R_, C_); \
        dst[0][i_] = S.rowtab[(unit_) * 256 + R_] + (unsigned)C_ * 2u; dst[1][i_] = S.rowtab[(unit_) * 256 + 128 + R_] + (unsigned)C_ * 2u; } } while (0)
    const size_t kstep = (size_t)(BK * 2);
    const size_t hstep = (size_t)HALF * K * 2;
    const size_t tstep = 2 * hstep;
    const size_t tstepA = Sched::GATHER ? (size_t)0 : tstep;
    const unsigned ldsw = (unsigned)wid * 1024u;
    const int aoff = lds_byte(wr * 64 + fr, fq * 8), boff = lds_byte(wc * 32 + fr, fq * 8);
#define PG8_SA(b, h) (((b) * 2 + (h)) * HTB)
#define PG8_SB(b, h) ((4 + (b) * 2 + (h)) * HTB)
#define PG8_STAGE(bufoff, gbase, voff) do { _Pragma("unroll") for (int _i = 0; _i < 2; ++_i) \
        __builtin_amdgcn_global_load_lds((const unsigned*)((const char*)(gbase) + (voff)[_i]), (PG8_LAS unsigned*)(lds + (bufoff) + ldsw + _i * 8192), 16, 0, 0); } while (0)
#define PG8_STAGE_A(bufoff, kptr, half, nx) do { if constexpr (Sched::GATHER) { _Pragma("unroll") for (int _i = 0; _i < 2; ++_i) \
        __builtin_amdgcn_global_load_lds((const unsigned*)((const char*)(kptr) + ((nx) ? vN[half][_i] : vC[half][_i])), (PG8_LAS unsigned*)(lds + (bufoff) + ldsw + _i * 8192), 16, 0, 0); } \
    else { PG8_STAGE(bufoff, (kptr) + ((half) ? hstep : (size_t)0), voffA); } } while (0)
#define PG8_LDA(dst, b, h) do { _Pragma("unroll") for (int m = 0; m < 4; ++m) _Pragma("unroll") for (int k = 0; k < 2; ++k) dst[m][k] = *(const PG8_LAS bf16x8*)(lds + PG8_SA(b, h) + aoff + m * 2048 + k * 1024); } while (0)
#define PG8_LDB(dst, b, h) do { _Pragma("unroll") for (int n = 0; n < 2; ++n) _Pragma("unroll") for (int k = 0; k < 2; ++k) dst[n][k] = *(const PG8_LAS bf16x8*)(lds + PG8_SB(b, h) + boff + n * 2048 + k * 1024); } while (0)
#define PG8_MMA(ai, bj, At, Bt) do { __builtin_amdgcn_s_setprio(1); _Pragma("unroll") for (int m = 0; m < 4; ++m) _Pragma("unroll") for (int n = 0; n < 2; ++n) _Pragma("unroll") for (int k = 0; k < 2; ++k) \
        acc[ai][bj][m][n] = __builtin_amdgcn_mfma_f32_16x16x32_bf16(Bt[n][k], At[m][k], acc[ai][bj][m][n], 0, 0, 0); __builtin_amdgcn_s_setprio(0); } while (0)
#define PG8_WAIT_V(n) asm volatile("s_waitcnt vmcnt(" #n ")" ::: "memory")
#define PG8_WAIT_L(n) asm volatile("s_waitcnt lgkmcnt(" #n ")" ::: "memory")
#define PG8_BAR __builtin_amdgcn_s_barrier()
#define PG8_SCHED __builtin_amdgcn_sched_barrier(0)
    Unit cur, nxt; int ui = 0;
    if (!S.next(0, cur)) return;
    f32x4 acc[2][2][4][2];
#pragma unroll
    for (int a = 0; a < 2; ++a)
#pragma unroll
        for (int b = 0; b < 2; ++b)
#pragma unroll
            for (int m = 0; m < 4; ++m)
#pragma unroll
                for (int n = 0; n < 2; ++n) acc[a][b][m][n] = (f32x4){0.f, 0.f, 0.f, 0.f};
    bf16x8 At[4][2], B0[2][2], B1[2][2];
    const char* cA = (const char*)(cur.sel ? g.A2 : g.A) + (size_t)cur.pm * tstepA; const char* cB = (const char*)(cur.sel ? g.Bt2 : g.Bt) + (size_t)cur.pn * tstep;
    if constexpr (Sched::GATHER) PG8_ROWOFF(vC, 0);
    S.a_ready(cur);
    if constexpr (SP2) {
        PG8_STAGE(PG8_SB(0, 0), cB, voffB); PG8_STAGE(PG8_SB(0, 1), cB + hstep, voffB); PG8_STAGE_A(PG8_SA(0, 0), cA, 0, false); PG8_STAGE_A(PG8_SA(0, 1), cA, 1, false);
        if (wr == 1) PG8_BAR;
        PG8_WAIT_V(2); PG8_BAR;
        PG8_STAGE(PG8_SB(1, 0), cB + kstep, voffB); PG8_STAGE_A(PG8_SA(1, 0), cA + kstep, 0, false); PG8_STAGE(PG8_SB(1, 1), cB + hstep + kstep, voffB);
        PG8_WAIT_V(6); PG8_BAR;
    } else {
        PG8_STAGE(PG8_SB(0, 0), cB, voffB); PG8_STAGE(PG8_SA(0, 0), cA, voffA); PG8_STAGE(PG8_SB(0, 1), cB + hstep, voffB); PG8_STAGE(PG8_SA(0, 1), cA + hstep, voffA);
        if (wr == 1) PG8_BAR;
        PG8_WAIT_V(4); PG8_BAR;
        PG8_STAGE(PG8_SB(1, 0), cB + kstep, voffB); PG8_STAGE(PG8_SA(1, 0), cA + kstep, voffA); PG8_STAGE(PG8_SB(1, 1), cB + hstep + kstep, voffB);
        PG8_WAIT_V(6); PG8_BAR;
    }
    for (;;) {
        const bool has_next = S.next(ui + 1, nxt);
        if constexpr (Sched::GATHER) { if (has_next) PG8_ROWOFF(vN, ui + 1); else { vN[0][0] = vC[0][0]; vN[0][1] = vC[0][1]; vN[1][0] = vC[1][0]; vN[1][1] = vC[1][1]; } }
        const char* nA = has_next ? (const char*)(nxt.sel ? g.A2 : g.A) + (size_t)nxt.pm * tstepA : cA; const char* nB = has_next ? (const char*)(nxt.sel ? g.Bt2 : g.Bt) + (size_t)nxt.pn * tstep : cB;
        for (int t = 0; t < nt; t += 2) {
            const bool last = (t == nt - 2);
            const char* a1 = cA + (size_t)(t + 1) * kstep;
            const char* a2 = last ? nA : cA + (size_t)(t + 2) * kstep; const char* b2 = last ? nB : cB + (size_t)(t + 2) * kstep;
            const char* a3 = a2 + kstep; const char* b3 = b2 + kstep;
            if (last && has_next) S.a_ready(nxt);
            if constexpr (SP2) {
            PG8_LDB(B0, 0, 0); PG8_LDB(B1, 0, 1); PG8_SCHED; PG8_LDA(At, 0, 0); PG8_STAGE_A(PG8_SA(1, 1), a1, 1, false);
            PG8_WAIT_V(8); PG8_WAIT_L(0); PG8_BAR; PG8_MMA(0, 0, At, B0); PG8_MMA(0, 1, At, B1); PG8_BAR; PG8_SCHED;
            PG8_LDA(At, 0, 1); PG8_STAGE(PG8_SB(0, 0), b2, voffB); PG8_STAGE(PG8_SB(0, 1), b2 + hstep, voffB); PG8_STAGE_A(PG8_SA(0, 0), a2, 0, last);
            PG8_WAIT_V(8); PG8_WAIT_L(0); PG8_BAR; PG8_MMA(1, 0, At, B0); PG8_MMA(1, 1, At, B1); PG8_BAR; PG8_SCHED;
            PG8_LDB(B0, 1, 0); PG8_LDB(B1, 1, 1); PG8_SCHED; PG8_LDA(At, 1, 0); PG8_STAGE_A(PG8_SA(0, 1), a2, 1, last);
            PG8_WAIT_V(8); PG8_WAIT_L(0); PG8_BAR; PG8_MMA(0, 0, At, B0); PG8_MMA(0, 1, At, B1); PG8_BAR; PG8_SCHED;
            PG8_LDA(At, 1, 1); PG8_STAGE(PG8_SB(1, 0), b3, voffB); PG8_STAGE(PG8_SB(1, 1), b3 + hstep, voffB); PG8_STAGE_A(PG8_SA(1, 0), a3, 0, last);
            PG8_WAIT_V(8); PG8_WAIT_L(0); PG8_BAR; PG8_MMA(1, 0, At, B0); PG8_MMA(1, 1, At, B1); PG8_BAR; PG8_SCHED;
            } else {
            PG8_LDB(B0, 0, 0); PG8_SCHED; PG8_LDA(At, 0, 0); PG8_STAGE(PG8_SA(1, 1), a1 + hstep, voffA);
            PG8_WAIT_L(8); PG8_BAR; PG8_WAIT_L(0); PG8_MMA(0, 0, At, B0); PG8_BAR; PG8_SCHED;
            PG8_LDB(B1, 0, 1); PG8_STAGE(PG8_SB(0, 0), b2, voffB);
            PG8_BAR; PG8_WAIT_L(0); PG8_MMA(0, 1, At, B1); PG8_BAR;
            PG8_LDA(At, 0, 1); PG8_STAGE(PG8_SA(0, 0), a2, voffA);
            PG8_BAR; PG8_WAIT_L(0); PG8_MMA(1, 0, At, B0); PG8_BAR; PG8_SCHED;
            PG8_STAGE(PG8_SB(0, 1), b2 + hstep, voffB);
            PG8_WAIT_V(6); PG8_BAR; PG8_MMA(1, 1, At, B1); PG8_BAR;
            PG8_LDB(B0, 1, 0); PG8_SCHED; PG8_LDA(At, 1, 0); PG8_STAGE(PG8_SA(0, 1), a2 + hstep, voffA);
            PG8_WAIT_L(8); PG8_BAR; PG8_WAIT_L(0); PG8_MMA(0, 0, At, B0); PG8_BAR; PG8_SCHED;
            PG8_LDB(B1, 1, 1); PG8_STAGE(PG8_SB(1, 0), b3, voffB);
            PG8_BAR; PG8_WAIT_L(0); PG8_MMA(0, 1, At, B1); PG8_BAR;
            PG8_LDA(At, 1, 1); PG8_STAGE(PG8_SA(1, 0), a3, voffA);
            PG8_BAR; PG8_WAIT_L(0); PG8_MMA(1, 0, At, B0); PG8_BAR; PG8_SCHED;
            PG8_STAGE(PG8_SB(1, 1), b3 + hstep, voffB);
            PG8_WAIT_V(6); PG8_BAR; PG8_MMA(1, 1, At, B1); PG8_BAR;
            }
        }
        if constexpr (ALIGN_EPI) { if (wr == 0) PG8_BAR; }
        bool keep = false;
        if constexpr (!Epi::AFTER_DRAIN) { if constexpr (Epi::CHAIN) keep = E.chain(acc, cur, wr, wc, fr, fq); else E(acc, cur, wr, wc, fr, fq); S.done(cur); }
        if (!has_next) break;
        if (!keep) {
#pragma unroll
        for (int a = 0; a < 2; ++a)
#pragma unroll
            for (int b = 0; b < 2; ++b)
#pragma unroll
                for (int m = 0; m < 4; ++m)
#pragma unroll
                    for (int n = 0; n < 2; ++n) acc[a][b][m][n] = (f32x4){0.f, 0.f, 0.f, 0.f};
        }
        cur = nxt; cA = nA; cB = nB; ++ui; vC[0][0] = vN[0][0]; vC[0][1] = vN[0][1]; vC[1][0] = vN[1][0]; vC[1][1] = vN[1][1];
        if constexpr (ALIGN_EPI) { if (wr == 1) PG8_BAR; }
    }
    PG8_WAIT_V(0);
    if constexpr (!ALIGN_EPI) { if (wr == 0) PG8_BAR; }
    PG8_BAR;
    if constexpr (Epi::AFTER_DRAIN) { E.fused(acc, cur, wr, wc, fr, fq, lds, wid, lane); S.done(cur); }
#undef PG8_SA
#undef PG8_SB
#undef PG8_STAGE
#undef PG8_LDA
#undef PG8_LDB
#undef PG8_MMA
#undef PG8_WAIT_V
#undef PG8_WAIT_L
#undef PG8_BAR
#undef PG8_SCHED
#undef PG8_STAGE_A
#undef PG8_ROWOFF
}

}

constexpr int D = 2048, L = 16384, LC = 256, LT = L + LC;
constexpr int NP = 19712;
constexpr int PW = 19456;
constexpr int PC_Z = 0, PC_X = 2048, PC_B = 4096, PC_C = 4608, PC_Q = 5120, PC_FF = 7168, PC_FB = 9216, PC_I = 11264, PC_G = 13312, PC_GS = 15360, PC_GH = 17408, PC_DT = 19456;
constexpr int NEXP = 32, TOPK = 4, NASSIGN = L * TOPK, MAXBLK = 288, MAXSLOT = MAXBLK * 256;
constexpr float EPS = 1e-6f;
__device__ __forceinline__ size_t pidx(size_t t, int col) { return ((size_t)(col >> 7) * LT + t) * 128 + (size_t)(col & 127); }

constexpr size_t MiB = 1u << 20;
constexpr size_t WS_CTL = 0, CTL_ZERO_BYTES = 65536;
constexpr size_t WS_MOD = 1 * MiB;
constexpr size_t WS_WR2 = WS_MOD + 131072;
constexpr size_t WS_RSTD = WS_MOD + 524288;
constexpr size_t WS_WIN = 2 * MiB;
constexpr size_t WS_WBS = 80 * MiB, WS_WBH = 88 * MiB, WS_WO = 96 * MiB;
constexpr size_t WS_WGU = 104 * MiB;
constexpr size_t WS_WDN = 616 * MiB;
constexpr size_t WS_HN = 872 * MiB;
constexpr size_t WS_PROJ = 937 * MiB;
constexpr size_t WS_DTRAW = 1555 * MiB;
constexpr size_t WS_XS = 1560 * MiB;
constexpr size_t WS_BN = 1625 * MiB, WS_CN = 1642 * MiB;
constexpr size_t WS_DTV = 1659 * MiB;
constexpr size_t WS_XT = 1664 * MiB;
constexpr size_t WS_BT = 1729 * MiB;
constexpr size_t WS_YF = 1746 * MiB, WS_YB = 1874 * MiB, WS_OF = 2002 * MiB, WS_OB = 2130 * MiB;
constexpr size_t WS_ACS = 1746 * MiB;
constexpr size_t WS_SST = 1751 * MiB;
constexpr size_t WS_HST = 1881 * MiB;
constexpr size_t WS_BETA = 2011 * MiB;
constexpr size_t WS_DEC = 2028 * MiB;
constexpr size_t WS_VT = 2031 * MiB;
constexpr size_t WS_QT = 2096 * MiB;
constexpr size_t WS_Y2 = 2258 * MiB;
constexpr size_t WS_PART = 2386 * MiB;
constexpr size_t WS_YM = 2514 * MiB;
constexpr size_t WS_H1 = 2578 * MiB;
constexpr size_t WS_HN2 = 2706 * MiB;
constexpr size_t WS_ROUTE = 2770 * MiB;
constexpr size_t WS_XG = 2772 * MiB, WS_ACT = 3060 * MiB, WS_Y2M = 3348 * MiB;
constexpr size_t WS_KD = 3636 * MiB;
constexpr size_t WS_KHT = 3766 * MiB;
constexpr size_t WS_SSTI = 3896 * MiB;
constexpr size_t WS_HSTI0 = WS_XS, WS_HSTI1 = 4024 * MiB;
constexpr size_t WS_END = 4088 * MiB;
static_assert(WS_WIN + (size_t)NP * D * 2 <= WS_WBS && WS_PROJ + (size_t)LT * PW * 2 <= WS_DTRAW && WS_DTRAW + (size_t)LT * 64 * 4 <= WS_XS && WS_BN + (size_t)LT * 512 * 2 <= WS_CN &&
              WS_CN + (size_t)LT * 512 * 2 <= WS_DTV && WS_DTV + (size_t)LT * 64 * 4 <= WS_XT && WS_BT + (size_t)LT * 512 * 2 <= WS_YF && WS_XG + (size_t)MAXSLOT * D * 2 <= WS_ACT, "d_ws map");
constexpr int CW_BAR = 4096;
constexpr int CW_GCNT = 8192;

constexpr int RING_BYTES = 131072;
constexpr int MISC_OFF = RING_BYTES;
constexpr int LDS_BYTES = 163840;
constexpr int ROWTAB_UNITS = (LDS_BYTES - RING_BYTES - 4096) / 1024;
constexpr int CONV_SCR_OFF = RING_BYTES + 4096;
constexpr int NWAVES = 8;

#define LDS_WAIT() asm volatile("s_waitcnt lgkmcnt(0)" ::: "memory")
#define VM_WAIT() asm volatile("s_waitcnt vmcnt(0)" ::: "memory")
__device__ __forceinline__ unsigned f2bf(float f) { unsigned u = __float_as_uint(f); return (u + 0x7fffu + ((u >> 16) & 1u)) >> 16; }
__device__ __forceinline__ unsigned pk2(float lo, float hi) { return f2bf(lo) | (f2bf(hi) << 16); }
__device__ __forceinline__ float bflo(unsigned w) { return __uint_as_float(w << 16); }
__device__ __forceinline__ float bfhi(unsigned w) { return __uint_as_float(w & 0xffff0000u); }
__device__ __forceinline__ float bf1(bf16 h) { return __uint_as_float(((unsigned)h) << 16); }
__device__ __forceinline__ float sigm(float x) { return __builtin_amdgcn_rcpf(1.f + __expf(-x)); }
__device__ __forceinline__ float silu(float x) { return x * __builtin_amdgcn_rcpf(1.f + __expf(-x)); }
__device__ __forceinline__ float wave_sum(float v) {
#pragma unroll
    for (int o = 1; o < 64; o <<= 1) v += __shfl_xor(v, o);
    return v;
}

#define XB_TMO      128
#define XB_XCNT(j)  (256  + 64 * (j))
#define XB_XSUB(j)  (1280 + 64 * (j))
#define XB_XGEN(j)  (2304 + 64 * (j))
#define XB_TOP      3328
#define XB_TOPGEN   3392
#define XCD_BAR_WORDS 3456
#define XB_SPIN_CAP (1u << 18)

__device__ __forceinline__ unsigned xb_ld(unsigned* p)              { return __hip_atomic_load(p, __ATOMIC_RELAXED, __HIP_MEMORY_SCOPE_AGENT); }
__device__ __forceinline__ unsigned xb_add(unsigned* p, unsigned v) { return __hip_atomic_fetch_add(p, v, __ATOMIC_RELAXED, __HIP_MEMORY_SCOPE_AGENT); }
__device__ __forceinline__ unsigned xb_xcc_id() { return (unsigned)__builtin_amdgcn_s_getreg((3 << 11) | 20) & 0xFu; }
#define XB_SPIN(cond, bar) do { unsigned _sp = 0; while (cond) { __builtin_amdgcn_s_sleep(1); \
    if ((++_sp & 255u) == 0u) { if (xb_ld(&(bar)[XB_TMO])) break; if (_sp > XB_SPIN_CAP) { atomicAdd(&(bar)[XB_TMO], 1u); break; } } } } while (0)

struct XcdBarrier {
    unsigned* bar; unsigned x;
    volatile LAS unsigned* st;
};

__device__ __forceinline__ XcdBarrier xcd_barrier_post(unsigned* bar, volatile LAS unsigned* st) {
    XcdBarrier b; b.bar = bar; b.x = xb_xcc_id(); b.st = st;
    if (threadIdx.x == 0) (void)xb_add(&bar[XB_XCNT(b.x)], 1u);
    return b;
}
__device__ __forceinline__ void xcd_barrier_complete(unsigned* bar, unsigned x, unsigned& nloc, unsigned& nx) {
    const unsigned G = gridDim.x * gridDim.y * gridDim.z;
    unsigned sum, cnt, mine, sp = 0u;
    for (;;) {
        sum = 0u; cnt = 0u; mine = 0u;
#pragma unroll
        for (unsigned j = 0; j < 16; ++j) { const unsigned c = xb_ld(&bar[XB_XCNT(j)]); sum += c; cnt += (c > 0u) ? 1u : 0u; mine = (j == x) ? c : mine; }
        if (sum == G) break;
        __builtin_amdgcn_s_sleep(1);
        if ((++sp & 255u) == 0u) { if (xb_ld(&bar[XB_TMO])) break; if (sp > XB_SPIN_CAP) { atomicAdd(&bar[XB_TMO], 1u); break; } }
    }
    nloc = mine > 0u ? mine : 1u; nx = cnt > 0u ? cnt : 1u;
}

__device__ __forceinline__ void xcd_barrier(const XcdBarrier& b) {
    asm volatile("s_waitcnt vmcnt(0)" ::: "memory");
    __syncthreads();
    if (threadIdx.x == 0) {
        unsigned* bar = b.bar;
        __builtin_amdgcn_s_waitcnt(0);
        unsigned nloc = b.st[0], nx = b.st[1];
        if (nloc == 0u) { xcd_barrier_complete(bar, b.x, nloc, nx); b.st[0] = nloc; b.st[1] = nx; }
        const unsigned old = xb_add(&bar[XB_XSUB(b.x)], 1u);
        const unsigned gen = old / nloc;
        if (old + 1u == (gen + 1u) * nloc) {
            __builtin_amdgcn_fence(__ATOMIC_RELEASE, "agent");
            asm volatile("s_waitcnt vmcnt(0)" ::: "memory");
            const unsigned og = xb_add(&bar[XB_TOP], 1u);
            const unsigned tg = og / nx;
            if (og + 1u == (tg + 1u) * nx) xb_add(&bar[XB_TOPGEN], 1u);
            else XB_SPIN(xb_ld(&bar[XB_TOPGEN]) == tg, bar);
            __builtin_amdgcn_fence(__ATOMIC_ACQUIRE, "agent");
            xb_add(&bar[XB_XGEN(b.x)], 1u);
            asm volatile("s_waitcnt vmcnt(0)" ::: "memory");
        } else {
            XB_SPIN(xb_ld(&bar[XB_XGEN(b.x)]) == gen, bar);
            __builtin_amdgcn_fence(__ATOMIC_ACQUIRE, "agent");
            asm volatile("s_waitcnt vmcnt(0)" ::: "memory");
        }
    }
    __syncthreads();
}

using pg8::Unit; using pg8::cvt_pk_bf16;
struct EpiProj {
    static constexpr bool PERM = true, AFTER_DRAIN = false, CHAIN = false;
    bf16* P; float* dtraw;
    __device__ __forceinline__ void operator()(const f32x4 (&acc)[2][2][4][2], const Unit& u, int wr, int wc, int fr, int fq) const {
        const int row0 = u.pm * 256 + wr * 64 + fr;
        if (u.pn < PW / 256) {
            const int col0 = u.pn * 256 + wc * 32 + 8 * fq; const bool si = u.pn >= PC_I / 256 && u.pn < (PC_I + 2048) / 256;
#pragma unroll
            for (int ai = 0; ai < 2; ++ai)
#pragma unroll
                for (int m = 0; m < 4; ++m) { bf16* rowp = P + pidx((size_t)(row0 + ai * 128 + m * 16), col0);
#pragma unroll
                    for (int bj = 0; bj < 2; ++bj) { f32x4 v0 = acc[ai][bj][m][0], v1 = acc[ai][bj][m][1];
                        if (si) {
#pragma unroll
                            for (int e_ = 0; e_ < 4; ++e_) { v0[e_] = silu(v0[e_]); v1[e_] = silu(v1[e_]); } }
                        v4u w; w.x = cvt_pk_bf16(v0[0], v0[1]); w.y = cvt_pk_bf16(v0[2], v0[3]); w.z = cvt_pk_bf16(v1[0], v1[1]); w.w = cvt_pk_bf16(v1[2], v1[3]);
                        *(v4u*)(rowp + (size_t)bj * LT * 128) = w; } }
        } else if (wc < 2) {
#pragma unroll
            for (int ai = 0; ai < 2; ++ai)
#pragma unroll
                for (int m = 0; m < 4; ++m) { float* rp = dtraw + (size_t)(row0 + ai * 128 + m * 16) * 64 + wc * 32 + 8 * fq;
                    *(f32x4*)rp = acc[ai][0][m][0]; *(f32x4*)(rp + 4) = acc[ai][0][m][1]; }
        }
    }
};
struct EpiBranch {
    static constexpr bool PERM = true, AFTER_DRAIN = false, CHAIN = true;
    const bf16* P; bf16* ym;
    __device__ __forceinline__ bool chain(f32x4 (&acc)[2][2][4][2], const Unit& u, int wr, int wc, int fr, int fq) const { if (u.sel == 0) { mid(acc, u, wr, wc, fr, fq); return true; } fin(acc, u, wr, wc, fr, fq); return false; }
    __device__ __forceinline__ void mid(f32x4 (&acc)[2][2][4][2], const Unit& u, int wr, int wc, int fr, int fq) const {
        const int row0 = u.pm * 256 + wr * 64 + fr, col0 = u.pn * 256 + wc * 32 + 8 * fq;
#pragma unroll
        for (int ai = 0; ai < 2; ++ai) { v4u gs[4][2], gh[4][2];
#pragma unroll
            for (int m = 0; m < 4; ++m)
#pragma unroll
                for (int bj = 0; bj < 2; ++bj) { const size_t r = (size_t)(row0 + ai * 128 + m * 16); gs[m][bj] = *(const v4u*)(P + pidx(r, PC_GS + col0 + bj * 128)); gh[m][bj] = *(const v4u*)(P + pidx(r, PC_GH + col0 + bj * 128)); }
#pragma unroll
            for (int m = 0; m < 4; ++m)
#pragma unroll
                for (int bj = 0; bj < 2; ++bj) { const unsigned gsw[4] = {gs[m][bj].x, gs[m][bj].y, gs[m][bj].z, gs[m][bj].w}, ghw[4] = {gh[m][bj].x, gh[m][bj].y, gh[m][bj].z, gh[m][bj].w};
#pragma unroll
                    for (int q = 0; q < 4; ++q) { const float r0 = (1.f + __expf(-bflo(ghw[q]))) * __builtin_amdgcn_rcpf(1.f + __expf(-bflo(gsw[q]))), r1 = (1.f + __expf(-bfhi(ghw[q]))) * __builtin_amdgcn_rcpf(1.f + __expf(-bfhi(gsw[q])));
                        acc[ai][bj][m][q >> 1][2 * (q & 1)] *= r0; acc[ai][bj][m][q >> 1][2 * (q & 1) + 1] *= r1; } }
            asm volatile("" ::: "memory"); }
    }
    __device__ __forceinline__ void fin(const f32x4 (&acc)[2][2][4][2], const Unit& u, int wr, int wc, int fr, int fq) const {
        const int row0 = u.pm * 256 + wr * 64 + fr, col0 = u.pn * 256 + wc * 32 + 8 * fq;
#pragma unroll
        for (int ai = 0; ai < 2; ++ai) { v4u gh[4][2];
#pragma unroll
            for (int m = 0; m < 4; ++m)
#pragma unroll
                for (int bj = 0; bj < 2; ++bj) gh[m][bj] = *(const v4u*)(P + pidx((size_t)(row0 + ai * 128 + m * 16), PC_GH + col0 + bj * 128));
#pragma unroll
            for (int m = 0; m < 4; ++m) { const size_t r = (size_t)(row0 + ai * 128 + m * 16);
#pragma unroll
                for (int bj = 0; bj < 2; ++bj) { const int c = col0 + bj * 128; const v4u g = gh[m][bj];
                    f32x4 v0 = acc[ai][bj][m][0], v1 = acc[ai][bj][m][1];
                    v0[0] *= sigm(bflo(g.x)); v0[1] *= sigm(bfhi(g.x)); v0[2] *= sigm(bflo(g.y)); v0[3] *= sigm(bfhi(g.y));
                    v1[0] *= sigm(bflo(g.z)); v1[1] *= sigm(bfhi(g.z)); v1[2] *= sigm(bflo(g.w)); v1[3] *= sigm(bfhi(g.w));
                    v4u w; w.x = cvt_pk_bf16(v0[0], v0[1]); w.y = cvt_pk_bf16(v0[2], v0[3]); w.z = cvt_pk_bf16(v1[0], v1[1]); w.w = cvt_pk_bf16(v1[2], v1[3]);
                    *(v4u*)(ym + r * D + c) = w; } }
            asm volatile("" ::: "memory"); }
    }
};
struct EpiOut {
    static constexpr bool PERM = true, AFTER_DRAIN = false, CHAIN = false;
    const float* x; const float* g1; bf16* h1;
    __device__ __forceinline__ void operator()(const f32x4 (&acc)[2][2][4][2], const Unit& u, int wr, int wc, int fr, int fq) const {
        const int row0 = u.pm * 256 + wr * 64 + fr, col0 = u.pn * 256 + wc * 32 + 8 * fq;
        f32x4 gv[2][2];
#pragma unroll
        for (int bj = 0; bj < 2; ++bj) { gv[bj][0] = *(const f32x4*)(g1 + col0 + bj * 128); gv[bj][1] = *(const f32x4*)(g1 + col0 + bj * 128 + 4); }
#pragma unroll
        for (int ai = 0; ai < 2; ++ai) { f32x4 xv[4][2][2];
#pragma unroll
            for (int m = 0; m < 4; ++m)
#pragma unroll
                for (int bj = 0; bj < 2; ++bj) { const float* xp = x + (size_t)(row0 + ai * 128 + m * 16) * D + col0 + bj * 128; xv[m][bj][0] = *(const f32x4*)xp; xv[m][bj][1] = *(const f32x4*)(xp + 4); }
#pragma unroll
            for (int m = 0; m < 4; ++m) { const size_t r = (size_t)(row0 + ai * 128 + m * 16);
#pragma unroll
                for (int bj = 0; bj < 2; ++bj) { const int c = col0 + bj * 128;
                    const f32x4 o0 = xv[m][bj][0] + gv[bj][0] * acc[ai][bj][m][0], o1 = xv[m][bj][1] + gv[bj][1] * acc[ai][bj][m][1];
                    v4u w; w.x = cvt_pk_bf16(o0[0], o0[1]); w.y = cvt_pk_bf16(o0[2], o0[3]); w.z = cvt_pk_bf16(o1[0], o1[1]); w.w = cvt_pk_bf16(o1[2], o1[3]);
                    *(v4u*)(h1 + r * D + c) = w; } }
            asm volatile("" ::: "memory"); }
    }
};
struct EpiMoe1 {
    static constexpr bool PERM = true, AFTER_DRAIN = false, CHAIN = false;
    const float* bgu; bf16* act;
    __device__ __forceinline__ void operator()(const f32x4 (&acc)[2][2][4][2], const Unit& u, int wr, int wc, int fr, int fq) const {
        const int e = u.pn >> 4, j = u.pn & 15, row0 = u.pm * 256 + wr * 64 + fr, gcol = 128 * j + wc * 32 + 8 * fq;
        const float* bb = bgu + (size_t)e * 4096 + gcol;
        f32x4 bg[2], bu[2];
        bg[0] = *(const f32x4*)bb; bg[1] = *(const f32x4*)(bb + 4); bu[0] = *(const f32x4*)(bb + 2048); bu[1] = *(const f32x4*)(bb + 2052);
#pragma unroll
        for (int ai = 0; ai < 2; ++ai)
#pragma unroll
            for (int m = 0; m < 4; ++m) { const size_t r = (size_t)(row0 + ai * 128 + m * 16); float o[8];
#pragma unroll
                for (int n = 0; n < 2; ++n)
#pragma unroll
                    for (int i = 0; i < 4; ++i) { float gt = acc[ai][0][m][n][i] + bg[n][i], up = acc[ai][1][m][n][i] + bu[n][i];
                        gt = fminf(gt, 7.0f); up = fminf(fmaxf(up, -7.0f), 7.0f);
                        const float glu = gt * sigm(1.702f * gt); o[4 * n + i] = (up + 1.0f) * glu; }
                v4u w; w.x = cvt_pk_bf16(o[0], o[1]); w.y = cvt_pk_bf16(o[2], o[3]); w.z = cvt_pk_bf16(o[4], o[5]); w.w = cvt_pk_bf16(o[6], o[7]);
                *(v4u*)(act + r * D + gcol) = w; }
    }
};
struct EpiMoe2 {
    static constexpr bool PERM = true, AFTER_DRAIN = false, CHAIN = false;
    const float* bdn; const float* rowp; bf16* y2m;
    __device__ __forceinline__ void operator()(const f32x4 (&acc)[2][2][4][2], const Unit& u, int wr, int wc, int fr, int fq) const {
        const int e = u.pn >> 3, j = u.pn & 7, row0 = u.pm * 256 + wr * 64 + fr, col0 = 256 * j + wc * 32 + 8 * fq;
        f32x4 bv[2][2];
#pragma unroll
        for (int bj = 0; bj < 2; ++bj) { bv[bj][0] = *(const f32x4*)(bdn + (size_t)e * D + col0 + bj * 128); bv[bj][1] = *(const f32x4*)(bdn + (size_t)e * D + col0 + bj * 128 + 4); }
        float pv[2][4];
#pragma unroll
        for (int ai = 0; ai < 2; ++ai)
#pragma unroll
            for (int m = 0; m < 4; ++m) pv[ai][m] = rowp[row0 + ai * 128 + m * 16];
#pragma unroll
        for (int ai = 0; ai < 2; ++ai)
#pragma unroll
            for (int m = 0; m < 4; ++m) { const size_t r = (size_t)(row0 + ai * 128 + m * 16); const float p = pv[ai][m];
#pragma unroll
                for (int bj = 0; bj < 2; ++bj) { const f32x4 v0 = (acc[ai][bj][m][0] + bv[bj][0]) * p, v1 = (acc[ai][bj][m][1] + bv[bj][1]) * p;
                    v4u w; w.x = cvt_pk_bf16(v0[0], v0[1]); w.y = cvt_pk_bf16(v0[2], v0[3]); w.z = cvt_pk_bf16(v1[0], v1[1]); w.w = cvt_pk_bf16(v1[2], v1[3]);
                    *(v4u*)(y2m + r * D + col0 + bj * 128) = w; } }
    }
};

struct Ctx {
    LAS unsigned char* lds; int tid, lane, wave, G, bid;
};

struct TrDesc { const float* src; bf16* dst; int ldsrc, k0, srccol0, K, dstrow0; };
__device__ __forceinline__ TrDesc tr_decode(int it, const float* const* in, unsigned char* ws) {
    constexpr int I_IN = 32 * (NP / 32), I_SQ = 32 * 64, I_GU = 32 * 128, I_DN = 32 * 64;
    TrDesc t; int r = it;
    if (r < I_IN) { const int nblk = NP / 32, kb = r / nblk, nb = r % nblk, n0 = 32 * nb;
        t.srccol0 = n0 < 5120 ? n0 : (n0 < PC_DT ? n0 + 64 : (n0 < PC_DT + 64 ? n0 - PC_DT + 5120 : -1));
        t.src = in[8]; t.ldsrc = 19520; t.k0 = 64 * kb; t.dst = (bf16*)(ws + WS_WIN); t.K = D; t.dstrow0 = n0; return t; } r -= I_IN;
    if (r < 3 * I_SQ) { const int w = r / I_SQ, rr = r % I_SQ, kb = rr / 64, nb = rr % 64;
        t.src = in[17 + w]; t.ldsrc = D; t.k0 = 64 * kb; t.srccol0 = 32 * nb; t.dst = (bf16*)(ws + (w == 0 ? WS_WBS : (w == 1 ? WS_WBH : WS_WO))); t.K = D; t.dstrow0 = 32 * nb; return t; } r -= 3 * I_SQ;
    if (r < NEXP * I_GU) { const int e = r / I_GU, rr = r % I_GU, kb = rr / 128, nb = rr % 128, n0 = 32 * nb, j = n0 >> 8, q = n0 & 255;
        t.srccol0 = q < 128 ? 128 * j + q : 2048 + 128 * j + (q - 128);
        t.src = in[22] + (size_t)e * D * 4096; t.ldsrc = 4096; t.k0 = 64 * kb; t.dst = (bf16*)(ws + WS_WGU); t.K = D; t.dstrow0 = e * 4096 + n0; return t; } r -= NEXP * I_GU;
    { const int e = r / I_DN, rr = r % I_DN, kb = rr / 64, nb = rr % 64;
        t.src = in[24] + (size_t)e * D * D; t.ldsrc = D; t.k0 = 64 * kb; t.srccol0 = 32 * nb; t.dst = (bf16*)(ws + WS_WDN); t.K = D; t.dstrow0 = e * D + 32 * nb; return t; }
}
__device__ __forceinline__ void tr_load(const TrDesc& t, f32x4 (&v)[8], int lane) {
    if (t.srccol0 >= 0) {
#pragma unroll
        for (int j = 0; j < 8; ++j) v[j] = *(const f32x4*)(t.src + (size_t)(t.k0 + 16 * (j >> 1) + 2 * (lane >> 3) + (j & 1)) * t.ldsrc + t.srccol0 + 4 * (lane & 7));
    } else {
#pragma unroll
        for (int j = 0; j < 8; ++j) v[j] = (f32x4){0.f, 0.f, 0.f, 0.f};
    }
}
__device__ __forceinline__ void tr_store(const TrDesc& t, const f32x4 (&v)[8], LAS bf16* scr, int lane) {
    const int kr = lane >> 3, n4 = lane & 7;
#pragma unroll
    for (int hf = 0; hf < 2; ++hf) {
#pragma unroll
        for (int m = 0; m < 2; ++m) { const f32x4 x0 = v[4 * hf + 2 * m], x1 = v[4 * hf + 2 * m + 1]; LAS unsigned* s32 = (LAS unsigned*)scr;
#pragma unroll
            for (int c = 0; c < 4; ++c) s32[(4 * n4 + c) * 20 + 8 * m + kr] = pg8::cvt_pk_bf16(x0[c], x1[c]); }
        LDS_WAIT(); asm volatile("" ::: "memory");
        const int n = lane >> 2, q = lane & 3;
        const v4u a = *(const LAS v4u*)(scr + n * 40 + q * 8), b = *(const LAS v4u*)(scr + (16 + n) * 40 + q * 8);
        bf16* dp = t.dst + (size_t)(t.dstrow0 + n) * t.K + t.k0 + 32 * hf + 8 * q;
        *(v4u*)dp = a; *(v4u*)(dp + (size_t)16 * t.K) = b;
        LDS_WAIT(); asm volatile("" ::: "memory");
    }
}
constexpr int TR_I_HEAD = 32 * (NP / 32) + 3 * 32 * 64;
constexpr int TR_I_ALL = TR_I_HEAD + NEXP * 32 * 128 + NEXP * 32 * 64;
__device__ __forceinline__ int tr_run(int first, int stride, int last, const float* const* in, unsigned char* ws, LAS bf16* scr, int lane) {
    int i0 = first, i1 = first + stride, i2 = first + 2 * stride; TrDesc d0, d1, d2; f32x4 a[8], b[8], c[8];
    d0 = tr_decode(i0 < last ? i0 : first, in, ws); d1 = d0; d2 = d0;
    if (i0 < last) tr_load(d0, a, lane);
    if (i1 < last) { d1 = tr_decode(i1, in, ws); tr_load(d1, b, lane); }
    if (i2 < last) { d2 = tr_decode(i2, in, ws); tr_load(d2, c, lane); }
#pragma unroll 1
    while (i0 < last) {
        tr_store(d0, a, scr, lane); i0 += 3 * stride; if (i0 < last) { d0 = tr_decode(i0, in, ws); tr_load(d0, a, lane); }
        if (i1 < last) { tr_store(d1, b, scr, lane); i1 += 3 * stride; if (i1 < last) { d1 = tr_decode(i1, in, ws); tr_load(d1, b, lane); } }
        if (i2 < last) { tr_store(d2, c, scr, lane); i2 += 3 * stride; if (i2 < last) { d2 = tr_decode(i2, in, ws); tr_load(d2, c, lane); } }
    }
    return i0;
}
struct ConvOrder : pg8::StaticOrder {
    const float* const* in; unsigned char* ws; LAS bf16* scr; int lane, stride; mutable int cursor;
    __device__ __forceinline__ void done(const pg8::Unit&) const {
        constexpr int IPU = 6;
        if (cursor >= TR_I_ALL) return;
        const int last = cursor + IPU * stride < TR_I_ALL ? cursor + IPU * stride : TR_I_ALL;
        (void)tr_run(cursor, stride, last, in, ws, scr, lane); cursor += IPU * stride;
        asm volatile("s_waitcnt vmcnt(0)" ::: "memory");
    }
};

__device__ __forceinline__ void p0_prologue(const Ctx& F, const float* const* in, unsigned char* ws) {
    {
        const float* cvec = in[1]; const float* cctx = in[3]; const float* w_ada = in[4]; const float* b_ada = in[5];
        float* mod = (float*)(ws + WS_MOD); float* modc = mod + 12288;
        LAS float* s1 = (LAS float*)F.lds; LAS float* s2 = s1 + 2048; LAS float* red = s2 + 2048;
        for (int k = F.tid; k < 2048; k += 512) { s1[k] = silu(cvec[k]); s2[k] = silu(cctx[k]); }
        __syncthreads();
        for (int cg = F.bid; cg < 256; cg += F.G) {
            const int q = F.tid % 12, kg = F.tid / 12;
            f32x4 a1 = {0.f, 0.f, 0.f, 0.f}, a2 = {0.f, 0.f, 0.f, 0.f};
            if (kg < 42) for (int k = kg; k < 2048; k += 42) { const f32x4 w = *(const f32x4*)(w_ada + (size_t)k * 12288 + cg * 48 + 4 * q); a1 += w * s1[k]; a2 += w * s2[k]; }
            if (kg < 42) {
#pragma unroll
                for (int i = 0; i < 4; ++i) { red[(0 * 42 + kg) * 48 + 4 * q + i] = a1[i]; red[(1 * 42 + kg) * 48 + 4 * q + i] = a2[i]; } }
            __syncthreads();
            if (F.tid < 96) { const int which = F.tid / 48, col = F.tid % 48; float s = 0.f; for (int g = 0; g < 42; ++g) s += red[(which * 42 + g) * 48 + col];
                s += b_ada[cg * 48 + col]; (which ? modc : mod)[cg * 48 + col] = s; }
            __syncthreads();
        }
    }
    LAS bf16* scr = (LAS bf16*)(F.lds + 40960 + F.wave * 2560);
    const int gw = F.bid * NWAVES + F.wave, NGW = F.G * NWAVES;
    constexpr int NITEMS = TR_I_HEAD;
    (void)tr_run(gw, NGW, NITEMS, in, ws, scr, F.lane);
}

__device__ __forceinline__ void p1_rows(const Ctx& F, const float* src0, const float* sh, const float* sc, const float* w1, bf16* hn0, int nrows) {
    const int gw = F.bid * NWAVES + F.wave, NGW = F.G * NWAVES;
    if (gw >= nrows) return;
    f32x4 sv[4][2], hv[4][2];
#pragma unroll
    for (int j = 0; j < 4; ++j)
#pragma unroll
        for (int q = 0; q < 2; ++q) { const int col = 8 * F.lane + 512 * j + 4 * q; sv[j][q] = *(const f32x4*)(w1 + col) * (*(const f32x4*)(sc + col) + 1.0f); hv[j][q] = *(const f32x4*)(sh + col); }
    for (int row = gw; row < nrows; row += NGW) {
        const float* src = src0 + (size_t)row * D; f32x4 v[4][2]; float ss = 0.f;
#pragma unroll
        for (int j = 0; j < 4; ++j)
#pragma unroll
            for (int q = 0; q < 2; ++q) { v[j][q] = *(const f32x4*)(src + 8 * F.lane + 512 * j + 4 * q); ss += (v[j][q][0] * v[j][q][0] + v[j][q][1] * v[j][q][1]) + (v[j][q][2] * v[j][q][2] + v[j][q][3] * v[j][q][3]); }
        const float rstd = 1.0f / sqrtf(wave_sum(ss) * (1.0f / D) + EPS);
#pragma unroll
        for (int j = 0; j < 4; ++j) { const f32x4 o0 = v[j][0] * rstd * sv[j][0] + hv[j][0], o1 = v[j][1] * rstd * sv[j][1] + hv[j][1];
            v4u pk; pk.x = pg8::cvt_pk_bf16(o0[0], o0[1]); pk.y = pg8::cvt_pk_bf16(o0[2], o0[3]); pk.z = pg8::cvt_pk_bf16(o1[0], o1[1]); pk.w = pg8::cvt_pk_bf16(o1[2], o1[3]);
            *(v4u*)(hn0 + (size_t)row * D + 8 * F.lane + 512 * j) = pk; }
    }
}
__device__ __forceinline__ void p1_norm(const Ctx& F, const float* const* in, unsigned char* ws) {
    const float* mod = (const float*)(ws + WS_MOD); const float* modc = mod + 12288; bf16* hn = (bf16*)(ws + WS_HN);
    p1_rows(F, in[0], mod, mod + 2048, in[6], hn, L);
    p1_rows(F, in[2], modc, modc + 2048, in[6], hn + (size_t)L * D, LC);
}

__device__ __forceinline__ void p1_router_fold(const Ctx& F, const float* const* in, unsigned char* ws) {
    const float* mod = (const float*)(ws + WS_MOD); const float* sh2 = mod + 6144; const float* sc2 = mod + 8192; const float* w2 = in[7]; const float* wr = in[20];
    f32x4* W2 = (f32x4*)(ws + WS_WR2); float* cvec = (float*)(ws + WS_WR2 + 262144);
    for (int u = F.bid * 512 + F.tid; u < 16384; u += F.G * 512) { const int e = u & 31, hf = (u >> 5) & 1, kq = (u >> 6) & 3, j = u >> 8; f32x4 o;
#pragma unroll
        for (int i = 0; i < 4; ++i) { const int k = 32 * j + 8 * kq + 4 * hf + i; o[i] = w2[k] * (1.0f + sc2[k]) * wr[k * 32 + e]; }
        W2[u] = o; }
    { const int e = F.bid * NWAVES + F.wave;
      if (e < NEXP) { float s = 0.f;
#pragma unroll 8
          for (int j = 0; j < 32; ++j) { const int k = F.lane + 64 * j; s += sh2[k] * wr[k * 32 + e]; }
          s = wave_sum(s); if (F.lane == 0) cvec[e] = s + in[21][e]; } }
}

__device__ __forceinline__ void p3_prep(const Ctx& F, const float* const* in, unsigned char* ws) {
    const bf16* P = (const bf16*)(ws + WS_PROJ); const float* cw = in[9]; const float* cb = in[10];
    bf16* XS = (bf16*)(ws + WS_XS); bf16* BN = (bf16*)(ws + WS_BN); bf16* CN = (bf16*)(ws + WS_CN);
    constexpr int NT = LT / 64, NS = 24, NCONV = NT * NS;
    for (int it = F.bid; it < NCONV + NT; it += F.G) {
        if (it < NCONV) {
            const int tt = it / NS, sb = it % NS, tl = F.tid >> 3, cg = F.tid & 7, t = tt * 64 + tl, ch0 = sb * 128 + cg * 16;
            const int r0 = t < L ? tt * 64 : L, r1 = t < L ? tt * 64 + 64 : LT;
            float a[16];
#pragma unroll
            for (int i = 0; i < 16; i += 4) { const f32x4 b = *(const f32x4*)(cb + ch0 + i); a[i] = b[0]; a[i + 1] = b[1]; a[i + 2] = b[2]; a[i + 3] = b[3]; }
#pragma unroll
            for (int k = 0; k < 4; ++k) { const int ts = t + k - 2;
                if (ts >= r0 && ts < r1) { const v4u u0 = *(const v4u*)(P + pidx((size_t)ts, PC_X + ch0)), u1 = *(const v4u*)(P + pidx((size_t)ts, PC_X + ch0 + 8));
                    const unsigned uu[8] = {u0.x, u0.y, u0.z, u0.w, u1.x, u1.y, u1.z, u1.w};
#pragma unroll
                    for (int i = 0; i < 8; ++i) { const float w0 = cw[k * 3072 + ch0 + 2 * i], w1 = cw[k * 3072 + ch0 + 2 * i + 1]; a[2 * i] += w0 * bflo(uu[i]); a[2 * i + 1] += w1 * bfhi(uu[i]); } } }
            v4u o0, o1;
            o0.x = pk2(silu(a[0]), silu(a[1])); o0.y = pk2(silu(a[2]), silu(a[3])); o0.z = pk2(silu(a[4]), silu(a[5])); o0.w = pk2(silu(a[6]), silu(a[7]));
            o1.x = pk2(silu(a[8]), silu(a[9])); o1.y = pk2(silu(a[10]), silu(a[11])); o1.z = pk2(silu(a[12]), silu(a[13])); o1.w = pk2(silu(a[14]), silu(a[15]));
            bf16* dst = ch0 < 2048 ? XS + (size_t)t * 2048 + ch0 : (ch0 < 2560 ? BN + (size_t)t * 512 + (ch0 - 2048) : CN + (size_t)t * 512 + (ch0 - 2560));
            *(v4u*)dst = o0; *(v4u*)(dst + 8) = o1;
        } else {
            const int tt = it - NCONV, t = tt * 64 + (F.tid >> 3), dh0 = (F.tid & 7) * 8;
            const float* dr = (const float*)(ws + WS_DTRAW) + (size_t)t * 64 + dh0; float* dtv = (float*)(ws + WS_DTV);
#pragma unroll
            for (int i = 0; i < 8; ++i) { const float xx = dr[i] + in[11][dh0 + i]; const float sp = fmaxf(xx, 0.f) + log1pf(expf(-fabsf(xx))); dtv[(size_t)(dh0 + i) * LT + t] = sp; }
        }
    }
}

__device__ __forceinline__ void p4_ssd_naive(const Ctx& F, const float* const* in, unsigned char* ws) {
    const bf16* XS = (const bf16*)(ws + WS_XS); const bf16* BN = (const bf16*)(ws + WS_BN); const bf16* CN = (const bf16*)(ws + WS_CN); const float* DTV = (const float*)(ws + WS_DTV);
    for (int u = F.bid * 512 + F.tid; u < 131072; u += F.G * 512) {
        const int nq = u & 31, p = (u >> 5) & 63, h = (u >> 11) & 31, d = u >> 16, g = h >> 3;
        const float A = -expf(in[12][d * 32 + h]);
        float* Y = (float*)(ws + (d ? WS_YB : WS_YF));
        const float* dtp = DTV + (size_t)(d * 32 + h) * LT;
        float S0 = 0.f, S1 = 0.f, S2 = 0.f, S3 = 0.f;
        for (int i = 0; i < LT; ++i) {
            const int tok = d == 0 ? (i < LC ? L + i : i - LC) : (i < LC ? LT - 1 - i : L - 1 - (i - LC));
            const float dt = dtp[tok], dec = __expf(A * dt), xv = bf1(XS[(size_t)tok * 2048 + h * 64 + p]) * dt;
            const v2u bq = *(const v2u*)(BN + (size_t)tok * 512 + g * 128 + 4 * nq), cq = *(const v2u*)(CN + (size_t)tok * 512 + g * 128 + 4 * nq);
            S0 = S0 * dec + xv * bflo(bq.x); S1 = S1 * dec + xv * bfhi(bq.x); S2 = S2 * dec + xv * bflo(bq.y); S3 = S3 * dec + xv * bfhi(bq.y);
            float y = (bflo(cq.x) * S0 + bfhi(cq.x) * S1) + (bflo(cq.y) * S2 + bfhi(cq.y) * S3);
            y += __shfl_xor(y, 1); y += __shfl_xor(y, 2); y += __shfl_xor(y, 4); y += __shfl_xor(y, 8); y += __shfl_xor(y, 16);
            if (nq == 0 && tok < L) Y[(size_t)tok * 2048 + h * 64 + p] = y;
        }
    }
}
__device__ __forceinline__ void p5_hgrn_naive(const Ctx& F, const float* const* in, unsigned char* ws) {
    const bf16* P = (const bf16*)(ws + WS_PROJ);
    for (int u = F.bid * 512 + F.tid; u < 131072; u += F.G * 512) {
        const int kq = u & 31, v = (u >> 5) & 127, h = (u >> 12) & 15, d = u >> 16;
        float* O = (float*)(ws + (d ? WS_OB : WS_OF));
        float lb[4];
#pragma unroll
        for (int j = 0; j < 4; ++j) { const int k = h * 128 + 4 * kq + j; lb[j] = 1.0f / (1.0f + expf(in[15][(d * 2 + 1) * 2048 + k] - in[15][(d * 2 + 0) * 2048 + k])); }
        float S[4] = {0.f, 0.f, 0.f, 0.f};
        const int fcol = (d ? PC_FB : PC_FF) + h * 128 + 4 * kq, qcol = PC_Q + h * 128 + 4 * kq, icol = PC_I + h * 128 + v;
        for (int i = 0; i < LT; ++i) {
            const int tok = d == 0 ? (i < LC ? L + i : i - LC) : (i < LC ? LT - 1 - i : L - 1 - (i - LC));
            const v2u fq = *(const v2u*)(P + pidx((size_t)tok, fcol)), qq = *(const v2u*)(P + pidx((size_t)tok, qcol)); const float vv = silu(bf1(P[pidx((size_t)tok, icol)]));
            const float fr[4] = {bflo(fq.x), bfhi(fq.x), bflo(fq.y), bfhi(fq.y)}; const float qv[4] = {bflo(qq.x), bfhi(qq.x), bflo(qq.y), bfhi(qq.y)};
            float o = 0.f;
#pragma unroll
            for (int j = 0; j < 4; ++j) { const float kin = (1.0f - lb[j]) * sigm(-fr[j]), f = 1.0f - kin; S[j] = f * S[j] + kin * vv; o += qv[j] * S[j]; }
            o += __shfl_xor(o, 1); o += __shfl_xor(o, 2); o += __shfl_xor(o, 4); o += __shfl_xor(o, 8); o += __shfl_xor(o, 16);
            if (kq == 0 && tok < L) O[(size_t)tok * 2048 + h * 128 + v] = o * 0.08838834764831845f;
        }
    }
}
__device__ __forceinline__ void p6_combine_naive(const Ctx& F, const float* const* in, unsigned char* ws) {
    const bf16* P = (const bf16*)(ws + WS_PROJ); const bf16* XS = (const bf16*)(ws + WS_XS);
    const float* YF = (const float*)(ws + WS_YF); const float* YB = (const float*)(ws + WS_YB); const float* OF = (const float*)(ws + WS_OF); const float* OB = (const float*)(ws + WS_OB);
    bf16* Y2S = (bf16*)(ws + WS_Y2); bf16* Y2H = (bf16*)(ws + WS_Y2 + 64 * MiB);
    const int gw = F.bid * NWAVES + F.wave, NGW = F.G * NWAVES;
    for (int t = gw; t < L; t += NGW) {
        f32x4 y[8]; float part[8];
#pragma unroll
        for (int j = 0; j < 8; ++j) { const int col = 4 * F.lane + 256 * j; const size_t o = (size_t)t * 2048 + col;
            const f32x4 a = *(const f32x4*)(YF + o), b = *(const f32x4*)(YB + o); const v2u xs = *(const v2u*)(XS + o), zz = *(const v2u*)(P + pidx((size_t)t, PC_Z + col));
            const float dsk = in[13][col >> 6];
            f32x4 v; v[0] = a[0] + b[0] + dsk * bflo(xs.x); v[1] = a[1] + b[1] + dsk * bfhi(xs.x); v[2] = a[2] + b[2] + dsk * bflo(xs.y); v[3] = a[3] + b[3] + dsk * bfhi(xs.y);
            v[0] *= silu(bflo(zz.x)); v[1] *= silu(bfhi(zz.x)); v[2] *= silu(bflo(zz.y)); v[3] *= silu(bfhi(zz.y));
            y[j] = v; part[j] = (v[0] * v[0] + v[1] * v[1]) + (v[2] * v[2] + v[3] * v[3]); }
#pragma unroll
        for (int g = 0; g < 4; ++g) { const float ss = wave_sum(part[2 * g] + part[2 * g + 1]); const float rstd = 1.0f / sqrtf(ss * (1.0f / 512.0f) + EPS);
#pragma unroll
            for (int jj = 0; jj < 2; ++jj) { const int j = 2 * g + jj, col = 4 * F.lane + 256 * j; const f32x4 w = *(const f32x4*)(in[14] + col); const f32x4 o = y[j] * rstd * w;
                v2u pk; pk.x = pk2(o[0], o[1]); pk.y = pk2(o[2], o[3]); *(v2u*)(Y2S + (size_t)t * 2048 + col) = pk; } }
#pragma unroll
        for (int j = 0; j < 8; ++j) { const int col = 4 * F.lane + 256 * j; const size_t o = (size_t)t * 2048 + col;
            const f32x4 a = *(const f32x4*)(OF + o), b = *(const f32x4*)(OB + o); f32x4 v = a + b;
            float ss = (v[0] * v[0] + v[1] * v[1]) + (v[2] * v[2] + v[3] * v[3]);
            ss += __shfl_xor(ss, 1); ss += __shfl_xor(ss, 2); ss += __shfl_xor(ss, 4); ss += __shfl_xor(ss, 8); ss += __shfl_xor(ss, 16);
            const float rstd = 1.0f / sqrtf(ss * (1.0f / 128.0f) + EPS);
            const f32x4 w = *(const f32x4*)(in[16] + (col & 127)); const v2u gg = *(const v2u*)(P + pidx((size_t)t, PC_G + col));
            v = v * rstd * w; v[0] *= silu(bflo(gg.x)); v[1] *= silu(bfhi(gg.x)); v[2] *= silu(bflo(gg.y)); v[3] *= silu(bfhi(gg.y));
            v2u pk; pk.x = pk2(v[0], v[1]); pk.y = pk2(v[2], v[3]); *(v2u*)(Y2H + (size_t)t * 2048 + col) = pk; }
    }
}

__device__ __forceinline__ void p10_route(const Ctx& F, const float* const* in, unsigned char* ws) {
    const bf16* H1 = (const bf16*)(ws + WS_H1); const f32x4* W2 = (const f32x4*)(ws + WS_WR2); const float* cvec = (const float*)(ws + WS_WR2 + 262144);
    unsigned* gcnt = (unsigned*)(ws + WS_CTL) + CW_GCNT; float* RSTD = (float*)(ws + WS_RSTD);
    int* A_E = (int*)(ws + WS_ROUTE); int* A_POS = A_E + NASSIGN; float* A_P = (float*)(A_POS + NASSIGN);
    LAS float* part = (LAS float*)F.lds;
    LAS int* lcnt = (LAS int*)(F.lds + 16384); LAS int* lbase = lcnt + 32; LAS int* rec_e = lbase + 32; LAS int* rec_lp = rec_e + 256; LAS float* rec_p = (LAS float*)(rec_lp + 256);
    const int l15 = F.lane & 15, g4 = F.lane >> 4, tg = F.wave & 3, kh = F.wave >> 2;
    for (int tb = F.bid; tb < L / 64; tb += F.G) {
        if (F.tid < 32) lcnt[F.tid] = 0;
        const int tok = tb * 64 + tg * 16 + l15;
        f32x4 acc0 = {0.f, 0.f, 0.f, 0.f}, acc1 = {0.f, 0.f, 0.f, 0.f}; float ss = 0.f;
        const bf16* hp = H1 + (size_t)tok * D + 8 * g4;
#pragma unroll 1
        for (int jb = kh * 32; jb < kh * 32 + 32; jb += 4) {
            v4u raw[4]; f32x4 bq[4][4];
#pragma unroll
            for (int u = 0; u < 4; ++u) { const int j = jb + u; raw[u] = *(const v4u*)(hp + 32 * j); const f32x4* wq = W2 + ((j * 4 + g4) * 2) * 32;
                bq[u][0] = wq[l15]; bq[u][1] = wq[16 + l15]; bq[u][2] = wq[32 + l15]; bq[u][3] = wq[48 + l15]; }
            __builtin_amdgcn_sched_barrier(0);
#pragma unroll
            for (int u = 0; u < 4; ++u) {
                const f32x4 a4 = {bflo(raw[u].x), bfhi(raw[u].x), bflo(raw[u].y), bfhi(raw[u].y)}, a5 = {bflo(raw[u].z), bfhi(raw[u].z), bflo(raw[u].w), bfhi(raw[u].w)};
                ss += ((a4[0] * a4[0] + a4[1] * a4[1]) + (a4[2] * a4[2] + a4[3] * a4[3])) + ((a5[0] * a5[0] + a5[1] * a5[1]) + (a5[2] * a5[2] + a5[3] * a5[3]));
#pragma unroll
                for (int i = 0; i < 4; ++i) { acc0 = __builtin_amdgcn_mfma_f32_16x16x4f32(a4[i], bq[u][0][i], acc0, 0, 0, 0); acc1 = __builtin_amdgcn_mfma_f32_16x16x4f32(a4[i], bq[u][1][i], acc1, 0, 0, 0); }
#pragma unroll
                for (int i = 0; i < 4; ++i) { acc0 = __builtin_amdgcn_mfma_f32_16x16x4f32(a5[i], bq[u][2][i], acc0, 0, 0, 0); acc1 = __builtin_amdgcn_mfma_f32_16x16x4f32(a5[i], bq[u][3][i], acc1, 0, 0, 0); } }
            __builtin_amdgcn_sched_barrier(0);
        }
        ss += __shfl_xor(ss, 16); ss += __shfl_xor(ss, 32);
        if (kh == 1) {
#pragma unroll
            for (int r = 0; r < 4; ++r) { part[(tg * 9 + r) * 64 + F.lane] = acc0[r]; part[(tg * 9 + 4 + r) * 64 + F.lane] = acc1[r]; }
            part[(tg * 9 + 8) * 64 + F.lane] = ss; }
        __syncthreads();
        if (kh == 0) {
#pragma unroll
            for (int r = 0; r < 4; ++r) { acc0[r] += part[(tg * 9 + r) * 64 + F.lane]; acc1[r] += part[(tg * 9 + 4 + r) * 64 + F.lane]; }
            ss += part[(tg * 9 + 8) * 64 + F.lane];
            const float rstd = 1.0f / sqrtf(ss * (1.0f / D) + EPS);
            if (g4 == 0) RSTD[tok] = rstd;
            const float c0 = cvec[l15], c1 = cvec[16 + l15];
#pragma unroll
            for (int r = 0; r < 4; ++r) { const float rs = __shfl(rstd, 4 * g4 + r);
                float v0 = acc0[r] * rs + c0, v1 = acc1[r] * rs + c1; int te[4]; float tv[4];
#pragma unroll
                for (int i = 0; i < 4; ++i) { float bv = v0 >= v1 ? v0 : v1; int bi = v0 >= v1 ? l15 : 16 + l15;
#pragma unroll
                    for (int o = 1; o < 16; o <<= 1) { const float ov = __shfl_xor(bv, o); const int oi = __shfl_xor(bi, o); const bool take = ov > bv || (ov == bv && oi < bi); bv = take ? ov : bv; bi = take ? oi : bi; }
                    bi = (bi < 0 || bi > 31) ? i : bi;
                    te[i] = bi; tv[i] = bv; if (bi == l15) v0 = -__builtin_inff(); if (bi == 16 + l15) v1 = -__builtin_inff(); }
                const float e1 = expf(tv[1] - tv[0]), e2 = expf(tv[2] - tv[0]), e3 = expf(tv[3] - tv[0]); const float inv = 1.0f / (1.0f + e1 + e2 + e3);
                const float pr[4] = {inv, e1 * inv, e2 * inv, e3 * inv};
                if (l15 == 0) { const int tl = tg * 16 + 4 * g4 + r;
#pragma unroll
                    for (int i = 0; i < 4; ++i) { const int lp = __hip_atomic_fetch_add(&lcnt[te[i]], 1, __ATOMIC_RELAXED, __HIP_MEMORY_SCOPE_WORKGROUP); rec_e[tl * 4 + i] = te[i]; rec_lp[tl * 4 + i] = lp; rec_p[tl * 4 + i] = pr[i]; } } }
        }
        __syncthreads();
        if (F.tid < 32) { const int c = lcnt[F.tid]; lbase[F.tid] = c ? (int)__hip_atomic_fetch_add(gcnt + F.tid * 64, (unsigned)c, __ATOMIC_RELAXED, __HIP_MEMORY_SCOPE_AGENT) : 0; }
        __syncthreads();
        if (F.tid < 256) { const int a = F.tid, t = tb * 64 + (a >> 2), ee = rec_e[a]; A_E[4 * t + (a & 3)] = ee; A_POS[4 * t + (a & 3)] = lbase[ee] + rec_lp[a]; A_P[4 * t + (a & 3)] = rec_p[a]; }
        __syncthreads();
    }
}
__device__ __forceinline__ int moe_tables(const Ctx& F, unsigned char* ws, LAS int* blk_e, LAS int* pad_start, LAS int* nblk_w) {
    const unsigned* gcnt = (const unsigned*)(ws + WS_CTL) + CW_GCNT;
    if (F.tid < 64) { const int e = F.lane & 31; const int c = (int)__hip_atomic_load(gcnt + e * 64, __ATOMIC_RELAXED, __HIP_MEMORY_SCOPE_AGENT); const int nbe = (c + 255) >> 8;
        int incl = nbe;
#pragma unroll
        for (int o = 1; o < 32; o <<= 1) { const int v = __shfl_up(incl, o, 32); if (e >= o) incl += v; }
        const int start = incl - nbe;
        if (F.lane < 32) { pad_start[e] = start * 256; for (int j = 0; j < nbe && start + j < MAXBLK; ++j) blk_e[start + j] = e; if (e == 31) nblk_w[0] = incl < MAXBLK ? incl : MAXBLK; } }
    __syncthreads();
    return nblk_w[0];
}
typedef int i32x4 __attribute__((ext_vector_type(4)));
__device__ __forceinline__ void p11_gather(const Ctx& F, const float* const* in, unsigned char* ws) {
    LAS int* blk_e = (LAS int*)(F.lds + MISC_OFF + 1024); LAS int* pad_start = blk_e + MAXBLK; LAS int* nblk_w = pad_start + 32;
    (void)moe_tables(F, ws, blk_e, pad_start, nblk_w);
    const int* A_E = (const int*)(ws + WS_ROUTE); const int* A_POS = A_E + NASSIGN; const float* A_P = (const float*)(A_POS + NASSIGN); int* SLOT = (int*)(A_P + NASSIGN); float* ROWP = (float*)(SLOT + NASSIGN); int* TOK = (int*)(ROWP + MAXSLOT);
    const bf16* H1 = (const bf16*)(ws + WS_H1); const float* RSTD = (const float*)(ws + WS_RSTD); bf16* HN2 = (bf16*)(ws + WS_XG);
    const float* mod = (const float*)(ws + WS_MOD); const float* sh2 = mod + 6144; const float* sc2 = mod + 8192; const float* w2 = in[7];
    const int gw = F.bid * NWAVES + F.wave, NGW = F.G * NWAVES;
    f32x4 sv[4][2], hv[4][2];
#pragma unroll
    for (int j = 0; j < 4; ++j)
#pragma unroll
        for (int q = 0; q < 2; ++q) { const int col = 8 * F.lane + 512 * j + 4 * q; sv[j][q] = *(const f32x4*)(w2 + col) * (*(const f32x4*)(sc2 + col) + 1.0f); hv[j][q] = *(const f32x4*)(sh2 + col); }
    for (int t = gw; t < L; t += NGW) {
        const float rstd = RSTD[t]; const i32x4 ae = *(const i32x4*)(A_E + 4 * t), ap = *(const i32x4*)(A_POS + 4 * t); const f32x4 pp = *(const f32x4*)(A_P + 4 * t);
        i32x4 slot; slot[0] = pad_start[ae[0]] + ap[0]; slot[1] = pad_start[ae[1]] + ap[1]; slot[2] = pad_start[ae[2]] + ap[2]; slot[3] = pad_start[ae[3]] + ap[3];
        if (F.lane == 0) { *(i32x4*)(SLOT + 4 * t) = slot; ROWP[slot[0]] = pp[0]; ROWP[slot[1]] = pp[1]; ROWP[slot[2]] = pp[2]; ROWP[slot[3]] = pp[3]; TOK[slot[0]] = t; TOK[slot[1]] = t; TOK[slot[2]] = t; TOK[slot[3]] = t; }
#pragma unroll
        for (int j = 0; j < 4; ++j) { const int col = 8 * F.lane + 512 * j; const v4u hr = *(const v4u*)(H1 + (size_t)t * D + col); const f32x4 v0 = {bflo(hr.x), bfhi(hr.x), bflo(hr.y), bfhi(hr.y)}, v1 = {bflo(hr.z), bfhi(hr.z), bflo(hr.w), bfhi(hr.w)};
            const f32x4 o0 = v0 * rstd * sv[j][0] + hv[j][0], o1 = v1 * rstd * sv[j][1] + hv[j][1];
            v4u pk; pk.x = pg8::cvt_pk_bf16(o0[0], o0[1]); pk.y = pg8::cvt_pk_bf16(o0[2], o0[3]); pk.z = pg8::cvt_pk_bf16(o1[0], o1[1]); pk.w = pg8::cvt_pk_bf16(o1[2], o1[3]);
            *(v4u*)(HN2 + (size_t)t * D + col) = pk; }
    }
}
__device__ __forceinline__ void p14_final(const Ctx& F, const float* const* in, float* out, unsigned char* ws) {
    const bf16* H1 = (const bf16*)(ws + WS_H1); const bf16* Y2M = (const bf16*)(ws + WS_Y2M); const float* g2 = (const float*)(ws + WS_MOD) + 10240; const float* fw = in[26];
    const int* SLOT = (const int*)(ws + WS_ROUTE) + 3 * NASSIGN;
    const int gw = F.bid * NWAVES + F.wave, NGW = F.G * NWAVES;
    f32x4 gv[4][2], fv[4][2];
#pragma unroll
    for (int j = 0; j < 4; ++j)
#pragma unroll
        for (int q = 0; q < 2; ++q) { const int col = 8 * F.lane + 512 * j + 4 * q; gv[j][q] = *(const f32x4*)(g2 + col); fv[j][q] = *(const f32x4*)(fw + col); }
    for (int t = gw; t < L; t += NGW) {
        const i32x4 sl = *(const i32x4*)(SLOT + 4 * t);
        f32x4 v[4][2]; float ss = 0.f;
#pragma unroll
        for (int j = 0; j < 4; ++j) { const int col = 8 * F.lane + 512 * j;
            const v4u a = *(const v4u*)(Y2M + (size_t)sl[0] * D + col), b = *(const v4u*)(Y2M + (size_t)sl[1] * D + col), c = *(const v4u*)(Y2M + (size_t)sl[2] * D + col), d = *(const v4u*)(Y2M + (size_t)sl[3] * D + col);
            f32x4 m0, m1;
            m0[0] = (bflo(a.x) + bflo(b.x)) + (bflo(c.x) + bflo(d.x)); m0[1] = (bfhi(a.x) + bfhi(b.x)) + (bfhi(c.x) + bfhi(d.x)); m0[2] = (bflo(a.y) + bflo(b.y)) + (bflo(c.y) + bflo(d.y)); m0[3] = (bfhi(a.y) + bfhi(b.y)) + (bfhi(c.y) + bfhi(d.y));
            m1[0] = (bflo(a.z) + bflo(b.z)) + (bflo(c.z) + bflo(d.z)); m1[1] = (bfhi(a.z) + bfhi(b.z)) + (bfhi(c.z) + bfhi(d.z)); m1[2] = (bflo(a.w) + bflo(b.w)) + (bflo(c.w) + bflo(d.w)); m1[3] = (bfhi(a.w) + bfhi(b.w)) + (bfhi(c.w) + bfhi(d.w));
            const v4u hr = *(const v4u*)(H1 + (size_t)t * D + col); const f32x4 h0 = {bflo(hr.x), bfhi(hr.x), bflo(hr.y), bfhi(hr.y)}, h1v = {bflo(hr.z), bfhi(hr.z), bflo(hr.w), bfhi(hr.w)};
            v[j][0] = h0 + gv[j][0] * m0; v[j][1] = h1v + gv[j][1] * m1;
            ss += (v[j][0][0] * v[j][0][0] + v[j][0][1] * v[j][0][1]) + (v[j][0][2] * v[j][0][2] + v[j][0][3] * v[j][0][3]) + (v[j][1][0] * v[j][1][0] + v[j][1][1] * v[j][1][1]) + (v[j][1][2] * v[j][1][2] + v[j][1][3] * v[j][1][3]); }
        const float rstd = 1.0f / sqrtf(wave_sum(ss) * (1.0f / D) + EPS);
#pragma unroll
        for (int j = 0; j < 4; ++j) { const int col = 8 * F.lane + 512 * j; *(f32x4*)(out + (size_t)t * D + col) = v[j][0] * rstd * fv[j][0]; *(f32x4*)(out + (size_t)t * D + col + 4) = v[j][1] * rstd * fv[j][1]; }
    }
}

__device__ __forceinline__ unsigned tile_off(int r, int ch) { return (unsigned)(r * 256 + ((ch ^ (r & 15)) << 4)); }
__device__ __forceinline__ void load_tile128(LAS unsigned char* dst, const bf16* src, size_t pitch, int tid) {
#pragma unroll
    for (int p = 0; p < 4; ++p) { const int idx = p * 512 + tid, r = idx >> 4, ch = idx & 15; const v4u v = *(const v4u*)(src + (size_t)r * pitch + ch * 8); *(LAS v4u*)(dst + tile_off(r, ch)) = v; }
}
__device__ __forceinline__ bf16x8 frag(const LAS unsigned char* tile, int row, int chunk) { return *(const LAS bf16x8*)(tile + tile_off(row, chunk)); }
__device__ __forceinline__ bf16x8 as_frag(v4u v) { return __builtin_bit_cast(bf16x8, v); }
typedef short s16x4 __attribute__((ext_vector_type(4)));
__device__ __forceinline__ unsigned vimg_off(int r, int ch) { return 256u * (unsigned)r + 16u * (unsigned)(ch ^ (((r & 3) << 2) | ((r >> 2) & 3))); }
__device__ __forceinline__ void stage_vimg(LAS unsigned char* img, const bf16* P, int tok0, int h, int tid) {
#pragma unroll
    for (int p = 0; p < 4; ++p) { const int idx = p * 512 + tid, r = idx >> 4, ch = idx & 15; *(LAS v4u*)(img + vimg_off(r, ch)) = *(const v4u*)(P + pidx((size_t)(tok0 + r), PC_I + h * 128 + 8 * ch)); }
}
__device__ __forceinline__ v2u vtr(const LAS unsigned char* a) { return __builtin_bit_cast(v2u, __builtin_amdgcn_ds_read_tr16_b64_v4i16((LAS s16x4*)a)); }
__device__ __forceinline__ bf16x8 scale8(v4u raw, const f32x4 fa, const f32x4 fb) {
    v4u o; o.x = cvt_pk_bf16(bflo(raw.x) * fa[0], bfhi(raw.x) * fa[1]); o.y = cvt_pk_bf16(bflo(raw.y) * fa[2], bfhi(raw.y) * fa[3]);
    o.z = cvt_pk_bf16(bflo(raw.z) * fb[0], bfhi(raw.z) * fb[1]); o.w = cvt_pk_bf16(bflo(raw.w) * fb[2], bfhi(raw.w) * fb[3]); return __builtin_bit_cast(bf16x8, o);
}
#define MFMA16(a, b, c) __builtin_amdgcn_mfma_f32_16x16x32_bf16((a), (b), (c), 0, 0, 0)
__device__ __forceinline__ v2u pack4(const f32x4 v) { v2u o; o.x = cvt_pk_bf16(v[0], v[1]); o.y = cvt_pk_bf16(v[2], v[3]); return o; }

template <int DIR> __device__ __forceinline__ void hg_item(const Ctx& F, const float* const* in, unsigned char* ws, int c, int h, int mask) {
    const bf16* P = (const bf16*)(ws + WS_PROJ);
    constexpr int d = DIR; const int kc = h * 128 + 2 * F.lane, tokc = c * 128, fc = (d ? PC_FB : PC_FF) + kc;
    const float oml0 = 1.0f - 1.0f / (1.0f + expf(in[15][(d * 2 + 1) * 2048 + kc] - in[15][(d * 2 + 0) * 2048 + kc]));
    const float oml1 = 1.0f - 1.0f / (1.0f + expf(in[15][(d * 2 + 1) * 2048 + kc + 1] - in[15][(d * 2 + 0) * 2048 + kc + 1]));
    const bf16* Pf = P + pidx((size_t)tokc, fc); const bf16* Pq = P + pidx((size_t)tokc, PC_Q + kc);
    const size_t tile = (((size_t)c * 16 + h) * 2 + d) * 16384;
    bf16* QTd = (bf16*)(ws + WS_QT) + tile; bf16* KDd = (bf16*)(ws + WS_KD) + tile;
    const bool needq = c < 128;
    float run0 = 0.f, run1 = 0.f;
    LAS unsigned* qb = (LAS unsigned*)(F.lds + F.wave * 16384); LAS unsigned* kb = qb + 1088;
    const int fslot = (F.lane >> 4) * 64 + ((F.lane >> 2) & 3) * 16;
    unsigned ub[2][16], qb2[2][16];
    { const int I0 = d ? 7 : 0;
#pragma unroll
      for (int j = 0; j < 16; ++j) { ub[0][j] = *(const unsigned*)(Pf + (16 * I0 + j) * 128); qb2[0][j] = *(const unsigned*)(Pq + (16 * I0 + j) * 128); } }
#pragma unroll 1
    for (int half = 0; half < 2; ++half) {
#pragma unroll
        for (int b4 = 0; b4 < 4; ++b4) { const int Ii = half * 4 + b4, I = d ? 7 - Ii : Ii;
            if (Ii + 1 < 8) { const int In = d ? 6 - Ii : Ii + 1;
#pragma unroll
                for (int j = 0; j < 16; ++j) { ub[(b4 + 1) & 1][j] = *(const unsigned*)(Pf + (16 * In + j) * 128); qb2[(b4 + 1) & 1][j] = *(const unsigned*)(Pq + (16 * In + j) * 128); } }
            unsigned (&u)[16] = ub[b4 & 1]; unsigned (&q)[16] = qb2[b4 & 1];
            *(f32x2*)((float*)(ws + WS_BETA) + ((size_t)(c * 2 + d) * 8 + I) * 2048 + kc) = (f32x2){run0, run1};
            float e0 = 1.0f, e1 = 1.0f;
#pragma unroll
            for (int jj = 0; jj < 16; ++jj) { const int j = DIR ? 15 - jj : jj;
                const float k0 = oml0 * sigm(-bflo(u[j])), k1 = oml1 * sigm(-bfhi(u[j]));
                e0 = fmaxf(e0 * (1.0f - k0), 1e-30f); e1 = fmaxf(e1 * (1.0f - k1), 1e-30f);
                const float kd0 = k0 * __builtin_amdgcn_rcpf(e0), kd1 = k1 * __builtin_amdgcn_rcpf(e1);
                { const int slot = fslot + j; qb[(slot + (slot >> 4)) * 4 + (F.lane & 3)] = cvt_pk_bf16(bflo(q[j]) * 0.08838834764831845f * e0, bfhi(q[j]) * 0.08838834764831845f * e1);
                  kb[(slot + (slot >> 4)) * 4 + (F.lane & 3)] = cvt_pk_bf16(kd0, kd1); }
                }
            run0 += __logf(e0); run1 += __logf(e1);
            LDS_WAIT(); asm volatile("" ::: "memory");
            if (!(mask & 16)) {
#pragma unroll
                for (int i = 0; i < 4; ++i) { const int slot = i * 64 + F.lane; const size_t go = (size_t)I * 2048 + (size_t)slot * 8;
                    if (needq) *(v4u*)(QTd + go) = *(const LAS v4u*)(qb + (slot + (slot >> 4)) * 4); *(v4u*)(KDd + go) = *(const LAS v4u*)(kb + (slot + (slot >> 4)) * 4); } }
            LDS_WAIT(); asm volatile("" ::: "memory");
        }
    }
    *(f32x2*)((float*)(ws + WS_DEC) + (size_t)(c * 2 + d) * 2048 + kc) = (f32x2){run0, run1};
}

__device__ __forceinline__ void p3_prep2(const Ctx& F, const float* const* in, unsigned char* ws, int mask) {
    const bf16* P = (const bf16*)(ws + WS_PROJ); const float* cw = in[9]; const float* cb = in[10];
    bf16* BN = (bf16*)(ws + WS_BN); bf16* CN = (bf16*)(ws + WS_CN); bf16* XT = (bf16*)(ws + WS_XT); bf16* BT = (bf16*)(ws + WS_BT);
    float* DTV = (float*)(ws + WS_DTV); float* ACS = (float*)(ws + WS_ACS);
    constexpr int NT = LT / 64, NS = 24, NCONV = NT * NS, NDT = 130 * 64 / 8, NHG = 128 * 16 * 2 / 8 + 2 * 16 * 2;
    if (mask & 1)
    for (int sb = F.bid % NS; sb < NS; sb += (F.G >= NS ? NS : F.G)) {
        const int nown = F.G >= NS ? (F.G - sb + NS - 1) / NS : 1, rank = F.G >= NS ? F.bid / NS : 0;
        const int tl = F.tid >> 3, cg = F.tid & 7, ch0 = sb * 128 + cg * 16;
        float wk[4][16], bk[16];
#pragma unroll
        for (int i = 0; i < 16; i += 4) { const f32x4 b = *(const f32x4*)(cb + ch0 + i); bk[i] = b[0]; bk[i + 1] = b[1]; bk[i + 2] = b[2]; bk[i + 3] = b[3];
#pragma unroll
            for (int k = 0; k < 4; ++k) { const f32x4 w = *(const f32x4*)(cw + k * 3072 + ch0 + i); wk[k][i] = w[0]; wk[k][i + 1] = w[1]; wk[k][i + 2] = w[2]; wk[k][i + 3] = w[3]; } }
        LAS unsigned char* rawb = F.lds + 32768;
#define CV_DMA(buf, ttn) do { _Pragma("unroll") for (int j_ = 0; j_ < 2; ++j_) { const int idx_ = j_ * 512 + F.tid, r_ = idx_ >> 4, ch_ = (idx_ & 15) ^ (r_ & 15); \
            __builtin_amdgcn_global_load_lds((const unsigned*)(P + pidx((size_t)((ttn) * 64 + r_), PC_X + sb * 128 + 8 * ch_)), (LAS unsigned*)((buf) + (j_ * 8 + F.wave) * 1024), 16, 0, 0); } } while (0)
        if (rank < NT && rank * 64 < L) CV_DMA(rawb, rank);
        __builtin_amdgcn_s_waitcnt(0x0F70); __syncthreads();
        int jn = 0;
        for (int tt = rank; tt < NT; tt += nown, ++jn) {
            const int t = tt * 64 + tl;
            const int r0 = t < L ? tt * 64 : L, r1 = t < L ? tt * 64 + 64 : LT;
            const bool lat = tt * 64 < L, latn = tt + nown < NT && (tt + nown) * 64 < L;
            if (latn) CV_DMA(rawb + ((jn + 1) & 1) * 16384, tt + nown);
            float a[16];
#pragma unroll
            for (int i = 0; i < 16; ++i) a[i] = bk[i];
            if (lat) { const LAS unsigned char* rb = rawb + (jn & 1) * 16384;
#pragma unroll
                for (int k = 0; k < 4; ++k) { const int rr = tl + k - 2;
                    if (rr >= 0 && rr < 64) { const v4u u0 = *(const LAS v4u*)(rb + rr * 256 + (((2 * cg) ^ (rr & 15)) << 4)), u1 = *(const LAS v4u*)(rb + rr * 256 + (((2 * cg + 1) ^ (rr & 15)) << 4));
                        const unsigned uu[8] = {u0.x, u0.y, u0.z, u0.w, u1.x, u1.y, u1.z, u1.w};
#pragma unroll
                        for (int i = 0; i < 8; ++i) { a[2 * i] += wk[k][2 * i] * bflo(uu[i]); a[2 * i + 1] += wk[k][2 * i + 1] * bfhi(uu[i]); } } }
            } else {
#pragma unroll
            for (int k = 0; k < 4; ++k) { const int ts = t + k - 2;
                if (ts >= r0 && ts < r1) { const v4u u0 = *(const v4u*)(P + pidx((size_t)ts, PC_X + ch0)), u1 = *(const v4u*)(P + pidx((size_t)ts, PC_X + ch0 + 8));
                    const unsigned uu[8] = {u0.x, u0.y, u0.z, u0.w, u1.x, u1.y, u1.z, u1.w};
#pragma unroll
                    for (int i = 0; i < 8; ++i) { a[2 * i] += wk[k][2 * i] * bflo(uu[i]); a[2 * i + 1] += wk[k][2 * i + 1] * bfhi(uu[i]); } } }
            }
            unsigned o[8];
#pragma unroll
            for (int i = 0; i < 8; ++i) o[i] = pk2(silu(a[2 * i]), silu(a[2 * i + 1]));
            if (sb < 20) {
                LAS bf16* tb = (LAS bf16*)F.lds;
#pragma unroll
                for (int i = 0; i < 8; ++i) { tb[(cg * 16 + 2 * i) * 66 + tl] = (bf16)(o[i] & 0xffffu); tb[(cg * 16 + 2 * i + 1) * 66 + tl] = (bf16)(o[i] >> 16); }
                __syncthreads();
                const int chl = F.tid >> 2, qd = F.tid & 3; const LAS unsigned* rowp = (const LAS unsigned*)(tb + chl * 66 + qd * 16);
                const v4u w0 = {rowp[0], rowp[1], rowp[2], rowp[3]}, w1 = {rowp[4], rowp[5], rowp[6], rowp[7]};
                const int ch = sb * 128 + chl;
                __builtin_amdgcn_s_waitcnt(0x0F70);
                if (ch0 >= 2048) { const int cc = ch0 - (ch0 < 2560 ? 2048 : 2560); bf16* dst = (ch0 < 2560 ? BN : CN) + ((((size_t)(t >> 7)) * 4 + (cc >> 7)) * 128 + (t & 127)) * 128 + (cc & 127);
                    *(v4u*)dst = (v4u){o[0], o[1], o[2], o[3]}; *(v4u*)(dst + 8) = (v4u){o[4], o[5], o[6], o[7]}; }
                if (ch < 2048) {
                    const int p = ch & 63, ks2 = (tt & 1) * 2 + (qd >> 1), g40 = 2 * (qd & 1);
                    bf16* td = XT + ((size_t)(tt >> 1) * 32 + (ch >> 6)) * 8192 + ((((p >> 4) * 4 + ks2) * 4 + g40) * 16 + (p & 15)) * 8;
                    *(v4u*)td = w0; *(v4u*)(td + 128) = w1;
                } else { bf16* td = BT + ((size_t)(tt >> 1) * 512 + (ch - 2048)) * 128 + (tt & 1) * 64 + qd * 16;
                    *(v4u*)td = w0; *(v4u*)(td + 8) = w1; }
                __syncthreads();
            } else {
                __builtin_amdgcn_s_waitcnt(0x0F70);
                { const int cc = ch0 - 2560; bf16* dst = CN + ((((size_t)(t >> 7)) * 4 + (cc >> 7)) * 128 + (t & 127)) * 128 + (cc & 127);
                  *(v4u*)dst = (v4u){o[0], o[1], o[2], o[3]}; *(v4u*)(dst + 8) = (v4u){o[4], o[5], o[6], o[7]}; }
                __syncthreads();
            }
        }
#undef CV_DMA
    }
    for (int it = NCONV + F.bid; it < NCONV + NDT + NHG; it += F.G) {
        if (it < NCONV + NDT) {
            if (!(mask & 2)) continue;
            const int wi = (it - NCONV) * 8 + F.wave, c = wi >> 6, dh = wi & 63, d = dh >> 5, t0 = c * 128 + 2 * F.lane;
            const float* dr = (const float*)(ws + WS_DTRAW); const float bias = in[11][dh], A = -expf(in[12][dh]);
            const float x0 = dr[(size_t)t0 * 64 + dh] + bias, x1 = dr[(size_t)(t0 + 1) * 64 + dh] + bias;
            const float d0 = fmaxf(x0, 0.f) + log1pf(expf(-fabsf(x0))), d1 = fmaxf(x1, 0.f) + log1pf(expf(-fabsf(x1)));
            *(f32x2*)(DTV + (size_t)dh * LT + t0) = (f32x2){d0, d1};
            const float a0 = A * d0, a1 = A * d1; float s = a0 + a1, incl = s;
            if (d == 0) {
#pragma unroll
                for (int o = 1; o < 64; o <<= 1) { const float v = __shfl_up(incl, o); if (F.lane >= o) incl += v; }
                const float excl = incl - s; *(f32x2*)(ACS + (size_t)dh * LT + t0) = (f32x2){excl + a0, excl + a0 + a1};
            } else {
#pragma unroll
                for (int o = 1; o < 64; o <<= 1) { const float v = __shfl_down(incl, o); if (F.lane + o < 64) incl += v; }
                const float excl = incl - s; *(f32x2*)(ACS + (size_t)dh * LT + t0) = (f32x2){excl + a0 + a1, excl + a1};
            }
        } else {
            if (!(mask & 4)) continue;
            const int be = it - NCONV - NDT; if (be >= 512 && F.wave != 0) continue;
            const int wi = be < 512 ? be * 8 + F.wave : 4096 + (be - 512), d = wi & 1, h = (wi >> 1) & 15, c = wi >> 5;
            if (d == 0) hg_item<0>(F, in, ws, c, h, mask); else hg_item<1>(F, in, ws, c, h, mask);
        }
    }
}

__device__ __forceinline__ void p4_local(const Ctx& F, unsigned char* ws, int mask) {
    const int g4 = F.lane >> 4, l15 = F.lane & 15;
    const float* DTV = (const float*)(ws + WS_DTV); const float* ACS = (const float*)(ws + WS_ACS);
    constexpr int NS1 = 130 * 4 * 2, NH1 = 130 * 16;
    for (int it = F.bid; it < NS1; it += F.G) {
        {
            if (!(mask & 1)) continue;
            const int d = it & 1, c = it >> 3, g = (it >> 1) & 3, h = 8 * g + F.wave, tok0 = c * 128;
            LAS unsigned char* BTt = F.lds; LAS float* coef = (LAS float*)(F.lds + 32768 + F.wave * 1024);
            load_tile128(BTt, (const bf16*)(ws + WS_BT) + ((size_t)c * 512 + g * 128) * 128, 128, F.tid);
            { const float aend = ACS[(size_t)h * LT + tok0 + 127], rst = ACS[(size_t)(32 + h) * LT + tok0];
#pragma unroll
              for (int q = 0; q < 2; ++q) { const int s = F.lane + 64 * q;
                  coef[s] = DTV[(size_t)h * LT + tok0 + s] * __expf(aend - ACS[(size_t)h * LT + tok0 + s]);
                  coef[128 + s] = DTV[(size_t)(32 + h) * LT + tok0 + s] * __expf(rst - ACS[(size_t)(32 + h) * LT + tok0 + s]); } }
            __syncthreads();
            const bf16* XT = (const bf16*)(ws + WS_XT); bf16* SST = (bf16*)(ws + WS_SST);
#pragma unroll 1
                for (int ph = 0; ph < 2; ++ph) {
                    asm volatile("" ::: "memory");
                    bf16x8 Y[2][4];
#pragma unroll
                    for (int pp = 0; pp < 2; ++pp)
#pragma unroll
                        for (int ks = 0; ks < 4; ++ks) { const v4u raw = *(const v4u*)(XT + ((size_t)c * 32 + h) * 8192 + (((2 * ph + pp) * 4 + ks) * 64 + F.lane) * 8);
                            const f32x4 fa = *(const LAS f32x4*)(coef + d * 128 + ks * 32 + 8 * g4), fb = *(const LAS f32x4*)(coef + d * 128 + ks * 32 + 8 * g4 + 4);
                            Y[pp][ks] = scale8(raw, fa, fb); }
                    f32x4 acc[8][2];
#pragma unroll
                    for (int nt = 0; nt < 8; ++nt) { acc[nt][0] = (f32x4){0.f, 0.f, 0.f, 0.f}; acc[nt][1] = (f32x4){0.f, 0.f, 0.f, 0.f}; }
#pragma unroll
                    for (int nt = 0; nt < 8; ++nt) { asm volatile("" ::: "memory");
#pragma unroll
                        for (int ks = 0; ks < 4; ++ks) { const bf16x8 X = frag(BTt, nt * 16 + l15, ks * 4 + g4); acc[nt][0] = MFMA16(X, Y[0][ks], acc[nt][0]); acc[nt][1] = MFMA16(X, Y[1][ks], acc[nt][1]); } }
#pragma unroll
                    for (int nt = 0; nt < 8; ++nt)
#pragma unroll
                        for (int pp = 0; pp < 2; ++pp)
                            *(v2u*)(SST + (((size_t)c * 32 + h) * 2 + d) * 8192 + (((((2 * ph + pp) * 4 + (nt >> 1)) * 4 + 2 * (nt & 1) + (g4 >> 1)) * 16 + l15) * 8 + 4 * (g4 & 1))) = pack4(acc[nt][pp]);
                }
            __syncthreads();
        }
    }
    if (mask & 2) {
        const bf16* Pj = (const bf16*)(ws + WS_PROJ); bf16* HST = (bf16*)(ws + WS_HST); const float* DECg = (const float*)(ws + WS_DEC); const float* BETg = (const float*)(ws + WS_BETA);
        const int first = F.G - 1 - F.bid, nit = first < NH1 ? (NH1 - first + F.G - 1) / F.G : 0, nhalf = 2 * nit, w = F.wave, q = l15 >> 2, p = l15 & 3;
        const unsigned ko = (unsigned)((((((g4 >> 1) * 4 + (w >> 1)) * 4 + ((2 * w + (p >> 1)) & 3)) * 16 + 8 * (g4 & 1) + q) * 16) + 8 * (p & 1));
        unsigned vo[2][8];
#pragma unroll
        for (int hb = 0; hb < 2; ++hb) { const int T = (p >> 1) ^ ((q << 2) | ((2 * g4 + hb) & 3));
#pragma unroll
            for (int vt = 0; vt < 8; ++vt) vo[hb][vt] = (unsigned)(256 * (8 * g4 + 4 * hb + q) + 8 * (p & 1) + ((32 * vt) ^ (16 * T))); }
#define H1_DMA_V(bufv, cc, hh) do { _Pragma("unroll") for (int j_ = 0; j_ < 4; ++j_) { const int idx_ = j_ * 512 + F.tid, r_ = idx_ >> 4, ch_ = (idx_ & 15) ^ (((r_ & 3) << 2) | ((r_ >> 2) & 3)); \
            __builtin_amdgcn_global_load_lds((const unsigned*)(Pj + pidx((size_t)((cc) * 128 + r_), PC_I + (hh) * 128 + 8 * ch_)), (LAS unsigned*)((bufv) + (j_ * 8 + w) * 1024), 16, 0, 0); } } while (0)
#define H1_DMA_K(bufk, cc, hh, dd) do { const bf16* ks_ = (const bf16*)(ws + WS_KD) + ((((size_t)(cc) * 16 + (hh)) * 2 + (dd)) * 16384); _Pragma("unroll") for (int j_ = 0; j_ < 4; ++j_) \
            __builtin_amdgcn_global_load_lds((const unsigned*)(ks_ + (size_t)(j_ * 512 + F.tid) * 8), (LAS unsigned*)((bufk) + (j_ * 8 + w) * 1024), 16, 0, 0); } while (0)
        if (nhalf > 0) { H1_DMA_V(F.lds, first >> 4, first & 15); H1_DMA_K(F.lds + 65536, first >> 4, first & 15, 0); }
        f32x4 pacc[8]; int pc = 0, ph = 0, pd = 0;
#pragma unroll
        for (int vt = 0; vt < 8; ++vt) pacc[vt] = (f32x4){0.f, 0.f, 0.f, 0.f};
#pragma unroll 1
        for (int k = 0; k < nhalf; ++k) {
            const int i = k >> 1, d = k & 1, it = first + i * F.G, c = it >> 4, h = it & 15;
            __builtin_amdgcn_s_waitcnt(0x0F70);
            __syncthreads();
            const int kk = h * 128 + 16 * w + l15; float gb[4], gdec;
            { const float* pd_ = DECg + (size_t)(c * 2 + d) * 2048 + kk; const float* pb_ = BETg + ((size_t)(c * 2 + d) * 8 + (g4 >> 1)) * 2048 + kk;
              asm volatile("global_load_dword %0, %5, off\n\tglobal_load_dword %1, %6, off\n\tglobal_load_dword %2, %7, off\n\tglobal_load_dword %3, %8, off\n\tglobal_load_dword %4, %9, off"
                           : "=&v"(gdec), "=&v"(gb[0]), "=&v"(gb[1]), "=&v"(gb[2]), "=&v"(gb[3]) : "v"(pd_), "v"(pb_), "v"(pb_ + 2 * 2048), "v"(pb_ + 4 * 2048), "v"(pb_ + 6 * 2048) : "memory"); }
            { const int kn = k + 1 < nhalf ? k + 1 : k, i1 = kn >> 1, d1 = kn & 1, it1 = first + i1 * F.G, c1 = it1 >> 4, h1 = it1 & 15;
              H1_DMA_V(F.lds + ((k + 1) & 1) * 32768, c1, h1); H1_DMA_K(F.lds + 65536 + ((k + 1) & 1) * 32768, c1, h1, d1); }
            asm volatile("s_waitcnt vmcnt(8)" : "+v"(gdec), "+v"(gb[0]), "+v"(gb[1]), "+v"(gb[2]), "+v"(gb[3]) :: "memory");
            { bf16* dst = k > 0 ? HST : (bf16*)(ws + WS_KHT);
#pragma unroll
              for (int vt = 0; vt < 8; ++vt) { const int v = 16 * vt + l15, kc = 16 * w + 4 * g4;
                  *(v2u*)(dst + ((((size_t)pc * 16 + ph) * 2 + pd) * 128 + v) * 128 + kc) = pack4(pacc[vt]); } }
            const unsigned ka = (unsigned)(size_t)(F.lds + 65536 + (k & 1) * 32768) + ko, vb = (unsigned)(size_t)(F.lds + (k & 1) * 32768);
            unsigned av[2][8];
#pragma unroll
            for (int hb = 0; hb < 2; ++hb)
#pragma unroll
                for (int vt = 0; vt < 8; ++vt) av[hb][vt] = vb + vo[hb][vt];
            f32x4 acc[8];
#pragma unroll
            for (int vt = 0; vt < 8; ++vt) acc[vt] = (f32x4){0.f, 0.f, 0.f, 0.f};
#define H1_STEP(ks, S1, S2) do { v2u t0, t1, bb[2][8]; \
                asm volatile(S1 : "=&v"(t0), "=&v"(t1), "=&v"(bb[0][0]), "=&v"(bb[1][0]), "=&v"(bb[0][1]), "=&v"(bb[1][1]), "=&v"(bb[0][2]), "=&v"(bb[1][2]), "=&v"(bb[0][3]), "=&v"(bb[1][3]) \
                             : "v"(ka), "v"(av[0][0]), "v"(av[1][0]), "v"(av[0][1]), "v"(av[1][1]), "v"(av[0][2]), "v"(av[1][2]), "v"(av[0][3]), "v"(av[1][3]) : "memory"); \
                asm volatile(S2 : "=&v"(bb[0][4]), "=&v"(bb[1][4]), "=&v"(bb[0][5]), "=&v"(bb[1][5]), "=&v"(bb[0][6]), "=&v"(bb[1][6]), "=&v"(bb[0][7]), "=&v"(bb[1][7]) \
                             : "v"(av[0][4]), "v"(av[1][4]), "v"(av[0][5]), "v"(av[1][5]), "v"(av[0][6]), "v"(av[1][6]), "v"(av[0][7]), "v"(av[1][7]) : "memory"); \
                const float gfac = __expf(gdec - gb[ks]); const f32x4 g4v = {gfac, gfac, gfac, gfac};     \
                const bf16x8 X = scale8((v4u){t0.x, t0.y, t1.x, t1.y}, g4v, g4v);                        \
                _Pragma("unroll") for (int vt = 0; vt < 8; ++vt) acc[vt] = MFMA16(X, as_frag((v4u){bb[0][vt].x, bb[0][vt].y, bb[1][vt].x, bb[1][vt].y}), acc[vt]); } while (0)
            H1_STEP(0, "ds_read_b64_tr_b16 %0, %10 offset:0\n\tds_read_b64_tr_b16 %1, %10 offset:64\n\tds_read_b64_tr_b16 %2, %11 offset:0\n\tds_read_b64_tr_b16 %3, %12 offset:0\n\tds_read_b64_tr_b16 %4, %13 offset:0\n\tds_read_b64_tr_b16 %5, %14 offset:0\n\tds_read_b64_tr_b16 %6, %15 offset:0\n\tds_read_b64_tr_b16 %7, %16 offset:0\n\tds_read_b64_tr_b16 %8, %17 offset:0\n\tds_read_b64_tr_b16 %9, %18 offset:0\n\ts_waitcnt lgkmcnt(0)", "ds_read_b64_tr_b16 %0, %8 offset:0\n\tds_read_b64_tr_b16 %1, %9 offset:0\n\tds_read_b64_tr_b16 %2, %10 offset:0\n\tds_read_b64_tr_b16 %3, %11 offset:0\n\tds_read_b64_tr_b16 %4, %12 offset:0\n\tds_read_b64_tr_b16 %5, %13 offset:0\n\tds_read_b64_tr_b16 %6, %14 offset:0\n\tds_read_b64_tr_b16 %7, %15 offset:0\n\ts_waitcnt lgkmcnt(0)");
            H1_STEP(1, "ds_read_b64_tr_b16 %0, %10 offset:8192\n\tds_read_b64_tr_b16 %1, %10 offset:8256\n\tds_read_b64_tr_b16 %2, %11 offset:8192\n\tds_read_b64_tr_b16 %3, %12 offset:8192\n\tds_read_b64_tr_b16 %4, %13 offset:8192\n\tds_read_b64_tr_b16 %5, %14 offset:8192\n\tds_read_b64_tr_b16 %6, %15 offset:8192\n\tds_read_b64_tr_b16 %7, %16 offset:8192\n\tds_read_b64_tr_b16 %8, %17 offset:8192\n\tds_read_b64_tr_b16 %9, %18 offset:8192\n\ts_waitcnt lgkmcnt(0)", "ds_read_b64_tr_b16 %0, %8 offset:8192\n\tds_read_b64_tr_b16 %1, %9 offset:8192\n\tds_read_b64_tr_b16 %2, %10 offset:8192\n\tds_read_b64_tr_b16 %3, %11 offset:8192\n\tds_read_b64_tr_b16 %4, %12 offset:8192\n\tds_read_b64_tr_b16 %5, %13 offset:8192\n\tds_read_b64_tr_b16 %6, %14 offset:8192\n\tds_read_b64_tr_b16 %7, %15 offset:8192\n\ts_waitcnt lgkmcnt(0)");
            H1_STEP(2, "ds_read_b64_tr_b16 %0, %10 offset:16384\n\tds_read_b64_tr_b16 %1, %10 offset:16448\n\tds_read_b64_tr_b16 %2, %11 offset:16384\n\tds_read_b64_tr_b16 %3, %12 offset:16384\n\tds_read_b64_tr_b16 %4, %13 offset:16384\n\tds_read_b64_tr_b16 %5, %14 offset:16384\n\tds_read_b64_tr_b16 %6, %15 offset:16384\n\tds_read_b64_tr_b16 %7, %16 offset:16384\n\tds_read_b64_tr_b16 %8, %17 offset:16384\n\tds_read_b64_tr_b16 %9, %18 offset:16384\n\ts_waitcnt lgkmcnt(0)", "ds_read_b64_tr_b16 %0, %8 offset:16384\n\tds_read_b64_tr_b16 %1, %9 offset:16384\n\tds_read_b64_tr_b16 %2, %10 offset:16384\n\tds_read_b64_tr_b16 %3, %11 offset:16384\n\tds_read_b64_tr_b16 %4, %12 offset:16384\n\tds_read_b64_tr_b16 %5, %13 offset:16384\n\tds_read_b64_tr_b16 %6, %14 offset:16384\n\tds_read_b64_tr_b16 %7, %15 offset:16384\n\ts_waitcnt lgkmcnt(0)");
            H1_STEP(3, "ds_read_b64_tr_b16 %0, %10 offset:24576\n\tds_read_b64_tr_b16 %1, %10 offset:24640\n\tds_read_b64_tr_b16 %2, %11 offset:24576\n\tds_read_b64_tr_b16 %3, %12 offset:24576\n\tds_read_b64_tr_b16 %4, %13 offset:24576\n\tds_read_b64_tr_b16 %5, %14 offset:24576\n\tds_read_b64_tr_b16 %6, %15 offset:24576\n\tds_read_b64_tr_b16 %7, %16 offset:24576\n\tds_read_b64_tr_b16 %8, %17 offset:24576\n\tds_read_b64_tr_b16 %9, %18 offset:24576\n\ts_waitcnt lgkmcnt(0)", "ds_read_b64_tr_b16 %0, %8 offset:24576\n\tds_read_b64_tr_b16 %1, %9 offset:24576\n\tds_read_b64_tr_b16 %2, %10 offset:24576\n\tds_read_b64_tr_b16 %3, %11 offset:24576\n\tds_read_b64_tr_b16 %4, %12 offset:24576\n\tds_read_b64_tr_b16 %5, %13 offset:24576\n\tds_read_b64_tr_b16 %6, %14 offset:24576\n\tds_read_b64_tr_b16 %7, %15 offset:24576\n\ts_waitcnt lgkmcnt(0)");
#undef H1_STEP
#pragma unroll
            for (int vt = 0; vt < 8; ++vt) pacc[vt] = acc[vt];
            pc = c; ph = h; pd = d;
        }
        if (nhalf > 0) {
#pragma unroll
            for (int vt = 0; vt < 8; ++vt) { const int v = 16 * vt + l15, kc = 16 * w + 4 * g4;
                *(v2u*)(HST + ((((size_t)pc * 16 + ph) * 2 + pd) * 128 + v) * 128 + kc) = pack4(pacc[vt]); } }
        __syncthreads();
#undef H1_DMA_V
#undef H1_DMA_K
    }
}

__device__ __forceinline__ void scan_decay(bool ssd, int d, int h, int kc, int c, const float* ACS, const float* DEC, float (&dv)[8]) {
    if (ssd) { const float x = __expf(d == 0 ? ACS[(size_t)h * LT + c * 128 + 127] : ACS[(size_t)(32 + h) * LT + c * 128]);
#pragma unroll
        for (int j = 0; j < 8; ++j) dv[j] = x; }
    else { const f32x4 a = *(const f32x4*)(DEC + (size_t)(c * 2 + d) * 2048 + kc), b = *(const f32x4*)(DEC + (size_t)(c * 2 + d) * 2048 + kc + 4);
        dv[0] = __expf(a[0]); dv[1] = __expf(a[1]); dv[2] = __expf(a[2]); dv[3] = __expf(a[3]); dv[4] = __expf(b[0]); dv[5] = __expf(b[1]); dv[6] = __expf(b[2]); dv[7] = __expf(b[3]); }
}
__device__ __forceinline__ bf16* hsti_chunk(unsigned char* ws, int c) { return (bf16*)(ws + (c < 64 ? WS_HSTI0 : WS_HSTI1)) + (size_t)(c & 63) * 524288; }
__device__ __forceinline__ void p5_scan(const Ctx& F, unsigned char* ws) {
    const float* ACS = (const float*)(ws + WS_ACS); const float* DEC = (const float*)(ws + WS_DEC);
    constexpr size_t CST = 524288;
    for (int u = F.bid * 512 + F.tid; u < 131072; u += F.G * 512) {
        const bool ssd = u < 65536; const int e = ssd ? u : u - 65536;
        int d, h, kc = 0; bf16* base; size_t eoff;
        if (ssd) { const int n8 = e & 15, p = (e >> 4) & 63; d = (e >> 10) & 1; h = e >> 11; eoff = (((size_t)h * 2 + d) * 64 + p) * 128 + n8 * 8; base = (bf16*)(ws + WS_SST) + eoff; }
        else { const int k8 = e & 15, v = (e >> 4) & 127; d = (e >> 11) & 1; h = e >> 12; kc = h * 128 + k8 * 8; eoff = (((size_t)h * 2 + d) * 128 + v) * 128 + k8 * 8; base = (bf16*)(ws + WS_HST) + eoff; }
        float run[8];
#pragma unroll
        for (int j = 0; j < 8; ++j) run[j] = 0.f;
#pragma unroll
        for (int i = 0; i < 2; ++i) { const int c = d == 0 ? 128 + i : 129 - i; float dv[8]; scan_decay(ssd, d, h, kc, c, ACS, DEC, dv); const v4u s = *(const v4u*)(base + (size_t)c * CST);
            const float sv[8] = {bflo(s.x), bfhi(s.x), bflo(s.y), bfhi(s.y), bflo(s.z), bfhi(s.z), bflo(s.w), bfhi(s.w)};
#pragma unroll
            for (int j = 0; j < 8; ++j) run[j] = run[j] * dv[j] + sv[j]; }
#pragma unroll 1
        for (int b = 0; b < 16; ++b) {
            v4u s[8]; float dv[8][8];
#pragma unroll
            for (int i = 0; i < 8; ++i) { const int c = d == 0 ? b * 8 + i : 127 - (b * 8 + i); s[i] = *(const v4u*)(base + (size_t)c * CST); scan_decay(ssd, d, h, kc, c, ACS, DEC, dv[i]); }
#pragma unroll
            for (int i = 0; i < 8; ++i) { const int c = d == 0 ? b * 8 + i : 127 - (b * 8 + i);
                v4u o; o.x = cvt_pk_bf16(run[0], run[1]); o.y = cvt_pk_bf16(run[2], run[3]); o.z = cvt_pk_bf16(run[4], run[5]); o.w = cvt_pk_bf16(run[6], run[7]);
                *(v4u*)((ssd ? (bf16*)(ws + WS_SSTI) + (size_t)c * CST : hsti_chunk(ws, c)) + eoff) = o;
                const float sv[8] = {bflo(s[i].x), bfhi(s[i].x), bflo(s[i].y), bfhi(s[i].y), bflo(s[i].z), bfhi(s[i].z), bflo(s[i].w), bfhi(s[i].w)};
#pragma unroll
                for (int j = 0; j < 8; ++j) run[j] = run[j] * dv[i][j] + sv[j]; }
        }
    }
}

__device__ __forceinline__ void p6_out(const Ctx& F, const float* const* in, unsigned char* ws, int mask) {
    const int g4 = F.lane >> 4, l15 = F.lane & 15;
    const bf16* P = (const bf16*)(ws + WS_PROJ);
    constexpr int NS3 = 128 * 4, NH3 = 128 * 16;
    for (int it = F.bid; it < NS3; it += F.G) {
        {
#ifndef SKIP_S3
            if (!(mask & 1)) continue;
            const int c = it >> 2, g = it & 3, h = 8 * g + F.wave, tok0 = c * 128;
            LAS unsigned char* CNt = F.lds; LAS unsigned char* BNt = F.lds + 32768; LAS float* CB = (LAS float*)(F.lds + 32768);
            LAS float* vec = (LAS float*)(F.lds + 100352 + F.wave * 2048);
            LAS float* ssq = (LAS float*)(F.lds + 116736);
            load_tile128(CNt, (const bf16*)(ws + WS_CN) + ((size_t)c * 4 + g) * 16384, 128, F.tid);
            load_tile128(BNt, (const bf16*)(ws + WS_BN) + ((size_t)c * 4 + g) * 16384, 128, F.tid);
            { const float* ACS = (const float*)(ws + WS_ACS); const float* DTV = (const float*)(ws + WS_DTV);
#pragma unroll
              for (int q = 0; q < 2; ++q) { const int s = F.lane + 64 * q; vec[s] = ACS[(size_t)h * LT + tok0 + s]; vec[128 + s] = ACS[(size_t)(32 + h) * LT + tok0 + s];
                  vec[256 + s] = DTV[(size_t)h * LT + tok0 + s]; vec[384 + s] = DTV[(size_t)(32 + h) * LT + tok0 + s]; } }
            __syncthreads();
            {
                f32x4 acc[8];
#pragma unroll
                for (int st = 0; st < 8; ++st) acc[st] = (f32x4){0.f, 0.f, 0.f, 0.f};
#pragma unroll
                for (int ks = 0; ks < 4; ++ks) { const bf16x8 Yc = frag(CNt, 16 * F.wave + l15, ks * 4 + g4);
#pragma unroll
                    for (int st = 0; st < 8; ++st) acc[st] = MFMA16(frag(BNt, 16 * st + l15, ks * 4 + g4), Yc, acc[st]); }
                __syncthreads();
#pragma unroll
                for (int st = 0; st < 8; ++st) *(LAS f32x4*)(CB + (16 * F.wave + l15) * 132 + 16 * st + 4 * g4) = acc[st];
            }
            __syncthreads();
            const bf16* SST = (const bf16*)(ws + WS_SSTI); const bf16* XT = (const bf16*)(ws + WS_XT); bf16* Y2S = (bf16*)(ws + WS_Y2);
            const float dsk = in[13][h];
#pragma unroll 1
            for (int th = 0; th < 2; ++th) {
                f32x4 y[4][4];
#pragma unroll
                for (int tt = 0; tt < 4; ++tt)
#pragma unroll
                    for (int pt = 0; pt < 4; ++pt) y[tt][pt] = (f32x4){0.f, 0.f, 0.f, 0.f};
#pragma unroll 1
                for (int d = 0; d < 2; ++d) {
                    asm volatile("" ::: "memory");
                    float ev[4];
#pragma unroll
                    for (int tt = 0; tt < 4; ++tt) ev[tt] = __expf(vec[d * 128 + 64 * th + 16 * tt + l15]);
#pragma unroll 1
                    for (int ks = 0; ks < 4; ++ks) {
                        asm volatile("" ::: "memory");
                        bf16x8 Xs[4];
#pragma unroll
                        for (int pt = 0; pt < 4; ++pt) Xs[pt] = as_frag(*(const v4u*)(SST + (((size_t)c * 32 + h) * 2 + d) * 8192 + ((pt * 4 + ks) * 64 + F.lane) * 8));
#pragma unroll
                        for (int tt = 0; tt < 4; ++tt) { const v4u craw = *(const LAS v4u*)(CNt + tile_off(64 * th + 16 * tt + l15, ks * 4 + g4)); const f32x4 e4 = {ev[tt], ev[tt], ev[tt], ev[tt]};
                            const bf16x8 Yc = scale8(craw, e4, e4);
#pragma unroll
                            for (int pt = 0; pt < 4; ++pt) y[tt][pt] = MFMA16(Xs[pt], Yc, y[tt][pt]); }
                    }
                }
#pragma unroll 1
                for (int ks = 0; ks < 4; ++ks) { const int s0 = 32 * ks + 8 * g4;
                    asm volatile("" ::: "memory");
                    bf16x8 Xx[4];
#pragma unroll
                    for (int pt = 0; pt < 4; ++pt) Xx[pt] = as_frag(*(const v4u*)(XT + ((size_t)c * 32 + h) * 8192 + ((pt * 4 + ks) * 64 + F.lane) * 8));
                    f32x4 afs[2], rbs[2], dfs[2], dbs[2];
#pragma unroll
                    for (int hf = 0; hf < 2; ++hf) { afs[hf] = *(const LAS f32x4*)(vec + s0 + 4 * hf); rbs[hf] = *(const LAS f32x4*)(vec + 128 + s0 + 4 * hf); dfs[hf] = *(const LAS f32x4*)(vec + 256 + s0 + 4 * hf); dbs[hf] = *(const LAS f32x4*)(vec + 384 + s0 + 4 * hf); }
#pragma unroll
                    for (int tt = 0; tt < 4; ++tt) { const int tl = 64 * th + 16 * tt + l15; const float aft = vec[tl], rbt = vec[128 + tl]; float m[8];
                        if (ks < 2 * th + (tt >> 1)) {
#pragma unroll
                            for (int hf = 0; hf < 2; ++hf) { const f32x4 cbv = *(const LAS f32x4*)(CB + tl * 132 + s0 + 4 * hf);
#pragma unroll
                                for (int j = 0; j < 4; ++j) m[4 * hf + j] = cbv[j] * dfs[hf][j] * __expf(aft - afs[hf][j]); }
                        } else if (ks > 2 * th + (tt >> 1)) {
#pragma unroll
                            for (int hf = 0; hf < 2; ++hf) { const f32x4 cbv = *(const LAS f32x4*)(CB + tl * 132 + s0 + 4 * hf);
#pragma unroll
                                for (int j = 0; j < 4; ++j) m[4 * hf + j] = cbv[j] * dbs[hf][j] * __expf(rbt - rbs[hf][j]); }
                        } else {
#pragma unroll
                        for (int hf = 0; hf < 2; ++hf) { const f32x4 cbv = *(const LAS f32x4*)(CB + tl * 132 + s0 + 4 * hf);
#pragma unroll
                            for (int j = 0; j < 4; ++j) { const int s = s0 + 4 * hf + j; const float arg = s <= tl ? aft - afs[hf][j] : rbt - rbs[hf][j]; const float cf = s < tl ? dfs[hf][j] : (s > tl ? dbs[hf][j] : dfs[hf][j] + dbs[hf][j]);
                                m[4 * hf + j] = cbv[j] * cf * __expf(arg) + (s == tl ? dsk : 0.f); } }
                        }
                        v4u mp; mp.x = cvt_pk_bf16(m[0], m[1]); mp.y = cvt_pk_bf16(m[2], m[3]); mp.z = cvt_pk_bf16(m[4], m[5]); mp.w = cvt_pk_bf16(m[6], m[7]);
                        const bf16x8 Ym = as_frag(mp);
#pragma unroll
                        for (int pt = 0; pt < 4; ++pt) y[tt][pt] = MFMA16(Xx[pt], Ym, y[tt][pt]); }
                }
                v2u zq[4][4];
#pragma unroll
                for (int tt = 0; tt < 4; ++tt)
#pragma unroll
                    for (int pt = 0; pt < 4; ++pt) zq[tt][pt] = *(const v2u*)(P + pidx((size_t)tok0 + 64 * th + 16 * tt + l15, PC_Z + h * 64 + 16 * pt + 4 * g4));
#pragma unroll
                for (int tt = 0; tt < 4; ++tt) { float ss = 0.f;
#pragma unroll
                    for (int pt = 0; pt < 4; ++pt) { const v2u zz = zq[tt][pt];
                        f32x4 v = y[tt][pt]; v[0] *= silu(bflo(zz.x)); v[1] *= silu(bfhi(zz.x)); v[2] *= silu(bflo(zz.y)); v[3] *= silu(bfhi(zz.y)); y[tt][pt] = v;
                        ss += (v[0] * v[0] + v[1] * v[1]) + (v[2] * v[2] + v[3] * v[3]); }
                    ss += __shfl_xor(ss, 16); ss += __shfl_xor(ss, 32);
                    if (g4 == 0) ssq[F.wave * 64 + 16 * tt + l15] = ss; }
                __syncthreads();
#pragma unroll
                for (int tt = 0; tt < 4; ++tt) { const size_t t = (size_t)tok0 + 64 * th + 16 * tt + l15; float tot = 0.f;
#pragma unroll
                    for (int w = 0; w < 8; ++w) tot += ssq[w * 64 + 16 * tt + l15];
                    const float rstd = 1.0f / sqrtf(tot * (1.0f / 512.0f) + EPS);
#pragma unroll
                    for (int pt = 0; pt < 4; ++pt) { const int ch = h * 64 + 16 * pt + 4 * g4; const f32x4 w = *(const f32x4*)(in[14] + ch);
                        *(v2u*)(Y2S + t * 2048 + ch) = pack4(y[tt][pt] * rstd * w); } }
                __syncthreads();
            }
#endif
        }
    }
    for (int it = F.bid; it < NH3; it += F.G) {
        {
#ifndef SKIP_H3
            if (!(mask & 2)) continue;
            const int hi = it, c = hi >> 4, h = hi & 15, tok0 = c * 128, w = F.wave;
            LAS unsigned char* STf = F.lds; LAS unsigned char* STb = F.lds + 32768; LAS unsigned char* VTt = F.lds + 65536; LAS float* beta = (LAS float*)(F.lds + 98304); LAS float* FT = (LAS float*)(F.lds + CONV_SCR_OFF);
            const bf16* HSTc = hsti_chunk(ws, c);
            const bf16* QT0 = (const bf16*)(ws + WS_QT) + (((size_t)c * 16 + h) * 2) * 16384; const bf16* KD0 = (const bf16*)(ws + WS_KD) + (((size_t)c * 16 + h) * 2) * 16384;
            v4u Qf[2][4]; v2u gg[8];
#pragma unroll
            for (int d = 0; d < 2; ++d)
#pragma unroll
                for (int kk = 0; kk < 4; ++kk) Qf[d][kk] = *(const v4u*)(QT0 + (size_t)d * 16384 + ((w * 4 + kk) * 64 + F.lane) * 8);
#pragma unroll
            for (int vt = 0; vt < 8; ++vt) gg[vt] = *(const v2u*)(P + pidx((size_t)tok0 + 16 * w + l15, PC_G + h * 128 + 16 * vt + 4 * g4));
            load_tile128(STf, HSTc + ((size_t)h * 2 + 0) * 16384, 128, F.tid);
            load_tile128(STb, HSTc + ((size_t)h * 2 + 1) * 16384, 128, F.tid);
            stage_vimg(VTt, P, tok0, h, F.tid);
            { const int idx = F.tid * 4, d = idx >> 10, I = (idx >> 7) & 7, k = idx & 127;
              *(LAS f32x4*)(beta + idx) = *(const f32x4*)((const float*)(ws + WS_BETA) + ((size_t)(c * 2 + d) * 8 + I) * 2048 + h * 128 + k); }
            __syncthreads();
            { const int kq = F.tid & 127, dsel = (F.tid >> 7) & 1, par = F.tid >> 8; float bv[8];
#pragma unroll
              for (int I = 0; I < 8; ++I) bv[I] = beta[(dsel * 8 + I) * 128 + kq];
#pragma unroll
              for (int a_ = 1; a_ < 8; ++a_)
#pragma unroll
                  for (int b_ = 0; b_ < a_; ++b_) { const int pp = a_ * (a_ - 1) / 2 + b_; if ((pp & 1) == par) { const float df = bv[a_] - bv[b_]; FT[(dsel * 28 + pp) * 128 + kq] = __expf(dsel ? -df : df); } } }
            __syncthreads();
            const LAS unsigned char* hv[8];
            { const int q = l15 >> 2, p = l15 & 3, T = (p >> 1) ^ ((q << 2) | g4);
#pragma unroll
              for (int vt = 0; vt < 8; ++vt) hv[vt] = VTt + 256 * (4 * g4 + q) + 8 * (p & 1) + ((32 * vt) ^ (16 * T)); }
            f32x4 o[8];
#pragma unroll
            for (int vt = 0; vt < 8; ++vt) o[vt] = (f32x4){0.f, 0.f, 0.f, 0.f};
#pragma unroll
            for (int d = 0; d < 2; ++d) {
                const LAS unsigned char* ST = d ? STb : STf; const LAS float* bw = beta + (d * 8 + w) * 128; const bf16* KDd = KD0 + (size_t)d * 16384;
                v4u kraw[2][2][4];
#define H3_LOADK(buf, ksx) do { _Pragma("unroll") for (int q_ = 0; q_ < 2; ++q_) { const int J_ = 2 * (ksx) + q_; if (d == 0 ? J_ <= w : J_ >= w) { _Pragma("unroll") for (int kk_ = 0; kk_ < 4; ++kk_) \
                        kraw[buf][q_][kk_] = *(const v4u*)(KDd + ((J_ * 4 + kk_) * 64 + F.lane) * 8); } } } while (0)
                H3_LOADK(0, 0);
#pragma unroll
                for (int kk = 0; kk < 4; ++kk) { const f32x4 b0 = *(const LAS f32x4*)(bw + 32 * kk + 8 * g4), b1 = *(const LAS f32x4*)(bw + 32 * kk + 8 * g4 + 4);
                    const f32x4 e0 = {__expf(b0[0]), __expf(b0[1]), __expf(b0[2]), __expf(b0[3])}, e1 = {__expf(b1[0]), __expf(b1[1]), __expf(b1[2]), __expf(b1[3])};
                    const bf16x8 Yq = scale8(Qf[d][kk], e0, e1);
#pragma unroll
                    for (int vt = 0; vt < 8; ++vt) o[vt] = MFMA16(frag(ST, 16 * vt + l15, kk * 4 + g4), Yq, o[vt]); }
#pragma unroll
                for (int ks = 0; ks < 4; ++ks) {
                    if (ks < 3) H3_LOADK((ks + 1) & 1, ks + 1);
                    const int J0 = 2 * ks, J1 = 2 * ks + 1; const bool n0 = d == 0 ? J0 <= w : J0 >= w, n1 = d == 0 ? J1 <= w : J1 >= w;
                    if (n0 || n1) {
                    f32x4 D[2];
#pragma unroll
                    for (int q = 0; q < 2; ++q) { D[q] = (f32x4){0.f, 0.f, 0.f, 0.f}; const int J = 2 * ks + q; const bool need = q ? n1 : n0;
                        if (need) { const int pa = d == 0 ? w : J, pb = d == 0 ? J : w; const LAS float* ft = FT + (d * 28 + (J != w ? pa * (pa - 1) / 2 + pb : 0)) * 128;
#pragma unroll
                            for (int kk = 0; kk < 4; ++kk) { const v4u raw = kraw[ks & 1][q][kk];
                                bf16x8 Xk;
                                if (J != w) { const f32x4 f0 = *(const LAS f32x4*)(ft + 32 * kk + 8 * g4), f1 = *(const LAS f32x4*)(ft + 32 * kk + 8 * g4 + 4);
                                    Xk = scale8(raw, f0, f1); }
                                else Xk = as_frag(raw);
                                D[q] = MFMA16(Xk, as_frag(Qf[d][kk]), D[q]); }
                            if (J == w) {
#pragma unroll
                                for (int r = 0; r < 4; ++r) { const bool keep = d == 0 ? (4 * g4 + r) <= l15 : (4 * g4 + r) >= l15; D[q][r] = keep ? D[q][r] : 0.f; } } } }
                    v4u ap; ap.x = cvt_pk_bf16(D[0][0], D[0][1]); ap.y = cvt_pk_bf16(D[0][2], D[0][3]); ap.z = cvt_pk_bf16(D[1][0], D[1][1]); ap.w = cvt_pk_bf16(D[1][2], D[1][3]);
                    const bf16x8 Ya = as_frag(ap);
#pragma unroll
                    for (int vh = 0; vh < 2; ++vh) { v2u x0[4], x1[4];
#pragma unroll
                        for (int i = 0; i < 4; ++i) { const int vt = 4 * vh + i; x0[i] = vtr(hv[vt] + 8192 * ks); x1[i] = vtr(hv[vt] + 8192 * ks + 4096); }
#pragma unroll
                        for (int i = 0; i < 4; ++i) { const int vt = 4 * vh + i; o[vt] = MFMA16(as_frag((v4u){x0[i].x, x0[i].y, x1[i].x, x1[i].y}), Ya, o[vt]); } }
                    }
                }
#undef H3_LOADK
            }
            { float ss = 0.f;
#pragma unroll
              for (int vt = 0; vt < 8; ++vt) ss += (o[vt][0] * o[vt][0] + o[vt][1] * o[vt][1]) + (o[vt][2] * o[vt][2] + o[vt][3] * o[vt][3]);
              ss += __shfl_xor(ss, 16); ss += __shfl_xor(ss, 32);
              const float rstd = 1.0f / sqrtf(ss * (1.0f / 128.0f) + EPS); const size_t t = (size_t)tok0 + 16 * w + l15; bf16* Y2H = (bf16*)(ws + WS_Y2 + 64 * MiB);
#pragma unroll
              for (int vt = 0; vt < 8; ++vt) { const int vv = 16 * vt + 4 * g4; const f32x4 wn = *(const f32x4*)(in[16] + vv);
                  f32x4 v = o[vt] * rstd * wn; v[0] *= silu(bflo(gg[vt].x)); v[1] *= silu(bfhi(gg[vt].x)); v[2] *= silu(bflo(gg[vt].y)); v[3] *= silu(bfhi(gg[vt].y));
                  *(v2u*)(Y2H + t * 2048 + h * 128 + vv) = pack4(v); } }
            __syncthreads();
#endif
        }
    }
}

struct Args { const float* in[27]; float* out; unsigned char* ws; int ph_lo, ph_hi, mask, pad; };
constexpr int N_PHASES = 15;
__global__ void __launch_bounds__(NWAVES * 64, 2) mega_fwd(Args args) {
    extern __shared__ __attribute__((aligned(16))) unsigned char lds_raw[];
    Ctx F; F.lds = (LAS unsigned char*)lds_raw; F.tid = threadIdx.x; F.lane = F.tid & 63; F.wave = __builtin_amdgcn_readfirstlane(F.tid >> 6); F.G = gridDim.x; F.bid = blockIdx.x;
    unsigned char* ws = args.ws; const float* const* in = args.in;
    volatile LAS unsigned* MISC = (volatile LAS unsigned*)(F.lds + MISC_OFF);
    if (F.tid < 4) MISC[F.tid] = 0u;
    __syncthreads();
    XcdBarrier bar; bar.bar = (unsigned*)(ws + WS_CTL) + CW_BAR; bar.x = 0; bar.st = nullptr;
    if (!MK_PER_PHASE) bar = xcd_barrier_post((unsigned*)(ws + WS_CTL) + CW_BAR, MISC);
    const int lo = args.ph_lo, hi = args.ph_hi;
#define IN(k) (lo <= (k) && (k) < hi)
#ifndef REPEAT_PHASE
#define REPEAT_PHASE -1
#endif
#define REP(k) for (int rep_ = 0; rep_ < ((k) == REPEAT_PHASE ? 2 : 1); ++rep_)
#define SEAM(k) do { if (IN(k) && IN((k) + 1)) xcd_barrier(bar); } while (0)

    if (IN(0)) REP(0) { if (rep_) xcd_barrier(bar); p0_prologue(F, in, ws); } SEAM(0);
    if (IN(1)) REP(1) { if (rep_) xcd_barrier(bar); p1_norm(F, in, ws); p1_router_fold(F, in, ws); } SEAM(1);
    if (IN(2)) REP(2) { if (rep_) xcd_barrier(bar);
        pg8::Gemm g{(const bf16*)(ws + WS_HN), (const bf16*)(ws + WS_WIN), LT, NP, D, nullptr, nullptr}; ConvOrder S; S.init(LT, NP, F.G, F.bid); S.in = in; S.ws = ws; S.scr = (LAS bf16*)(F.lds + CONV_SCR_OFF + F.wave * 2560); S.lane = F.lane; S.stride = F.G * NWAVES; S.cursor = TR_I_HEAD + F.bid * NWAVES + F.wave;
        EpiProj E{(bf16*)(ws + WS_PROJ), (float*)(ws + WS_DTRAW)};
        pg8::gemm_phase<EpiProj, ConvOrder, true, true>(F.lds, g, S, E);
        { const pg8::Unit du{0, 0, 0}; while (S.cursor < TR_I_ALL) S.done(du); }
    } SEAM(2);
#if NAIVE_SCAN
    if (IN(3)) REP(3) { if (rep_) xcd_barrier(bar); p3_prep(F, in, ws); } SEAM(3);
    if (IN(4)) REP(4) { if (rep_) xcd_barrier(bar); p4_ssd_naive(F, in, ws); p5_hgrn_naive(F, in, ws); } SEAM(4);
    SEAM(5);
    if (IN(6)) REP(6) { if (rep_) xcd_barrier(bar); p6_combine_naive(F, in, ws); } SEAM(6);
#else
    if (IN(3)) REP(3) { if (rep_) xcd_barrier(bar); p3_prep2(F, in, ws, args.mask); } SEAM(3);
    if (IN(4)) REP(4) { if (rep_) xcd_barrier(bar); p4_local(F, ws, args.mask); } SEAM(4);
    if (IN(5)) REP(5) { if (rep_) xcd_barrier(bar); p5_scan(F, ws); } SEAM(5);
    if (IN(6)) REP(6) { if (rep_) xcd_barrier(bar); p6_out(F, in, ws, args.mask); } SEAM(6);
#endif
    if (IN(7)) REP(7) { if (rep_) xcd_barrier(bar);
        pg8::Gemm g{(const bf16*)(ws + WS_Y2), (const bf16*)(ws + WS_WBS), L, D, D, (const bf16*)(ws + WS_Y2 + 64 * MiB), (const bf16*)(ws + WS_WBH)}; pg8::PairOrder S; S.init(L, D, F.G, F.bid);
        EpiBranch E{(const bf16*)(ws + WS_PROJ), (bf16*)(ws + WS_YM)};
        pg8::gemm_phase<EpiBranch, pg8::PairOrder, true, true>(F.lds, g, S, E);
    } if (IN(7) && IN(9)) xcd_barrier(bar);
    if (false) {}
    if (IN(9)) REP(9) { if (rep_) xcd_barrier(bar);
        pg8::Gemm g{(const bf16*)(ws + WS_YM), (const bf16*)(ws + WS_WO), L, D, D, nullptr, nullptr}; pg8::StaticOrder S; S.init(L, D, F.G, F.bid);
        EpiOut E{in[0], (const float*)(ws + WS_MOD) + 4096, (bf16*)(ws + WS_H1)};
        pg8::gemm_phase<EpiOut, pg8::StaticOrder, true, true>(F.lds, g, S, E);
    } SEAM(9);
    if (IN(10)) REP(10) { if (rep_) xcd_barrier(bar); p10_route(F, in, ws); } SEAM(10);
    if (IN(11)) REP(11) { if (rep_) xcd_barrier(bar); p11_gather(F, in, ws); } SEAM(11);
    if (IN(12)) REP(12) { if (rep_) xcd_barrier(bar);
        LAS int* blk_e = (LAS int*)(F.lds + MISC_OFF + 1024); LAS int* pad_start = blk_e + MAXBLK; LAS int* nblk_w = pad_start + 32;
        const int nblk = moe_tables(F, ws, blk_e, pad_start, nblk_w);
        pg8::Gemm g{(const bf16*)(ws + WS_XG), (const bf16*)(ws + WS_WGU), MAXSLOT, NEXP * 4096, D, nullptr, nullptr}; pg8::MoeGatherOrder S; S.init(nblk, 16, F.G, F.bid, blk_e);
        { LAS unsigned* rt = (LAS unsigned*)(F.lds + CONV_SCR_OFF); const int* TOK = (const int*)(ws + WS_ROUTE) + 4 * NASSIGN + MAXSLOT; pg8::Unit u;
          for (int i = 0; i < ROWTAB_UNITS && S.next(i, u); ++i) if (F.tid < 256) { const unsigned tk = (unsigned)TOK[u.pm * 256 + F.tid]; rt[i * 256 + F.tid] = (tk < (unsigned)L ? tk : 0u) * (unsigned)(D * 2); }
          S.rowtab = rt; __syncthreads(); }
        EpiMoe1 E{in[23], (bf16*)(ws + WS_ACT)};
        pg8::gemm_phase<EpiMoe1, pg8::MoeGatherOrder, true, true>(F.lds, g, S, E);
    } SEAM(12);
    if (IN(13)) REP(13) { if (rep_) xcd_barrier(bar);
        LAS int* blk_e = (LAS int*)(F.lds + MISC_OFF + 1024); LAS int* pad_start = blk_e + MAXBLK; LAS int* nblk_w = pad_start + 32;
        const int nblk = moe_tables(F, ws, blk_e, pad_start, nblk_w);
        pg8::Gemm g{(const bf16*)(ws + WS_ACT), (const bf16*)(ws + WS_WDN), MAXSLOT, NEXP * 2048, D, nullptr, nullptr}; pg8::MoeOrder S; S.init(nblk, 8, F.G, F.bid, blk_e);
        EpiMoe2 E{in[25], (const float*)(ws + WS_ROUTE) + 4 * NASSIGN, (bf16*)(ws + WS_Y2M)};
        pg8::gemm_phase<EpiMoe2, pg8::MoeOrder, true, true>(F.lds, g, S, E);
    } SEAM(13);
    if (IN(14)) REP(14) { if (rep_) xcd_barrier(bar); p14_final(F, in, args.out, ws); }
#undef IN
#undef SEAM
}

extern "C" void kernel_launch(void* const* d_in, const int* in_sizes, int n_in, void* d_out, int out_size, void* d_ws, size_t ws_size, hipStream_t stream) {
    static int grid = 0;
    if (grid == 0) {
        if (n_in != 27 || in_sizes[0] != L * D || out_size != L * D || ws_size < WS_END) { fprintf(stderr, "kernel_launch: unexpected shapes (n_in %d, in0 %d, out %d, ws %zu < %zu)\n", n_in, n_in > 0 ? in_sizes[0] : -1, out_size, ws_size, (size_t)WS_END); grid = -1; return; }
        int dev = 0, cus = 0, per_cu = 0;
        if (hipGetDevice(&dev) != hipSuccess || hipDeviceGetAttribute(&cus, hipDeviceAttributeMultiprocessorCount, dev) != hipSuccess) { grid = -1; return; }
        if (hipFuncSetAttribute((const void*)mega_fwd, hipFuncAttributeMaxDynamicSharedMemorySize, LDS_BYTES) != hipSuccess) { fprintf(stderr, "kernel_launch: hipFuncSetAttribute failed\n"); grid = -1; return; }
        if (hipOccupancyMaxActiveBlocksPerMultiprocessor(&per_cu, (const void*)mega_fwd, NWAVES * 64, LDS_BYTES) != hipSuccess || per_cu < 1) { fprintf(stderr, "kernel_launch: occupancy query reports %d\n", per_cu); }
        (void)hipGetLastError();
        grid = cus;
    }
    if (grid < 0) return;
    if (hipMemsetAsync((char*)d_ws + WS_CTL, 0, CTL_ZERO_BYTES, stream) != hipSuccess) return;
    Args a{};
    for (int i = 0; i < 27; ++i) a.in[i] = (const float*)d_in[i];
    a.out = (float*)d_out; a.ws = (unsigned char*)d_ws; a.mask = 7;
#if MK_PER_PHASE
    for (int p = 0; p < 15; ++p) { a.ph_lo = p; a.ph_hi = p + 1; hipLaunchKernelGGL(mega_fwd, dim3(grid), dim3(NWAVES * 64), LDS_BYTES, stream, a); }
#else
    a.ph_lo = 0; a.ph_hi = 15; hipLaunchKernelGGL(mega_fwd, dim3(grid), dim3(NWAVES * 64), LDS_BYTES, stream, a);
#endif
#if PROBE_PHASE >= 0
    a.ph_lo = PROBE_PHASE; a.ph_hi = PROBE_PHASE + 1; a.mask = PROBE_MASK; hipLaunchKernelGGL(mega_fwd, dim3(grid), dim3(NWAVES * 64), LDS_BYTES, stream, a);
#endif
}
```
